# Optimizing an MI355X kernel written in HIP

```python
import jax, jax.numpy as jnp
from jax import lax
import numpy as np

D_MODEL = 1024
BATCH = 8
SEQ = 4096
DEPTH = 1

CHUNK = 64
Q_BLOCK = 128
NORM_EPS = 1e-6
FOX_HEADS = 8
FOX_HEAD_DIM = 64
FOX_WIDTH = FOX_HEADS * FOX_HEAD_DIM
MLA_HEADS = 8
MLA_NOPE_DIM = 64
MLA_ROPE_DIM = 32
MLA_V_DIM = 64
MLA_Q_RANK = 256
MLA_KV_RANK = 128
MLA_QK_DIM = MLA_NOPE_DIM + MLA_ROPE_DIM
MLA_WIDTH = MLA_HEADS * MLA_V_DIM
ROPE_THETA = 10000.0
N_BRANCHES = 2
N_EXPERTS = 32
TOP_K = 4
EXPERT_FF = 1024
SWIGLU_LIMIT = 7.0
SWIGLU_ALPHA = 1.702
EXPERT_BLOCK = 256

IN_SIZES = (FOX_WIDTH, FOX_WIDTH, FOX_WIDTH, FOX_HEADS, MLA_Q_RANK, MLA_KV_RANK + MLA_ROPE_DIM, N_BRANCHES * D_MODEL)
IN_COLS = FOX_WIDTH * 3 + FOX_HEADS + MLA_Q_RANK + MLA_KV_RANK + MLA_ROPE_DIM + N_BRANCHES * D_MODEL

kernel_name = 'hybrid_fox_mla_gated_moe_block'


def rms_norm(x, g):
    xf = x.astype(jnp.float32)
    y = xf * lax.rsqrt(jnp.mean(xf * xf, axis=-1, keepdims=True) + NORM_EPS)
    return (y * g.astype(jnp.float32)).astype(x.dtype)


def apply_rope(x, cos, sin):
    x1, x2 = jnp.split(x, 2, axis=-1)
    return jnp.concatenate([x1 * cos - x2 * sin, x2 * cos + x1 * sin], axis=-1).astype(x.dtype)


def blocked_attention(q, k, v, scale, log_f_cum=None):
    S = q.shape[1]
    neg = jnp.finfo(jnp.float32).min
    outs = []
    for i in range(S // Q_BLOCK):
        q0, q1 = i * Q_BLOCK, (i + 1) * Q_BLOCK
        s = jnp.einsum('bqhd,bkhd->bhqk', q[:, q0:q1], k[:, :q1]).astype(jnp.float32) * scale
        tq = jnp.arange(q0, q1)[:, None]
        tk = jnp.arange(q1)[None, :]
        if log_f_cum is None:
            allowed = (tk // CHUNK) <= (tq // CHUNK)
        else:
            allowed = tk <= tq
            s = s + (log_f_cum[:, :, q0:q1, None] - log_f_cum[:, :, None, :q1])
        p = jax.nn.softmax(jnp.where(allowed, s, neg), axis=-1)
        outs.append(jnp.einsum('bhqk,bkhd->bqhd', p.astype(v.dtype), v[:, :q1]))
    return jnp.concatenate(outs, axis=1)


def token_mixer(h, positions, w_in, b_fgate, g_q_a, w_q_b, g_kv_a, w_kv_b, w_fox_out, w_mla_out, b_merge, w_o):
    B, S, _ = h.shape
    proj = h @ w_in
    q_f, k_f, v_f, f_logit, q_lat, kv_lat, gate_logit = jnp.split(proj, list(np.cumsum(IN_SIZES)[:-1]), axis=-1)

    qf = q_f.reshape(B, S, FOX_HEADS, FOX_HEAD_DIM)
    kf = k_f.reshape(B, S, FOX_HEADS, FOX_HEAD_DIM)
    vf = v_f.reshape(B, S, FOX_HEADS, FOX_HEAD_DIM)
    log_f = jax.nn.log_sigmoid(f_logit.astype(jnp.float32) + b_fgate.astype(jnp.float32))
    log_f_cum = jnp.cumsum(log_f, axis=1).transpose(0, 2, 1)
    y_fox = blocked_attention(qf, kf, vf, FOX_HEAD_DIM ** -0.5, log_f_cum).reshape(B, S, FOX_WIDTH)

    q = (rms_norm(q_lat, g_q_a) @ w_q_b).reshape(B, S, MLA_HEADS, MLA_QK_DIM)
    q_nope, q_pe = q[..., :MLA_NOPE_DIM], q[..., MLA_NOPE_DIM:]
    c_kv, k_pe = kv_lat[..., :MLA_KV_RANK], kv_lat[..., MLA_KV_RANK:]
    kv = (rms_norm(c_kv, g_kv_a) @ w_kv_b).reshape(B, S, MLA_HEADS, MLA_NOPE_DIM + MLA_V_DIM)
    k_nope, v_m = kv[..., :MLA_NOPE_DIM], kv[..., MLA_NOPE_DIM:]
    half = MLA_ROPE_DIM // 2
    inv_freq = ROPE_THETA ** (-jnp.arange(half, dtype=jnp.float32) / half)
    ang = positions.astype(jnp.float32)[..., None] * inv_freq
    cos, sin = jnp.cos(ang), jnp.sin(ang)
    q_pe = apply_rope(q_pe, cos[:, :, None, :], sin[:, :, None, :])
    k_pe = apply_rope(k_pe, cos, sin)
    q_m = jnp.concatenate([q_nope, q_pe], axis=-1)
    k_m = jnp.concatenate([k_nope, jnp.broadcast_to(k_pe[:, :, None, :], (B, S, MLA_HEADS, MLA_ROPE_DIM))], axis=-1)
    y_mla = blocked_attention(q_m, k_m, v_m, MLA_QK_DIM ** -0.5, None).reshape(B, S, MLA_WIDTH)

    gates = jax.nn.sigmoid(gate_logit.reshape(B, S, N_BRANCHES, D_MODEL) + b_merge)
    merged = gates[:, :, 0] * (y_fox @ w_fox_out) + gates[:, :, 1] * (y_mla @ w_mla_out)
    return merged @ w_o


def expert_ffn(xb, w_gu, b_gu, w_d, b_d):
    gu = xb @ w_gu + b_gu
    gate = jnp.minimum(gu[..., :EXPERT_FF], SWIGLU_LIMIT)
    up = jnp.clip(gu[..., EXPERT_FF:], -SWIGLU_LIMIT, SWIGLU_LIMIT)
    glu = gate * jax.nn.sigmoid(SWIGLU_ALPHA * gate)
    return ((up + 1.0) * glu) @ w_d + b_d


def moe_ffn(h, w_router, b_router, w_gu, b_gu, w_d, b_d):
    B, S, D = h.shape
    N = B * S
    A = N * TOP_K
    t = h.reshape(N, D)
    logits = (t @ w_router).astype(jnp.float32) + b_router.astype(jnp.float32)
    top_val, top_idx = lax.top_k(logits, TOP_K)
    top_w = jax.nn.softmax(top_val, axis=-1)
    flat_e = top_idx.reshape(A)
    flat_w = top_w.reshape(A)
    order = jnp.argsort(flat_e)
    sorted_e = flat_e[order]
    sorted_tok = (order // TOP_K).astype(jnp.int32)
    counts = jnp.zeros((N_EXPERTS,), jnp.int32).at[flat_e].add(1)
    padded = (counts + EXPERT_BLOCK - 1) // EXPERT_BLOCK * EXPERT_BLOCK
    pad_end = jnp.cumsum(padded)
    pad_start = pad_end - padded
    start = jnp.cumsum(counts) - counts
    row = pad_start[sorted_e] + (jnp.arange(A, dtype=jnp.int32) - start[sorted_e])
    R = A + N_EXPERTS * EXPERT_BLOCK
    n_blocks = R // EXPERT_BLOCK
    row_tok = jnp.zeros((R,), jnp.int32).at[row].set(sorted_tok)
    row_w = jnp.zeros((R,), jnp.float32).at[row].set(flat_w[order])
    block_e = jnp.minimum(jnp.searchsorted(pad_end, jnp.arange(n_blocks, dtype=jnp.int32) * EXPERT_BLOCK, side='right'), N_EXPERTS - 1)
    xs = t[row_tok].reshape(n_blocks, EXPERT_BLOCK, D)
    ys = lax.map(lambda a: expert_ffn(a[0], w_gu[a[1]], b_gu[a[1]], w_d[a[1]], b_d[a[1]]), (xs, block_e))
    ys = ys.reshape(R, D) * row_w[:, None].astype(ys.dtype)
    return jax.ops.segment_sum(ys, row_tok, num_segments=N).reshape(B, S, D)


def setup_inputs(seed: int = 0) -> dict:
    key = jax.random.key(seed)
    ks = jax.random.split(key, 24)
    f32 = jnp.float32
    L = DEPTH

    def nrm(k, shape, scale):
        return jax.random.normal(k, shape, f32) * scale

    def gain(k, shape):
        return 1.0 + 0.05 * jax.random.normal(k, shape, f32)

    x = jax.random.normal(ks[0], (BATCH, SEQ, D_MODEL), f32)
    offsets = jax.random.randint(ks[1], (BATCH, 1), 0, 8192, dtype=jnp.int32)
    positions = offsets + jnp.arange(SEQ, dtype=jnp.int32)[None, :]
    return {
        'x': x,
        'positions': positions,
        'g_attn_norm': gain(ks[2], (L, D_MODEL)),
        'w_in': nrm(ks[3], (L, D_MODEL, IN_COLS), D_MODEL ** -0.5),
        'b_fgate': 3.0 + 0.5 * jax.random.normal(ks[4], (L, FOX_HEADS), f32),
        'g_q_a': gain(ks[5], (L, MLA_Q_RANK)),
        'w_q_b': nrm(ks[6], (L, MLA_Q_RANK, MLA_HEADS * MLA_QK_DIM), MLA_Q_RANK ** -0.5),
        'g_kv_a': gain(ks[7], (L, MLA_KV_RANK)),
        'w_kv_b': nrm(ks[8], (L, MLA_KV_RANK, MLA_HEADS * (MLA_NOPE_DIM + MLA_V_DIM)), MLA_KV_RANK ** -0.5),
        'w_fox_out': nrm(ks[9], (L, FOX_WIDTH, D_MODEL), FOX_WIDTH ** -0.5),
        'w_mla_out': nrm(ks[10], (L, MLA_WIDTH, D_MODEL), MLA_WIDTH ** -0.5),
        'b_merge': nrm(ks[11], (L, N_BRANCHES, D_MODEL), 0.1),
        'w_o': nrm(ks[12], (L, D_MODEL, D_MODEL), D_MODEL ** -0.5),
        'g_ffn_norm': gain(ks[13], (L, D_MODEL)),
        'w_router': nrm(ks[14], (L, D_MODEL, N_EXPERTS), D_MODEL ** -0.5),
        'b_router': nrm(ks[15], (L, N_EXPERTS), 0.01),
        'w_gu': nrm(ks[16], (L, N_EXPERTS, D_MODEL, 2 * EXPERT_FF), D_MODEL ** -0.5),
        'b_gu': nrm(ks[17], (L, N_EXPERTS, 2 * EXPERT_FF), 0.01),
        'w_down': nrm(ks[18], (L, N_EXPERTS, EXPERT_FF, D_MODEL), EXPERT_FF ** -0.5),
        'b_down': nrm(ks[19], (L, N_EXPERTS, D_MODEL), 0.01),
        'g_final': gain(ks[20], (D_MODEL,)),
    }


def reference(x, positions, g_attn_norm, w_in, b_fgate, g_q_a, w_q_b, g_kv_a, w_kv_b, w_fox_out, w_mla_out, b_merge, w_o, g_ffn_norm, w_router, b_router, w_gu, b_gu, w_down, b_down, g_final):
    for l in range(DEPTH):
        h = rms_norm(x, g_attn_norm[l])
        x = x + token_mixer(h, positions, w_in[l], b_fgate[l], g_q_a[l], w_q_b[l], g_kv_a[l], w_kv_b[l], w_fox_out[l], w_mla_out[l], b_merge[l], w_o[l])
        h = rms_norm(x, g_ffn_norm[l])
        x = x + moe_ffn(h, w_router[l], b_router[l], w_gu[l], b_gu[l], w_down[l], b_down[l])
    return rms_norm(x, g_final)
```

```cpp
#include <hip/hip_runtime.h>
#include <cstdio>
#include <cstdint>

constexpr int DM = 1024, BATCH = 8, SEQ = 4096, NTOK = BATCH * SEQ;
constexpr int NE = 32, TOPK = 4, FF = 1024;
constexpr int IN_COLS = 4008;
constexpr int C_QF = 0, C_KF = 512, C_VF = 1024, C_FL = 1536, C_QL = 1544, C_KV = 1800, C_KPE = 1928, C_G = 1960;
constexpr float EPS = 1e-6f;
constexpr size_t SSQ2 = (size_t)NTOK * 4;
constexpr float LOG2E = 1.4426950408889634f;
constexpr float C2F = 0.125f * LOG2E;
constexpr float C2M = 0.10206207261596577f * LOG2E;

typedef unsigned short bf16;
__device__ __forceinline__ unsigned f2bf(float f) { unsigned u = __builtin_bit_cast(unsigned, f); return (u + 0x7fffu + ((u >> 16) & 1u)) >> 16; }
__device__ __forceinline__ float bf2f(bf16 b) { return __builtin_bit_cast(float, (unsigned)b << 16); }

constexpr size_t MiB = 1u << 20;
constexpr size_t WS_CTL = 0;
constexpr size_t WS_WIN = 2 * MiB, WS_WQ = 10 * MiB, WS_WKV = 10 * MiB + 512 * 1024, WS_WF = 11 * MiB, WS_WM = 12 * MiB, WS_WO = 13 * MiB;
constexpr size_t WS_WGU = 16 * MiB, WS_WD = 144 * MiB;
constexpr size_t WS_SSQ = 208 * MiB, WS_KPE = 209 * MiB, WS_LOGF = 211 * MiB, WS_CS = 212 * MiB, WS_KB = 216 * MiB, WS_TOPI = 217 * MiB, WS_TOPW = 217 * MiB + 512 * 1024;
constexpr size_t WS_ROWTOK = 218 * MiB, WS_ROWSLOT = 219 * MiB, WS_ROWW = 220 * MiB, WS_MISC = 221 * MiB;
constexpr size_t WS_T0 = 224 * MiB, WS_H2 = 224 * MiB, WS_MG = 288 * MiB;
constexpr size_t WS_A = 352 * MiB, WS_H = 352 * MiB, WS_QF = 416 * MiB, WS_KF = 448 * MiB, WS_VF = 480 * MiB, WS_QL = 512 * MiB, WS_QM = 544 * MiB, WS_ACT = 480 * MiB, WS_X1 = 352 * MiB;
constexpr size_t WS_B = 624 * MiB, WS_G = 624 * MiB, WS_KN = 752 * MiB, WS_VM = 784 * MiB, WS_YF = 816 * MiB, WS_YM = 848 * MiB, WS_Z = 624 * MiB;
constexpr size_t WS_H8 = 288 * MiB;
constexpr size_t WS_WIN8 = 2 * MiB + 4 * MiB;
constexpr size_t WS_END = 896 * MiB;

struct P {
    const float* x; const int* pos; const float* g_attn; const float* w_in; const float* b_fgate; const float* g_q_a; const float* w_q_b; const float* g_kv_a; const float* w_kv_b;
    const float* w_fox; const float* w_mla; const float* b_merge; const float* w_o; const float* g_ffn; const float* w_router; const float* b_router;
    const float* w_gu; const float* b_gu; const float* w_down; const float* b_down; const float* g_final;
    float* out; unsigned char* ws;
};
#define WSP(T, off) ((T*)(p.ws + (off)))

__device__ __forceinline__ float wave_sum(float v) {
#pragma unroll
    for (int o = 1; o < 64; o <<= 1) v += __shfl_xor(v, o);
    return v;
}

#ifndef GATE_FP8
#define GATE_FP8 1
#endif
#ifndef Z_FP8
#define G_FP8 1
#define WO_FP8 1
#define FUSED_ROWS 1
#define Z_FP8 1
#endif
#ifndef MOE_FP8
#define MOE_FP8 1
#endif
#define GAS __attribute__((address_space(1)))
#define LAS __attribute__((address_space(3)))
typedef unsigned u32x4 __attribute__((ext_vector_type(4)));
typedef unsigned u32x2 __attribute__((ext_vector_type(2)));
typedef float f32x4 __attribute__((ext_vector_type(4)));
typedef float f32x16 __attribute__((ext_vector_type(16)));
typedef short bf16x8 __attribute__((ext_vector_type(8)));
typedef short s16x4 __attribute__((ext_vector_type(4)));
typedef int v8i32 __attribute__((ext_vector_type(8)));
typedef int v4i32 __attribute__((ext_vector_type(4)));
typedef GAS unsigned gu32;
#define RLX_AGENT __ATOMIC_RELAXED, __HIP_MEMORY_SCOPE_AGENT
#define LDS_WAIT() asm volatile("s_waitcnt lgkmcnt(0)" ::: "memory")
#define VM_WAIT() asm volatile("s_waitcnt vmcnt(0)" ::: "memory")
__device__ __forceinline__ unsigned cvt_pk_bf16(float lo, float hi) { unsigned r; asm volatile("v_cvt_pk_bf16_f32 %0, %1, %2" : "=v"(r) : "v"(lo), "v"(hi)); return r; }
__device__ __forceinline__ u32x4 pack8(f32x4 a, f32x4 b) { u32x4 w; w.x = cvt_pk_bf16(a[0], a[1]); w.y = cvt_pk_bf16(a[2], a[3]); w.z = cvt_pk_bf16(b[0], b[1]); w.w = cvt_pk_bf16(b[2], b[3]); return w; }
__device__ __forceinline__ u32x2 pack8_fp8(f32x4 a, f32x4 b) { int w0 = __builtin_amdgcn_cvt_pk_fp8_f32(a[0], a[1], 0, false); w0 = __builtin_amdgcn_cvt_pk_fp8_f32(a[2], a[3], w0, true);
    int w1 = __builtin_amdgcn_cvt_pk_fp8_f32(b[0], b[1], 0, false); w1 = __builtin_amdgcn_cvt_pk_fp8_f32(b[2], b[3], w1, true); return (u32x2){(unsigned)w0, (unsigned)w1}; }
__device__ __forceinline__ float bflo(unsigned w) { return __builtin_bit_cast(float, w << 16); }
__device__ __forceinline__ float bfhi(unsigned w) { return __builtin_bit_cast(float, w & 0xffff0000u); }
typedef float f32x2 __attribute__((ext_vector_type(2)));
__device__ __forceinline__ f32x2 fsigmoid2(f32x2 z) { const f32x2 t = z * (-LOG2E); f32x2 e; e.x = __builtin_amdgcn_exp2f(t.x); e.y = __builtin_amdgcn_exp2f(t.y); const f32x2 d = e + 1.f; f32x2 r; r.x = __builtin_amdgcn_rcpf(d.x); r.y = __builtin_amdgcn_rcpf(d.y); return r; }
__device__ __forceinline__ unsigned lane_xor1(unsigned v) { return (unsigned)__builtin_amdgcn_mov_dpp((int)v, 0xB1, 0xF, 0xF, true); }
__device__ __forceinline__ float fsigmoid(float z) { return __builtin_amdgcn_rcpf(1.f + __builtin_amdgcn_exp2f(-z * LOG2E)); }

constexpr int RING_BYTES = 131072;
constexpr int MISC_OFF = RING_BYTES;
constexpr int BLKE_OFF = MISC_OFF + 1024;
constexpr int ROWTAB_OFF = BLKE_OFF + 2304;
constexpr int ROWTAB_UNITS = 18;
constexpr int BIASL_OFF = ROWTAB_OFF + ROWTAB_UNITS * 1024;
constexpr int LDS_BYTES = BIASL_OFF + ROWTAB_UNITS * 512;
static_assert(LDS_BYTES <= 160 * 1024, "LDS");
static_assert(WS_VF - WS_KF == WS_KF - WS_QF, "QF/KF/VF equally spaced");
constexpr int NWAVES = 8;
constexpr int MAXBLK = 544;
constexpr int GM_NBLK = 0, GM_BLKE = 64, GM_CNT = 1024, GM_KMAX = 40000;
constexpr int GM_CUR = GM_CNT;
constexpr int ESTR = NTOK + 256;
constexpr size_t WS_EROWTOK = 80 * MiB, WS_EROWSLOT = 85 * MiB, WS_EROWW = 90 * MiB;

namespace pg8 {
#define PG8_LAS __attribute__((address_space(3)))
typedef unsigned short bf16_t;
constexpr int BM = 256, BK = 64, HALF = 128, HTB = HALF * BK * 2, STAGE_BYTES = 8 * HTB, NXCD = 8, WGM = 8;
__host__ __device__ __forceinline__ int lds_byte(int r, int c) { const int st = (r >> 4) * 2 + (c >> 5), rr = r & 15, cc = c & 31, ob = rr * 64 + cc * 2; return st * 1024 + (ob ^ (((ob >> 9) & 1) << 5)); }
__host__ __device__ __forceinline__ void stage_rc(int b, int& R, int& C) { const int st = b / 1024, sb = b % 1024, swz = sb ^ (((sb >> 9) & 1) << 5); R = (st >> 1) * 16 + swz / 64; C = (st & 1) * 32 + (swz % 64) / 2; }
__host__ __device__ __forceinline__ int perm32(int rho) { const int n = rho >> 4, i = rho & 15; return 8 * (i >> 2) + 4 * n + (i & 3); }

struct Unit { int pm, pn, bt, e, ui; };
struct Gemm { const bf16_t* A; const bf16_t* Bt; int K, lda; int ascale = 0x7F7F7F7F; };

struct StaticOrder {
    int nM, nN, nwg, G, c;
    __device__ void init(int M, int N, int G_, int c_) { nM = M / BM; nN = N / BM; nwg = nM * nN; G = G_; c = c_; }
    __device__ bool next(int i, Unit& u) const {
        const long L = (long)i * G + c; if (L >= nwg) return false;
        int wgid = (int)L; { const int q = nwg / NXCD, r = nwg % NXCD, xcd = wgid % NXCD, off = wgid / NXCD; wgid = (xcd < r ? xcd * (q + 1) : r * (q + 1) + (xcd - r) * q) + off; }
        const int nig = WGM * nN, gid = wgid / nig, fm = gid * WGM, gsz = (nM - fm) < WGM ? (nM - fm) : WGM;
        u.pm = fm + ((wgid % nig) % gsz); u.pn = (wgid % nig) / gsz; u.bt = u.pn; u.e = 0; u.ui = i; return true;
    }
};
struct LinearOrder {
    int nunits, G, c, shift;
    __device__ bool next(int i, Unit& u) const { const int idx = c + i * G; if (idx >= nunits) return false; u.pm = idx >> shift; u.pn = idx & ((1 << shift) - 1); u.bt = u.pn; u.e = 0; return true; }
};
struct MoeOrder {
    int nblk, s, g8, xr, gr, pn0, cpxs, shift; const PG8_LAS int* blke;
    __device__ void init(int nblk_, int G, int c, int shift_, int gc_log2, const PG8_LAS int* blke_) {
        nblk = nblk_; shift = shift_; blke = blke_; g8 = G >> 3; s = c >> 3; const int x = c & 7; gr = 8 >> gc_log2; xr = x & (gr - 1); const int xc = x / gr; cpxs = shift_ - gc_log2; pn0 = xc << cpxs; }
    __device__ int rb_of(int i) const { const int j = s + i * g8; return (j >> cpxs) * gr + xr; }
    __device__ bool next(int i, Unit& u) const {
        const int j = s + i * g8, rb = (j >> cpxs) * gr + xr; if (rb >= nblk) return false;
        const int pn = pn0 + (j & ((1 << cpxs) - 1)), e = blke[rb];
        u.pm = rb; u.pn = pn; u.e = e; u.bt = (e << shift) + pn; u.ui = i; return true;
    }
};

template <class Epi, class Sched, bool ALIGN_EPI, bool GATHER>
__device__ __forceinline__ void gemm_phase(PG8_LAS unsigned char* lds, const Gemm g, const Sched& S, const Epi& E, const PG8_LAS int* rowtab) {
    int tid_ = threadIdx.x; asm volatile("" : "+v"(tid_));
    const int tid = tid_, wid = __builtin_amdgcn_readfirstlane(tid >> 6), lane = tid & 63, wr = wid >> 2, wc = wid & 3, fr = lane & 15, fq = lane >> 4;
    const int K = g.K, nt = K / BK, lda = g.lda;
    unsigned voffA[2], voffB[2]; int RA[2]; unsigned CA2[2];
#pragma unroll
    for (int i = 0; i < 2; ++i) { int R, C; stage_rc(tid * 16 + i * 8192, R, C); const int Rb = Epi::WIDE ? (64 * (R >> 5) + perm32(R & 31)) : Epi::PERM ? ((R & ~31) + perm32(R & 31)) : R;
        voffA[i] = (unsigned)(R * lda + C) * 2u; voffB[i] = (unsigned)(Rb * K + C) * 2u; RA[i] = R; CA2[i] = (unsigned)C * 2u; }
    const size_t kstep = (size_t)(BK * 2);
    const size_t hstepA = (size_t)HALF * lda * 2, tstepA = 2 * hstepA;
    const size_t hstepB = (size_t)(Epi::WIDE ? 32 : HALF) * K * 2, tstepB = (size_t)2 * HALF * K * 2;
    const unsigned ldsw = (unsigned)wid * 1024u;
    const int aoff = lds_byte(wr * 64 + fr, fq * 8), boff = lds_byte(wc * 32 + fr, fq * 8);
    unsigned va[2][2], vn[2][2];
#define PG8_SA(b, h) (((b) * 2 + (h)) * HTB)
#define PG8_SB(b, h) ((4 + (b) * 2 + (h)) * HTB)
#define PG8_STAGE(bufoff, gbase, voff) do { _Pragma("unroll") for (int _i = 0; _i < 2; ++_i) \
        __builtin_amdgcn_global_load_lds((const unsigned*)((const char*)(gbase) + (voff)[_i]), (PG8_LAS unsigned*)(lds + (bufoff) + ldsw + _i * 8192), 16, 0, 0); } while (0)
#define PG8_STAGE_A(bufoff, gbase, h, NXT) do { if constexpr (GATHER) { unsigned o_[2]; o_[0] = (NXT) ? vn[h][0] : va[h][0]; o_[1] = (NXT) ? vn[h][1] : va[h][1]; PG8_STAGE(bufoff, gbase, o_); } \
        else { PG8_STAGE(bufoff, (gbase) + (h) * hstepA, voffA); } } while (0)
#define PG8_LDA(dst, b, h) do { _Pragma("unroll") for (int m = 0; m < 4; ++m) _Pragma("unroll") for (int k = 0; k < 2; ++k) dst[m][k] = *(const PG8_LAS bf16x8*)(lds + PG8_SA(b, h) + aoff + m * 2048 + k * 1024); } while (0)
#define PG8_LDB(dst, b, h) do { _Pragma("unroll") for (int n = 0; n < 2; ++n) _Pragma("unroll") for (int k = 0; k < 2; ++k) dst[n][k] = *(const PG8_LAS bf16x8*)(lds + PG8_SB(b, h) + boff + n * 2048 + k * 1024); } while (0)
#define PG8_MMA(ai, bj, At, Bt) do { __builtin_amdgcn_s_setprio(1); _Pragma("unroll") for (int m = 0; m < 4; ++m) _Pragma("unroll") for (int n = 0; n < 2; ++n) _Pragma("unroll") for (int k = 0; k < 2; ++k) \
        acc[ai][bj][m][n] = __builtin_amdgcn_mfma_f32_16x16x32_bf16(Bt[n][k], At[m][k], acc[ai][bj][m][n], 0, 0, 0); __builtin_amdgcn_s_setprio(0); } while (0)
#define PG8_WAIT_V(n) asm volatile("s_waitcnt vmcnt(" #n ")" ::: "memory")
#define PG8_WAIT_L(n) asm volatile("s_waitcnt lgkmcnt(" #n ")" ::: "memory")
#define PG8_BAR __builtin_amdgcn_s_barrier()
#define PG8_SCHED __builtin_amdgcn_sched_barrier(0)
#define PG8_ROWOFF(dst, ui_) do { _Pragma("unroll") for (int h_ = 0; h_ < 2; ++h_) _Pragma("unroll") for (int i_ = 0; i_ < 2; ++i_) \
        dst[h_][i_] = (unsigned)rowtab[(ui_) * 256 + h_ * 128 + RA[i_]] * (unsigned)(lda * 2) + CA2[i_]; } while (0)
    Unit cur, nxt; int ui = 0;
    if (!S.next(0, cur)) return;
    f32x4 acc[2][2][4][2];
#pragma unroll
    for (int a = 0; a < 2; ++a)
#pragma unroll
        for (int b = 0; b < 2; ++b)
#pragma unroll
            for (int m = 0; m < 4; ++m)
#pragma unroll
                for (int n = 0; n < 2; ++n) acc[a][b][m][n] = (f32x4){0.f, 0.f, 0.f, 0.f};
    bf16x8 At[4][2], B0[2][2], B1[2][2];
    const char* cA = (const char*)g.A + (GATHER ? (size_t)0 : (size_t)cur.pm * tstepA); const char* cB = (const char*)g.Bt + (size_t)cur.bt * tstepB;
    if constexpr (GATHER) { PG8_ROWOFF(va, 0); }
    PG8_STAGE(PG8_SB(0, 0), cB, voffB); PG8_STAGE(PG8_SB(0, 1), cB + hstepB, voffB); PG8_STAGE_A(PG8_SA(0, 0), cA, 0, false); PG8_STAGE_A(PG8_SA(0, 1), cA, 1, false);
    if (wr == 1) PG8_BAR;
    PG8_WAIT_V(2); PG8_BAR;
    PG8_STAGE(PG8_SB(1, 0), cB + kstep, voffB); PG8_STAGE_A(PG8_SA(1, 0), cA + kstep, 0, false); PG8_STAGE(PG8_SB(1, 1), cB + hstepB + kstep, voffB);
    PG8_WAIT_V(6); PG8_BAR;
    for (;;) {
        const bool has_next = S.next(ui + 1, nxt);
        const char* nA = has_next ? (const char*)g.A + (GATHER ? (size_t)0 : (size_t)nxt.pm * tstepA) : cA; const char* nB = has_next ? (const char*)g.Bt + (size_t)nxt.bt * tstepB : cB;
        if constexpr (GATHER) { if (has_next) { PG8_ROWOFF(vn, ui + 1); } else {
#pragma unroll
            for (int h_ = 0; h_ < 2; ++h_)
#pragma unroll
                for (int i_ = 0; i_ < 2; ++i_) vn[h_][i_] = va[h_][i_]; } }
        for (int t = 0; t < nt; t += 2) {
            const bool last = (t == nt - 2);
            const char* a1 = cA + (size_t)(t + 1) * kstep;
            const char* a2 = last ? nA : cA + (size_t)(t + 2) * kstep; const char* b2 = last ? nB : cB + (size_t)(t + 2) * kstep;
            const char* a3 = a2 + kstep; const char* b3 = b2 + kstep;
            PG8_LDB(B0, 0, 0); PG8_LDB(B1, 0, 1); PG8_SCHED; PG8_LDA(At, 0, 0); PG8_STAGE_A(PG8_SA(1, 1), a1, 1, false);
            PG8_WAIT_V(8); PG8_WAIT_L(0); PG8_BAR; PG8_MMA(0, 0, At, B0); PG8_MMA(0, 1, At, B1); PG8_BAR; PG8_SCHED;
            PG8_LDA(At, 0, 1); PG8_STAGE(PG8_SB(0, 0), b2, voffB); PG8_STAGE(PG8_SB(0, 1), b2 + hstepB, voffB); PG8_STAGE_A(PG8_SA(0, 0), a2, 0, last);
            PG8_WAIT_V(8); PG8_WAIT_L(0); PG8_BAR; PG8_MMA(1, 0, At, B0); PG8_MMA(1, 1, At, B1); PG8_BAR; PG8_SCHED;
            PG8_LDB(B0, 1, 0); PG8_LDB(B1, 1, 1); PG8_SCHED; PG8_LDA(At, 1, 0); PG8_STAGE_A(PG8_SA(0, 1), a2, 1, last);
            PG8_WAIT_V(8); PG8_WAIT_L(0); PG8_BAR; PG8_MMA(0, 0, At, B0); PG8_MMA(0, 1, At, B1); PG8_BAR; PG8_SCHED;
            PG8_LDA(At, 1, 1); PG8_STAGE(PG8_SB(1, 0), b3, voffB); PG8_STAGE(PG8_SB(1, 1), b3 + hstepB, voffB); PG8_STAGE_A(PG8_SA(1, 0), a3, 0, last);
            PG8_WAIT_V(8); PG8_WAIT_L(0); PG8_BAR; PG8_MMA(1, 0, At, B0); PG8_MMA(1, 1, At, B1); PG8_BAR; PG8_SCHED;
        }
        if constexpr (ALIGN_EPI) { if (wr == 0) PG8_BAR; }
        E(acc, cur, wr, wc, fr, fq);
        if (!has_next) break;
#pragma unroll
        for (int a = 0; a < 2; ++a)
#pragma unroll
            for (int b = 0; b < 2; ++b)
#pragma unroll
                for (int m = 0; m < 4; ++m)
#pragma unroll
                    for (int n = 0; n < 2; ++n) acc[a][b][m][n] = (f32x4){0.f, 0.f, 0.f, 0.f};
        cur = nxt; cA = nA; cB = nB; ++ui;
        if constexpr (GATHER) {
#pragma unroll
            for (int h_ = 0; h_ < 2; ++h_)
#pragma unroll
                for (int i_ = 0; i_ < 2; ++i_) va[h_][i_] = vn[h_][i_]; }
        if constexpr (ALIGN_EPI) { if (wr == 1) PG8_BAR; }
    }
    PG8_WAIT_V(0);
    if constexpr (!ALIGN_EPI) { if (wr == 0) PG8_BAR; }
    PG8_BAR;
#undef PG8_SA
#undef PG8_SB
#undef PG8_STAGE
#undef PG8_STAGE_A
#undef PG8_LDA
#undef PG8_LDB
#undef PG8_MMA
#undef PG8_WAIT_V
#undef PG8_WAIT_L
#undef PG8_BAR
#undef PG8_SCHED
#undef PG8_ROWOFF
}

template <class Epi, class Sched, bool ALIGN_EPI, bool GATHER>
__device__ __forceinline__ void gemm_phase8(PG8_LAS unsigned char* lds, const Gemm g, const Sched& S, const Epi& E, const PG8_LAS int* rowtab) {
    int tid_ = threadIdx.x; asm volatile("" : "+v"(tid_));
    const int tid = tid_, wid = __builtin_amdgcn_readfirstlane(tid >> 6), lane = tid & 63, wr = wid >> 2, wc = wid & 3, fr = lane & 15, fq = lane >> 4;
    int K_ = g.K; asm volatile("" : "+s"(K_));
    const int K = K_, nt = K / 128, lda = g.lda;
    unsigned voffA[2], voffB[2]; int RA[2]; unsigned CA2[2];
#pragma unroll
    for (int i = 0; i < 2; ++i) { const int u = tid * 16 + i * 8192; const int R = 16 * (u >> 11) + ((u & 1023) >> 6), J = 4 * ((u >> 10) & 1) + (((u & 63) >> 4) ^ ((R >> 2) & 3)); const int Rb = Epi::WIDE ? (64 * (R >> 5) + perm32(R & 31)) : Epi::PERM ? ((R & ~31) + perm32(R & 31)) : R;
        voffA[i] = (unsigned)(R * lda + J * 16); voffB[i] = (unsigned)(Rb * K + J * 16); RA[i] = R; CA2[i] = (unsigned)(J * 16); }
    const size_t kstep = (size_t)128;
    const size_t hstepA = (size_t)HALF * lda, tstepA = 2 * hstepA;
    const size_t hstepB = (size_t)(Epi::WIDE ? 32 : HALF) * K, tstepB = (size_t)2 * HALF * K;
    const unsigned ldsw = (unsigned)wid * 1024u;
    const int aoff0 = wr * 8192 + fr * 64 + 16 * (fq ^ ((fr >> 2) & 3)), boff0 = wc * 4096 + fr * 64 + 16 * (fq ^ ((fr >> 2) & 3));
    unsigned va[2][2], vn[2][2];
#define PG8_SA(b, h) (((b) * 2 + (h)) * HTB)
#define PG8_SB(b, h) ((4 + (b) * 2 + (h)) * HTB)
#define PG8_STAGE(bufoff, gbase, voff) do { _Pragma("unroll") for (int _i = 0; _i < 2; ++_i) \
        __builtin_amdgcn_global_load_lds((const unsigned*)((const char*)(gbase) + (voff)[_i]), (PG8_LAS unsigned*)(lds + (bufoff) + ldsw + _i * 8192), 16, 0, 0); } while (0)
#define PG8_STAGE_A(bufoff, gbase, h, NXT) do { if constexpr (GATHER) { unsigned o_[2]; o_[0] = (NXT) ? vn[h][0] : va[h][0]; o_[1] = (NXT) ? vn[h][1] : va[h][1]; PG8_STAGE(bufoff, gbase, o_); } \
        else { PG8_STAGE(bufoff, (gbase) + (h) * hstepA, voffA); } } while (0)
#define PG8_LDA(dst, b, h) do { _Pragma("unroll") for (int m = 0; m < 4; ++m) { const v4i32 lo_ = *(const PG8_LAS v4i32*)(lds + PG8_SA(b, h) + aoff0 + m * 2048), hi_ = *(const PG8_LAS v4i32*)(lds + PG8_SA(b, h) + aoff0 + m * 2048 + 1024); dst[m] = __builtin_shufflevector(lo_, hi_, 0, 1, 2, 3, 4, 5, 6, 7); } } while (0)
#define PG8_LDB(dst, b, h) do { _Pragma("unroll") for (int n = 0; n < 2; ++n) { const v4i32 lo_ = *(const PG8_LAS v4i32*)(lds + PG8_SB(b, h) + boff0 + n * 2048), hi_ = *(const PG8_LAS v4i32*)(lds + PG8_SB(b, h) + boff0 + n * 2048 + 1024); dst[n] = __builtin_shufflevector(lo_, hi_, 0, 1, 2, 3, 4, 5, 6, 7); } } while (0)
#define PG8_F8(F_) ((v8i32){(int)F_[0][0], (int)F_[0][1], (int)F_[0][2], (int)F_[0][3], (int)F_[1][0], (int)F_[1][1], (int)F_[1][2], (int)F_[1][3]})
#define PG8_MMA(ai, bj, At, Bt) do { __builtin_amdgcn_s_setprio(1); _Pragma("unroll") for (int m = 0; m < 4; ++m) _Pragma("unroll") for (int n = 0; n < 2; ++n) \
        asm volatile("v_mfma_scale_f32_16x16x128_f8f6f4 %0, %1, %2, %0, %3, %4 op_sel_hi:[0,0,0]" : "+v"(acc[ai][bj][m][n]) : "v"(Bt[n]), "v"(At[m]), "v"(sclw_), "v"(scl_));     __builtin_amdgcn_s_setprio(0); } while (0)
#define PG8_WAIT_V(n) asm volatile("s_waitcnt vmcnt(" #n ")" ::: "memory")
#define PG8_WAIT_L(n) asm volatile("s_waitcnt lgkmcnt(" #n ")" ::: "memory")
#define PG8_BAR __builtin_amdgcn_s_barrier()
#define PG8_SCHED __builtin_amdgcn_sched_barrier(0)
#define PG8_ROWOFF(dst, ui_) do { _Pragma("unroll") for (int h_ = 0; h_ < 2; ++h_) _Pragma("unroll") for (int i_ = 0; i_ < 2; ++i_) \
        dst[h_][i_] = (unsigned)rowtab[(ui_) * 256 + h_ * 128 + RA[i_]] * (unsigned)lda + CA2[i_]; } while (0)
    Unit cur, nxt; int ui = 0;
    if (!S.next(0, cur)) return;
    int scl_ = g.ascale, sclw_ = 0x7A7A7A7A; asm volatile("" : "+v"(scl_), "+v"(sclw_));
    float z_ = 0.f; asm volatile("" : "+v"(z_));
    f32x4 acc[2][2][4][2];
#pragma unroll
    for (int a = 0; a < 2; ++a)
#pragma unroll
        for (int b = 0; b < 2; ++b)
#pragma unroll
            for (int m = 0; m < 4; ++m)
#pragma unroll
                for (int n = 0; n < 2; ++n) acc[a][b][m][n] = (f32x4){z_, z_, z_, z_};
    v8i32 At[4], B0[2], B1[2];
    const char* cA = (const char*)g.A + (GATHER ? (size_t)0 : (size_t)cur.pm * tstepA); const char* cB = (const char*)g.Bt + (size_t)cur.bt * tstepB;
    if constexpr (GATHER) { PG8_ROWOFF(va, 0); }
    PG8_STAGE(PG8_SB(0, 0), cB, voffB); PG8_STAGE(PG8_SB(0, 1), cB + hstepB, voffB); PG8_STAGE_A(PG8_SA(0, 0), cA, 0, false); PG8_STAGE_A(PG8_SA(0, 1), cA, 1, false);
    if (wr == 1) PG8_BAR;
    PG8_WAIT_V(2); PG8_BAR;
    PG8_STAGE(PG8_SB(1, 0), cB + kstep, voffB); PG8_STAGE_A(PG8_SA(1, 0), cA + kstep, 0, false); PG8_STAGE(PG8_SB(1, 1), cB + hstepB + kstep, voffB);
    PG8_WAIT_V(6); PG8_BAR;
    for (;;) {
        const bool has_next = S.next(ui + 1, nxt);
        const char* nA = has_next ? (const char*)g.A + (GATHER ? (size_t)0 : (size_t)nxt.pm * tstepA) : cA; const char* nB = has_next ? (const char*)g.Bt + (size_t)nxt.bt * tstepB : cB;
        asm volatile("" : "+s"(nB));
        if constexpr (GATHER) { if (has_next) { PG8_ROWOFF(vn, ui + 1); } else {
#pragma unroll
            for (int h_ = 0; h_ < 2; ++h_)
#pragma unroll
                for (int i_ = 0; i_ < 2; ++i_) vn[h_][i_] = va[h_][i_]; } }
#pragma unroll 1
        for (int t = 0; t < nt; t += 2) {
            const bool last = (t == nt - 2);
            const char* a1 = cA + (size_t)(t + 1) * kstep;
            const char* a2 = last ? nA : cA + (size_t)(t + 2) * kstep; const char* b2 = last ? nB : cB + (size_t)(t + 2) * kstep;
            const char* a3 = a2 + kstep; const char* b3 = b2 + kstep;
            PG8_LDB(B0, 0, 0); PG8_LDB(B1, 0, 1); PG8_SCHED; PG8_LDA(At, 0, 0); PG8_STAGE_A(PG8_SA(1, 1), a1, 1, false);
            PG8_WAIT_V(8); PG8_WAIT_L(0); PG8_BAR; PG8_MMA(0, 0, At, B0); PG8_MMA(0, 1, At, B1); PG8_BAR; PG8_SCHED;
            PG8_LDA(At, 0, 1); PG8_STAGE(PG8_SB(0, 0), b2, voffB); PG8_STAGE(PG8_SB(0, 1), b2 + hstepB, voffB); PG8_STAGE_A(PG8_SA(0, 0), a2, 0, last);
            PG8_WAIT_V(8); PG8_WAIT_L(0); PG8_BAR; PG8_MMA(1, 0, At, B0); PG8_MMA(1, 1, At, B1); PG8_BAR; PG8_SCHED;
            PG8_LDB(B0, 1, 0); PG8_LDB(B1, 1, 1); PG8_SCHED; PG8_LDA(At, 1, 0); PG8_STAGE_A(PG8_SA(0, 1), a2, 1, last);
            PG8_WAIT_V(8); PG8_WAIT_L(0); PG8_BAR; PG8_MMA(0, 0, At, B0); PG8_MMA(0, 1, At, B1); PG8_BAR; PG8_SCHED;
            PG8_LDA(At, 1, 1); PG8_STAGE(PG8_SB(1, 0), b3, voffB); PG8_STAGE(PG8_SB(1, 1), b3 + hstepB, voffB); PG8_STAGE_A(PG8_SA(1, 0), a3, 0, last);
            PG8_WAIT_V(8); PG8_WAIT_L(0); PG8_BAR; PG8_MMA(1, 0, At, B0); PG8_MMA(1, 1, At, B1); PG8_BAR; PG8_SCHED;
        }
        if constexpr (ALIGN_EPI) { if (wr == 0) PG8_BAR; }
        asm volatile("s_nop 15\n\ts_nop 7" ::: "memory");
        E(acc, cur, wr, wc, fr, fq);
        if (!has_next) break;
#pragma unroll
        for (int a = 0; a < 2; ++a)
#pragma unroll
            for (int b = 0; b < 2; ++b)
#pragma unroll
                for (int m = 0; m < 4; ++m)
#pragma unroll
                    for (int n = 0; n < 2; ++n) acc[a][b][m][n] = (f32x4){z_, z_, z_, z_};
        cur = nxt; cA = nA; cB = nB; ++ui;
        if constexpr (GATHER) {
#pragma unroll
            for (int h_ = 0; h_ < 2; ++h_)
#pragma unroll
                for (int i_ = 0; i_ < 2; ++i_) va[h_][i_] = vn[h_][i_]; }
        if constexpr (ALIGN_EPI) { if (wr == 1) PG8_BAR; }
    }
    PG8_WAIT_V(0);
    if constexpr (!ALIGN_EPI) { if (wr == 0) PG8_BAR; }
    PG8_BAR;
#undef PG8_SA
#undef PG8_SB
#undef PG8_STAGE
#undef PG8_STAGE_A
#undef PG8_LDA
#undef PG8_LDB
#undef PG8_MMA
#undef PG8_WAIT_V
#undef PG8_WAIT_L
#undef PG8_BAR
#undef PG8_SCHED
#undef PG8_ROWOFF
#undef PG8_F8
}


typedef const f32x4 (&AccRef)[2][2][4][2];
#define EPI_ROWS(...) _Pragma("unroll") for (int ai = 0; ai < 2; ++ai) _Pragma("unroll") for (int m = 0; m < 4; ++m) { const int row = u.pm * BM + ai * HALF + wr * 64 + m * 16 + fr; __VA_ARGS__ }

template <bool F8> struct EpiInproj {
    static constexpr bool PERM = true, WIDE = !F8;
    unsigned char* ws;
    __device__ __forceinline__ void operator()(AccRef acc, const Unit& u, int wr, int wc, int fr, int fq) const {
        if constexpr (F8) {
            unsigned char* gb = ws + WS_G + (size_t)(u.pn * 256 + wc * 32 + 8 * fq);
            EPI_ROWS(
                unsigned char* rp = gb + (size_t)row * 2048;
                _Pragma("unroll") for (int bj = 0; bj < 2; ++bj) *(u32x2*)(rp + bj * HALF) = pack8_fp8(acc[ai][bj][m][0], acc[ai][bj][m][1]);
            )
            return;
        }
        const int pn = u.pn; const bool odd = fr & 1;
#if G_FP8
        if (pn >= 8) {
            unsigned char* gb = ws + WS_G + (size_t)((pn - 8) * 256 + wc * 64 + 8 * fq + (odd ? 32 : 0));
            EPI_ROWS(
                const u32x2 x0 = pack8_fp8(acc[ai][0][m][0], acc[ai][0][m][1]), x1 = pack8_fp8(acc[ai][1][m][0], acc[ai][1][m][1]);
                const u32x2 snd = odd ? x0 : x1; u32x2 rcv; rcv.x = lane_xor1(snd.x); rcv.y = lane_xor1(snd.y);
                unsigned char* rp = gb + (size_t)(row & ~1) * 2048;
                *(u32x2*)rp = odd ? rcv : x0; *(u32x2*)(rp + 2048) = odd ? x1 : rcv;
            )
            return;
        }
#endif
        const size_t off = pn < 6 ? WS_QF + (size_t)(pn >> 1) * (WS_KF - WS_QF) : pn < 8 ? WS_QL : WS_G;
        const int ld = pn < 8 ? 512 : 2048, col0 = (pn < 6 ? (pn & 1) : pn < 8 ? (pn - 6) : (pn - 8)) * 256 + wc * 64 + 8 * fq + (odd ? 32 : 0);
        const float sc = (pn < 2 ? C2F : 1.f);
        bf16_t* base = (bf16_t*)(ws + off) + col0;
        EPI_ROWS(
            const u32x4 x0 = pack8(acc[ai][0][m][0] * sc, acc[ai][0][m][1] * sc), x1 = pack8(acc[ai][1][m][0] * sc, acc[ai][1][m][1] * sc);
            const u32x4 snd = odd ? x0 : x1; u32x4 rcv; rcv.x = lane_xor1(snd.x); rcv.y = lane_xor1(snd.y); rcv.z = lane_xor1(snd.z); rcv.w = lane_xor1(snd.w);
            bf16_t* rp = base + (size_t)(row & ~1) * ld;
            *(u32x4*)rp = odd ? rcv : x0; *(u32x4*)(rp + ld) = odd ? x1 : rcv;
        )
    }
};
struct EpiQup {
    static constexpr bool PERM = true, WIDE = false;
    bf16_t* QM; const float *SSQ, *CS;
    __device__ __forceinline__ void operator()(AccRef acc, const Unit& u, int wr, int wc, int fr, int fq) const {
        const int pn = u.pn;
        if (pn < 2) {
            EPI_ROWS(
                const float rs = C2M * SSQ[(size_t)row * 2];
                _Pragma("unroll") for (int bj = 0; bj < 2; ++bj) { const int c = pn * 256 + bj * HALF + wc * 32 + 8 * fq, h = c >> 6, d = c & 63;
                    *(u32x4*)(QM + (size_t)row * 768 + h * 96 + d) = pack8(acc[ai][bj][m][0] * rs, acc[ai][bj][m][1] * rs); }
            )
        } else {
            const float sgn = (fq < 2) ? -1.f : 1.f;
            EPI_ROWS(
                const float rs = C2M * SSQ[(size_t)row * 2];
                const float* cs = CS + (size_t)row * 32 + ((8 * fq) & 15);
                f32x4 c0 = *(const f32x4*)(cs) * rs, c1 = *(const f32x4*)(cs + 4) * rs, s0 = *(const f32x4*)(cs + 16) * (rs * sgn), s1 = *(const f32x4*)(cs + 20) * (rs * sgn);
                _Pragma("unroll") for (int bj = 0; bj < 2; ++bj) { const int h = 4 * bj + wc; f32x4 o0, o1;
                    _Pragma("unroll") for (int i = 0; i < 4; ++i) {
                        const float v0 = acc[ai][bj][m][0][i], v1 = acc[ai][bj][m][1][i]; const float p0 = __shfl_xor(v0, 32), p1 = __shfl_xor(v1, 32);
                        o0[i] = v0 * c0[i] + p0 * s0[i]; o1[i] = v1 * c1[i] + p1 * s1[i]; }
                    *(u32x4*)(QM + (size_t)row * 768 + h * 96 + 64 + 8 * fq) = pack8(o0, o1); }
            )
        }
    }
};
struct EpiKvup {
    static constexpr bool PERM = true, WIDE = false;
    bf16_t* KN; const float* SSQ;
    __device__ __forceinline__ void operator()(AccRef acc, const Unit& u, int wr, int wc, int fr, int fq) const {
        bf16_t* base = KN + (size_t)(u.pn >> 1) * ((WS_VM - WS_KN) / 2) + (u.pn & 1) * 256 + wc * 32 + 8 * fq;
        EPI_ROWS(
            const float rs = SSQ[(size_t)row * 2 + 1];
            _Pragma("unroll") for (int bj = 0; bj < 2; ++bj) *(u32x4*)(base + (size_t)row * 512 + bj * HALF) = pack8(acc[ai][bj][m][0] * rs, acc[ai][bj][m][1] * rs);
        )
    }
};
template <int STEP> struct EpiMerge {
    static constexpr bool PERM = true, WIDE = true;
    bf16_t *T0, *MG; const bf16_t* G; const float* b_merge;
    __device__ __forceinline__ void operator()(AccRef acc, const Unit& u, int wr, int wc, int fr, int fq) const {
        const int c0 = u.pn * 256 + wc * 64 + 8 * fq; const bool odd = fr & 1;
        f32x4 bm[2][2];
        _Pragma("unroll") for (int bj = 0; bj < 2; ++bj) { bm[bj][0] = *(const f32x4*)(b_merge + STEP * 1024 + c0 + bj * 32); bm[bj][1] = *(const f32x4*)(b_merge + STEP * 1024 + c0 + bj * 32 + 4); }
        _Pragma("unroll") for (int ai = 0; ai < 2; ++ai) {
            u32x4 tv[4][2];
#if G_FP8
            u32x2 gv[4][2];
#else
            u32x4 gv[4][2];
#endif
            _Pragma("unroll") for (int m = 0; m < 4; ++m) _Pragma("unroll") for (int bj = 0; bj < 2; ++bj) { const size_t row = (size_t)(u.pm * BM + ai * HALF + wr * 64 + m * 16 + fr);
#if G_FP8
                gv[m][bj] = *(const u32x2*)((const unsigned char*)G + row * 2048 + STEP * 1024 + c0 + bj * 32);
#else
                gv[m][bj] = *(const u32x4*)(G + row * 2048 + STEP * 1024 + c0 + bj * 32);
#endif
                if (STEP == 1) tv[m][bj] = *(const u32x4*)(T0 + row * 1024 + c0 + bj * 32); }
            _Pragma("unroll") for (int m = 0; m < 4; ++m) { const size_t row = (size_t)(u.pm * BM + ai * HALF + wr * 64 + m * 16 + fr); u32x4 xo[2];
              _Pragma("unroll") for (int bj = 0; bj < 2; ++bj) {
                const f32x4 bm0 = bm[bj][0], bm1 = bm[bj][1];
                f32x4 a = acc[ai][bj][m][0], b = acc[ai][bj][m][1];
#if G_FP8
                { const u32x2 g = gv[m][bj];
                  const f32x2 g01 = __builtin_amdgcn_cvt_pk_f32_fp8((int)g.x, false), g23 = __builtin_amdgcn_cvt_pk_f32_fp8((int)g.x, true), g45 = __builtin_amdgcn_cvt_pk_f32_fp8((int)g.y, false), g67 = __builtin_amdgcn_cvt_pk_f32_fp8((int)g.y, true);
                  const f32x2 s01 = fsigmoid2(g01 + (f32x2){bm0[0], bm0[1]}), s23 = fsigmoid2(g23 + (f32x2){bm0[2], bm0[3]}), s45 = fsigmoid2(g45 + (f32x2){bm1[0], bm1[1]}), s67 = fsigmoid2(g67 + (f32x2){bm1[2], bm1[3]});
                  const f32x2 a01 = (f32x2){a[0], a[1]} * s01, a23 = (f32x2){a[2], a[3]} * s23, b01 = (f32x2){b[0], b[1]} * s45, b23 = (f32x2){b[2], b[3]} * s67;
                  a = (f32x4){a01.x, a01.y, a23.x, a23.y}; b = (f32x4){b01.x, b01.y, b23.x, b23.y}; }
#else
                const u32x4 g = gv[m][bj];
                a[0] *= fsigmoid(bflo(g.x) + bm0[0]); a[1] *= fsigmoid(bfhi(g.x) + bm0[1]); a[2] *= fsigmoid(bflo(g.y) + bm0[2]); a[3] *= fsigmoid(bfhi(g.y) + bm0[3]);
                b[0] *= fsigmoid(bflo(g.z) + bm1[0]); b[1] *= fsigmoid(bfhi(g.z) + bm1[1]); b[2] *= fsigmoid(bflo(g.w) + bm1[2]); b[3] *= fsigmoid(bfhi(g.w) + bm1[3]);
#endif
                if (STEP == 1) { const u32x4 t = tv[m][bj];
                    a[0] += bflo(t.x); a[1] += bfhi(t.x); a[2] += bflo(t.y); a[3] += bfhi(t.y); b[0] += bflo(t.z); b[1] += bfhi(t.z); b[2] += bflo(t.w); b[3] += bfhi(t.w);
#if WO_FP8
                    { _Pragma("unroll") for (int i = 0; i < 4; ++i) { a[i] = fminf(fmaxf(a[i] * 16.f, -448.f), 448.f); b[i] = fminf(fmaxf(b[i] * 16.f, -448.f), 448.f); }
                      const u32x2 q8 = pack8_fp8(a, b); xo[bj] = (u32x4){q8.x, q8.y, 0u, 0u}; } }
#else
                    xo[bj] = pack8(a, b); }
#endif
                else xo[bj] = pack8(a, b); }
#if WO_FP8
              if (STEP == 1) { const u32x2 s2 = odd ? (u32x2){xo[0].x, xo[0].y} : (u32x2){xo[1].x, xo[1].y}; u32x2 r2; r2.x = lane_xor1(s2.x); r2.y = lane_xor1(s2.y);
                unsigned char* rp = (unsigned char*)MG + (row & ~(size_t)1) * 1024 + c0 + (odd ? 32 : 0);
                *(u32x2*)rp = odd ? r2 : (u32x2){xo[0].x, xo[0].y}; *(u32x2*)(rp + 1024) = odd ? (u32x2){xo[1].x, xo[1].y} : r2; } else
#endif
              { const u32x4 snd = odd ? xo[0] : xo[1]; u32x4 rcv; rcv.x = lane_xor1(snd.x); rcv.y = lane_xor1(snd.y); rcv.z = lane_xor1(snd.z); rcv.w = lane_xor1(snd.w);
                bf16_t* rp = (STEP == 1 ? MG : T0) + (row & ~(size_t)1) * 1024 + c0 + (odd ? 32 : 0);
                *(u32x4*)rp = odd ? rcv : xo[0]; *(u32x4*)(rp + 1024) = odd ? xo[1] : rcv; } }
        }
    }
};
template <int MB> struct EpiWoT {
    static constexpr bool PERM = true, WIDE = (MB == 2);
    const float* x; bf16_t* X1;
    __device__ __forceinline__ void operator()(AccRef acc, const Unit& u, int wr, int wc, int fr, int fq) const {
        if constexpr (MB == 1) {
            const int c0 = u.pn * 256 + wc * 32 + 8 * fq;
            EPI_ROWS(
                const float* xl = x + (size_t)row * 1024 + c0; asm volatile("" : "+v"(xl));
                _Pragma("unroll") for (int bj = 0; bj < 2; ++bj) { const f32x4 xa = *(const f32x4*)(xl + bj * HALF), xb = *(const f32x4*)(xl + bj * HALF + 4);
                    *(u32x4*)(X1 + (size_t)row * 1024 + c0 + bj * HALF) = pack8(xa + acc[ai][bj][m][0], xb + acc[ai][bj][m][1]); }
            )
        } else {
        const int c0 = u.pn * 256 + wc * 64 + 8 * fq; const bool odd = fr & 1;
        _Pragma("unroll") for (int ai = 0; ai < 2; ++ai) _Pragma("unroll") for (int mh = 0; mh < 2; ++mh) {
            f32x4 xv[2][2][2];
            _Pragma("unroll") for (int mm = 0; mm < 2; ++mm) _Pragma("unroll") for (int bj = 0; bj < 2; ++bj) { const size_t off = (size_t)(u.pm * BM + ai * HALF + wr * 64 + (2 * mh + mm) * 16 + fr) * 1024 + c0 + bj * 32;
                xv[mm][bj][0] = *(const f32x4*)(x + off); xv[mm][bj][1] = *(const f32x4*)(x + off + 4); }
            _Pragma("unroll") for (int mm = 0; mm < 2; ++mm) { const int m = 2 * mh + mm; const size_t row = (size_t)(u.pm * BM + ai * HALF + wr * 64 + m * 16 + fr);
                const u32x4 x0 = pack8(xv[mm][0][0] + acc[ai][0][m][0], xv[mm][0][1] + acc[ai][0][m][1]), x1 = pack8(xv[mm][1][0] + acc[ai][1][m][0], xv[mm][1][1] + acc[ai][1][m][1]);
                const u32x4 snd = odd ? x0 : x1; u32x4 rcv; rcv.x = lane_xor1(snd.x); rcv.y = lane_xor1(snd.y); rcv.z = lane_xor1(snd.z); rcv.w = lane_xor1(snd.w);
                bf16_t* rp = X1 + (row & ~(size_t)1) * 1024 + c0 + (odd ? 32 : 0);
                *(u32x4*)rp = odd ? rcv : x0; *(u32x4*)(rp + 1024) = odd ? x1 : rcv; }
        }
        }
    }
};
#if WO_FP8
typedef EpiWoT<1> EpiWo;
#else
typedef EpiWoT<2> EpiWo;
#endif
template <bool F8> struct EpiSwiglu {
    static constexpr bool PERM = true, WIDE = false;
    bf16_t* ACT; const float* b_gu; const PG8_LAS unsigned short* biasL;
    __device__ __forceinline__ void operator()(AccRef acc, const Unit& u, int wr, int wc, int fr, int fq) const {
        const int c = u.pn * 128 + wc * 32 + 8 * fq; const float sc = 1.f;
        f32x4 g0, g1, u0, u1;
        if constexpr (F8) { const PG8_LAS unsigned short* bl = biasL + u.ui * 256 + wc * 32 + 8 * fq; const u32x4 gw = *(const PG8_LAS u32x4*)bl, uw = *(const PG8_LAS u32x4*)(bl + 128);
            g0 = (f32x4){bflo(gw.x), bfhi(gw.x), bflo(gw.y), bfhi(gw.y)}; g1 = (f32x4){bflo(gw.z), bfhi(gw.z), bflo(gw.w), bfhi(gw.w)};
            u0 = (f32x4){bflo(uw.x), bfhi(uw.x), bflo(uw.y), bfhi(uw.y)}; u1 = (f32x4){bflo(uw.z), bfhi(uw.z), bflo(uw.w), bfhi(uw.w)}; }
        else { const float* bg = b_gu + (size_t)u.e * 2048 + c; g0 = *(const f32x4*)(bg); g1 = *(const f32x4*)(bg + 4); u0 = *(const f32x4*)(bg + 1024); u1 = *(const f32x4*)(bg + 1028); }
        EPI_ROWS(
            f32x4 ga = acc[ai][0][m][0] * sc + g0, gb = acc[ai][0][m][1] * sc + g1, ua = acc[ai][1][m][0] * sc + u0, ub = acc[ai][1][m][1] * sc + u1, oa, ob;
            _Pragma("unroll") for (int i = 0; i < 4; ++i) {
                const f32x2 x = (f32x2){fminf(ga[i], 7.f), fminf(gb[i], 7.f)}, y = (f32x2){fminf(fmaxf(ua[i], -7.f), 7.f), fminf(fmaxf(ub[i], -7.f), 7.f)};
                const f32x2 r = (y + 1.f) * x * fsigmoid2(x * 1.702f);
                oa[i] = r.x; ob[i] = r.y; }
            if (F8) *(u32x2*)((unsigned char*)ACT + (size_t)row * 1024 + c) = pack8_fp8(oa, ob);
            else *(u32x4*)(ACT + (size_t)row * 1024 + c) = pack8(oa, ob);
        )
    }
};
template <bool F8> struct EpiDown {
    static constexpr bool PERM = true, WIDE = false;
    bf16_t* Z; const float* b_down; const int* ROWSLOT; const float* ROWW; const volatile PG8_LAS int* cntL; const volatile PG8_LAS int* bst;
    __device__ __forceinline__ void operator()(AccRef acc, const Unit& u, int wr, int wc, int fr, int fq) const {
        const int c0 = u.pn * 256 + wc * 32 + 8 * fq; const float* bd = b_down + (size_t)u.e * 1024 + c0; const float sc = 1.f;
#if FUSED_ROWS
        const int eb = u.e * ESTR + ((u.pm - bst[u.e]) << 8) - u.pm * BM;
#endif
        f32x4 bv[2][2];
        _Pragma("unroll") for (int bj = 0; bj < 2; ++bj) _Pragma("unroll") for (int n = 0; n < 2; ++n) bv[bj][n] = *(const f32x4*)(bd + bj * HALF + 4 * n);
        EPI_ROWS(
#if FUSED_ROWS
            const int slot = ROWSLOT[eb + row]; const float w = ROWW[eb + row];
#else
            const int slot = ROWSLOT[row]; const float w = ROWW[row];
#endif
#if Z_FP8
            const float w16 = w * 16.f;
            _Pragma("unroll") for (int bj = 0; bj < 2; ++bj)
                { f32x4 za = (acc[ai][bj][m][0] * sc + bv[bj][0]) * w16, zb = (acc[ai][bj][m][1] * sc + bv[bj][1]) * w16;
                    _Pragma("unroll") for (int i = 0; i < 4; ++i) { za[i] = fminf(fmaxf(za[i], -448.f), 448.f); zb[i] = fminf(fmaxf(zb[i], -448.f), 448.f); }
                    *(u32x2*)((unsigned char*)Z + (size_t)slot * 1024 + c0 + bj * HALF) = pack8_fp8(za, zb); }
#else
            _Pragma("unroll") for (int bj = 0; bj < 2; ++bj)
                *(u32x4*)(Z + (size_t)slot * 1024 + c0 + bj * HALF) = pack8((acc[ai][bj][m][0] * sc + bv[bj][0]) * w, (acc[ai][bj][m][1] * sc + bv[bj][1]) * w);
#endif
        )
    }
};
#undef EPI_ROWS
}

namespace att {
constexpr int KB_OFF = 0, K_OFF = 16384, KSLOT = 12288, V_OFF = K_OFF + 2 * KSLOT, VSLOT = 8192, OST_OFF = V_OFF + 2 * VSLOT, OST_W = 4608, ATT_LDS = OST_OFF + 8 * OST_W + 64;
constexpr int BG_STAGE_OFF = 96 * 1024;
static_assert(ATT_LDS <= BG_STAGE_OFF && BG_STAGE_OFF + 32768 <= RING_BYTES, "attention LDS");
typedef short v4i16_t __attribute__((ext_vector_type(4)));
__device__ __forceinline__ s16x4 vtr(const LAS unsigned char* p) { return __builtin_bit_cast(s16x4, __builtin_amdgcn_ds_read_tr16_b64_v4i16((LAS v4i16_t*)p)); }
__device__ __forceinline__ float xor32(float v) { return __shfl_xor(v, 32); }
__device__ __forceinline__ void glds16(const void* gsrc, unsigned lds_dst) { unsigned keep;
    asm volatile("s_mov_b32 %0, m0\n\ts_mov_b32 m0, %2\n\ts_nop 0\n\tglobal_load_lds_dwordx4 %1, off\n\ts_mov_b32 m0, %0" : "=&s"(keep) : "v"(gsrc), "s"(lds_dst) : "memory"); }

template <int DQ, bool FOX, class CV>
__device__ __forceinline__ void attn_unit(CV& cv, LAS unsigned char* lds, int b, int h, int qb, const bf16* Q, const bf16* K, const bf16* KP, const bf16* V, const float* KBg, bf16* O, float kmax2) {
    constexpr int QP = FOX ? 512 : 768, ND = DQ / 16;
    int tid_ = threadIdx.x; asm volatile("" : "+v"(tid_));
    const int tid = tid_, lane = tid & 63, r32 = lane & 31, hi = lane >> 5; const int wid = __builtin_amdgcn_readfirstlane(tid >> 6);
    const size_t rowbase = (size_t)b * SEQ; const int q0 = qb * 256, NT = q0 / 64 + 4, qw0 = q0 + 32 * wid, my_last = (qw0 + 31) >> 6;
    if (FOX) { const f32x4* src = (const f32x4*)(KBg + (size_t)(b * 8 + h) * SEQ); LAS f32x4* dst = (LAS f32x4*)(lds + KB_OFF);
        for (int i = tid; i < NT * 16; i += 512) dst[i] = src[i]; }
    bf16x8 qr[ND];
    { const bf16* Qw = Q + (rowbase + qw0 + r32) * QP + h * DQ + hi * 8;
#pragma unroll
      for (int d0 = 0; d0 < ND; ++d0) qr[d0] = *(const bf16x8*)(Qw + d0 * 16);
#pragma unroll
      for (int d0 = 0; d0 < ND; ++d0) asm volatile("" : "+v"(qr[d0])); }
    const bf16* ksrc = K + (rowbase + lane) * 512 + h * 64 + wid * 8;
    const bf16* kpsrc = KP + (rowbase + lane) * 32 + (wid & 3) * 8;
    const bf16* vsrc = V + (rowbase + 16 * (wid & 3) + (lane >> 2)) * 512 + h * 64 + (wid >> 2) * 32 + (lane & 3) * 8;
    const unsigned ldsb = (unsigned)(size_t)lds;
#define ATT_ISSUE(t, buf) do { \
        glds16(ksrc + (size_t)(t) * 64 * 512, (unsigned)__builtin_amdgcn_readfirstlane(ldsb + K_OFF + (buf) * KSLOT + wid * 1024)); \
        if (DQ > 64 && wid < 4) glds16(kpsrc + (size_t)(t) * 64 * 32, (unsigned)__builtin_amdgcn_readfirstlane(ldsb + K_OFF + (buf) * KSLOT + (8 + wid) * 1024)); \
        glds16(vsrc + (size_t)(t) * 64 * 512, (unsigned)__builtin_amdgcn_readfirstlane(ldsb + V_OFF + (buf) * VSLOT + wid * 1024)); } while (0)
    float m = 0.f, l = 0.f; f32x16 o0 = {}, o1 = {}, negm = {};
    float bq = 0.f; bool wdone = false;
    volatile LAS int* dflag = (volatile LAS int*)(lds + OST_OFF + 8 * OST_W);
    if (FOX) {
        float qs = 0.f;
#pragma unroll
        for (int d0 = 0; d0 < ND; ++d0)
#pragma unroll
            for (int j = 0; j < 8; ++j) { const float v = bf2f((bf16)qr[d0][j]); qs += v * v; }
        qs += xor32(qs);
        bq = sqrtf(qs) * sqrtf(kmax2) + 1.f;
        if (lane == 0) dflag[wid] = 0x7fffffff;
    }
    ATT_ISSUE(NT - 1, 0);
    if (wid >= 4) __builtin_amdgcn_s_setprio(1);
    for (int it = 0; it < NT; ++it) {
        const int t = NT - 1 - it;
        const bool full = (it == 0) || !(cv.pend && cv.age == 0);
        if (full) VM_WAIT(); else asm volatile("s_waitcnt vmcnt(4)" ::: "memory");
        LDS_WAIT(); __builtin_amdgcn_s_barrier(); asm volatile("" ::: "memory");
        if (FOX && it > 0) { int mxf = 0;
#pragma unroll
            for (int w8 = 0; w8 < 8; ++w8) mxf = max(mxf, dflag[w8]);
            if (mxf < it) break; }
        if (cv.pend) { if (full) cv.consume(lane); else cv.age = 1; }
        if (it + 1 < NT) ATT_ISSUE(t - 1, (it + 1) & 1);
        if (!FOX && !cv.pend) cv.issue(lane);
        __builtin_amdgcn_sched_barrier(0);
        if (t <= my_last && !wdone) {
            const LAS unsigned char* Kb = lds + K_OFF + (it & 1) * KSLOT + hi * 1024 + r32 * 16;
            const LAS unsigned char* vp = lds + V_OFF + (it & 1) * VSLOT + ((lane >> 4) & 1) * 32 + (lane & 3) * 8 + (4 * hi + ((lane & 15) >> 2)) * 64;
            bf16x8 kf[2 * ND]; s16x4 vt[16];
#pragma unroll
            for (int d0 = 0; d0 < ND; ++d0) { kf[2 * d0] = *(const LAS bf16x8*)(Kb + d0 * 2048); kf[2 * d0 + 1] = *(const LAS bf16x8*)(Kb + d0 * 2048 + 512); }
            f32x16 p0, p1;
            if (FOX) {
                const LAS float* kbt = (const LAS float*)(lds + KB_OFF) + t * 64 + 4 * hi;
#pragma unroll
                for (int g = 0; g < 4; ++g) { const f32x4 a = *(const LAS f32x4*)(kbt + 8 * g), c = *(const LAS f32x4*)(kbt + 32 + 8 * g);
                    const f32x2 mm = (f32x2){m, m};
                    const f32x2 a01 = (f32x2){a[0], a[1]} - mm, a23 = (f32x2){a[2], a[3]} - mm, c01 = (f32x2){c[0], c[1]} - mm, c23 = (f32x2){c[2], c[3]} - mm;
                    p0[4 * g] = a01.x; p0[4 * g + 1] = a01.y; p0[4 * g + 2] = a23.x; p0[4 * g + 3] = a23.y; p1[4 * g] = c01.x; p1[4 * g + 1] = c01.y; p1[4 * g + 2] = c23.x; p1[4 * g + 3] = c23.y; }
            }
#pragma unroll
            for (int k = 0; k < 4; ++k) { vt[4 * k] = vtr(vp + k * 1024); vt[4 * k + 1] = vtr(vp + k * 1024 + 512); vt[4 * k + 2] = vtr(vp + 4096 + k * 1024); vt[4 * k + 3] = vtr(vp + 4096 + k * 1024 + 512); }
            __builtin_amdgcn_sched_barrier(0);
            if (!FOX) { p0 = negm; p1 = negm; }
#pragma unroll
            for (int d0 = 0; d0 < ND; ++d0) {
                p0 = __builtin_amdgcn_mfma_f32_32x32x16_bf16(kf[2 * d0], qr[d0], p0, 0, 0, 0); p1 = __builtin_amdgcn_mfma_f32_32x32x16_bf16(kf[2 * d0 + 1], qr[d0], p1, 0, 0, 0); }
            const bool first = (t == my_last);
            if (FOX && first) { const int qabs = qw0 + r32, kv0 = t * 64 + 4 * hi;
#pragma unroll
                for (int r = 0; r < 16; ++r) { const int kv = kv0 + (r & 3) + 8 * (r >> 2); if (kv > qabs) p0[r] = -INFINITY; if (kv + 32 > qabs) p1[r] = -INFINITY; } }
            asm volatile("s_nop 15\n\ts_nop 3" : "+v"(p0), "+v"(p1));
            float mx;
            asm("v_max_f32 %0, %1, %2" : "=v"(mx) : "v"(p0[0]), "v"(p1[0]));
#pragma unroll
            for (int r = 1; r < 16; ++r) asm("v_max3_f32 %0, %1, %2, %3" : "=v"(mx) : "v"(mx), "v"(p0[r]), "v"(p1[r]));
            mx = fmaxf(mx, xor32(mx));
            if (first || __any(mx > 6.f)) {
                const float dl = first ? mx : fmaxf(mx, 0.f), al = __builtin_amdgcn_exp2f(-dl);
                m += dl; l *= al;
#pragma unroll
                for (int r = 0; r < 16; ++r) { p0[r] -= dl; p1[r] -= dl; o0[r] *= al; o1[r] *= al; negm[r] = -m; }
            }
            float sum = 0.f;
#pragma unroll
            for (int r = 0; r < 16; ++r) { p0[r] = __builtin_amdgcn_exp2f(p0[r]); p1[r] = __builtin_amdgcn_exp2f(p1[r]); sum += p0[r] + p1[r]; }
            l += sum;
            u32x4 pw[4];
#pragma unroll
            for (int k = 0; k < 2; ++k) {
                pw[k] = (u32x4){cvt_pk_bf16(p0[8 * k], p0[8 * k + 1]), cvt_pk_bf16(p0[8 * k + 2], p0[8 * k + 3]), cvt_pk_bf16(p0[8 * k + 4], p0[8 * k + 5]), cvt_pk_bf16(p0[8 * k + 6], p0[8 * k + 7])};
                pw[2 + k] = (u32x4){cvt_pk_bf16(p1[8 * k], p1[8 * k + 1]), cvt_pk_bf16(p1[8 * k + 2], p1[8 * k + 3]), cvt_pk_bf16(p1[8 * k + 4], p1[8 * k + 5]), cvt_pk_bf16(p1[8 * k + 6], p1[8 * k + 7])}; }
#pragma unroll
            for (int k = 0; k < 4; ++k) {
                const s16x4 a0 = vt[4 * k], a1 = vt[4 * k + 1], c0 = vt[4 * k + 2], c1 = vt[4 * k + 3];
                const bf16x8 vf0 = (bf16x8){a0[0], a0[1], a0[2], a0[3], a1[0], a1[1], a1[2], a1[3]}, vf1 = (bf16x8){c0[0], c0[1], c0[2], c0[3], c1[0], c1[1], c1[2], c1[3]};
                const bf16x8 pk = __builtin_bit_cast(bf16x8, pw[k]);
                o0 = __builtin_amdgcn_mfma_f32_32x32x16_bf16(vf0, pk, o0, 0, 0, 0); o1 = __builtin_amdgcn_mfma_f32_32x32x16_bf16(vf1, pk, o1, 0, 0, 0); }
            if (FOX && t > 0) { const float kbn = ((const LAS float*)(lds + KB_OFF))[64 * t - 1];
                if (__all(bq + kbn - m <= -40.f)) { wdone = true; if (lane == 0) dflag[wid] = it; } }
        }
    }
#undef ATT_ISSUE
    __builtin_amdgcn_s_setprio(0);
    l += xor32(l); const float il = 1.f / l;
    LAS bf16* stg = (LAS bf16*)(lds + OST_OFF + wid * OST_W);
#pragma unroll
    for (int g = 0; g < 4; ++g) {
        u32x2 w0, w1; w0.x = cvt_pk_bf16(o0[4 * g] * il, o0[4 * g + 1] * il); w0.y = cvt_pk_bf16(o0[4 * g + 2] * il, o0[4 * g + 3] * il);
        w1.x = cvt_pk_bf16(o1[4 * g] * il, o1[4 * g + 1] * il); w1.y = cvt_pk_bf16(o1[4 * g + 2] * il, o1[4 * g + 3] * il);
        *(LAS u32x2*)(stg + r32 * 72 + 8 * g + 4 * hi) = w0; *(LAS u32x2*)(stg + r32 * 72 + 32 + 8 * g + 4 * hi) = w1; }
    LDS_WAIT();
    bf16* Ow = O + (rowbase + qw0) * 512 + h * 64;
#pragma unroll
    for (int i = 0; i < 4; ++i) { const int row = i * 8 + (lane >> 3), ch = lane & 7; const u32x4 v = *(const LAS u32x4*)(stg + row * 72 + ch * 8); *(u32x4*)(Ow + (size_t)row * 512 + ch * 8) = v; }
    __syncthreads();
}
}

#define XB_TMO      128
#define XB_XCNT(j)  (256  + 64 * (j))
#define XB_XSUB(j)  (1280 + 64 * (j))
#define XB_XGEN(j)  (2304 + 64 * (j))
#define XB_TOP      3328
#define XB_TOPGEN   3392
#define XCD_BAR_WORDS 3456
#define XB_SPIN_CAP (1u << 18)
__device__ __forceinline__ unsigned xb_ld(unsigned* p)              { return __hip_atomic_load(p, __ATOMIC_RELAXED, __HIP_MEMORY_SCOPE_AGENT); }
__device__ __forceinline__ unsigned xb_add(unsigned* p, unsigned v) { return __hip_atomic_fetch_add(p, v, __ATOMIC_RELAXED, __HIP_MEMORY_SCOPE_AGENT); }
__device__ __forceinline__ unsigned xb_xcc_id() { return (unsigned)__builtin_amdgcn_s_getreg((3 << 11) | 20) & 0xFu; }
#define XB_SPIN(cond, bar) do { unsigned _sp = 0; while (cond) { __builtin_amdgcn_s_sleep(1); \
    if ((++_sp & 255u) == 0u) { if (xb_ld(&(bar)[XB_TMO])) break; if (_sp > XB_SPIN_CAP) { atomicAdd(&(bar)[XB_TMO], 1u); break; } } } } while (0)
struct XcdBarrier { unsigned* bar; unsigned x; volatile LAS unsigned* st; };
__device__ __forceinline__ XcdBarrier xcd_barrier_post(unsigned* bar, volatile LAS unsigned* st) {
    XcdBarrier b; b.bar = bar; b.x = xb_xcc_id(); b.st = st;
    if (threadIdx.x == 0) (void)xb_add(&bar[XB_XCNT(b.x)], 1u);
    return b;
}
__device__ __forceinline__ void xcd_barrier_complete(unsigned* bar, unsigned x, unsigned& nloc, unsigned& nx) {
    const unsigned G = gridDim.x * gridDim.y * gridDim.z;
    unsigned sum, cnt, mine, sp = 0u;
    for (;;) {
        sum = 0u; cnt = 0u; mine = 0u;
#pragma unroll
        for (unsigned j = 0; j < 16; ++j) { const unsigned c = xb_ld(&bar[XB_XCNT(j)]); sum += c; cnt += (c > 0u) ? 1u : 0u; mine = (j == x) ? c : mine; }
        if (sum == G) break;
        __builtin_amdgcn_s_sleep(1);
        if ((++sp & 255u) == 0u) { if (xb_ld(&bar[XB_TMO])) break; if (sp > XB_SPIN_CAP) { atomicAdd(&bar[XB_TMO], 1u); break; } }
    }
    nloc = mine > 0u ? mine : 1u; nx = cnt > 0u ? cnt : 1u;
}
__device__ __forceinline__ void xcd_barrier(const XcdBarrier& b) {
    asm volatile("s_waitcnt vmcnt(0)" ::: "memory");
    __syncthreads();
    if (threadIdx.x == 0) {
        unsigned* bar = b.bar;
        __builtin_amdgcn_s_waitcnt(0);
        unsigned nloc = b.st[0], nx = b.st[1];
        if (nloc == 0u) { xcd_barrier_complete(bar, b.x, nloc, nx); b.st[0] = nloc; b.st[1] = nx; }
        const unsigned old = xb_add(&bar[XB_XSUB(b.x)], 1u);
        const unsigned gen = old / nloc;
        if (old + 1u == (gen + 1u) * nloc) {
            __builtin_amdgcn_fence(__ATOMIC_RELEASE, "agent");
            asm volatile("s_waitcnt vmcnt(0)" ::: "memory");
            const unsigned og = xb_add(&bar[XB_TOP], 1u);
            const unsigned tg = og / nx;
            if (og + 1u == (tg + 1u) * nx) xb_add(&bar[XB_TOPGEN], 1u);
            else XB_SPIN(xb_ld(&bar[XB_TOPGEN]) == tg, bar);
            __builtin_amdgcn_fence(__ATOMIC_ACQUIRE, "agent");
            xb_add(&bar[XB_XGEN(b.x)], 1u);
            asm volatile("s_waitcnt vmcnt(0)" ::: "memory");
        } else {
            XB_SPIN(xb_ld(&bar[XB_XGEN(b.x)]) == gen, bar);
            __builtin_amdgcn_fence(__ATOMIC_ACQUIRE, "agent");
            asm volatile("s_waitcnt vmcnt(0)" ::: "memory");
        }
    }
    __syncthreads();
}

struct Frame { LAS unsigned char* lds; volatile LAS unsigned* MISC; int tid, wave, vcu, G; };

constexpr int W_SMALL = 128 * 16 + 24 * 4 + 32 * 4 + 32 * 8 + 32 * 8 + 32 * 16, W_ALL = W_SMALL + 32 * 64 * 16 + 32 * 32 * 16;
struct WItem { const float* src; const float* ksc; bf16* dst; int ldw, ldt, nvalid, fp8; };
__device__ __forceinline__ WItem wt_decode(const P& p, int it) {
    constexpr int I_WIN = 128 * 16, I_WQ = 24 * 4, I_WKV = 32 * 4, I_WF = 32 * 8, I_WM = 32 * 8, I_WO = 32 * 16, I_GU = 32 * 64 * 16;
    WItem w; w.ksc = nullptr; w.nvalid = 32; w.fp8 = 0; int r = it;
    if (r < I_WIN) { const int db = r & 127, kb = r >> 7, n = 32 * db; int src0;
        if (n < 1536) src0 = n; else if (n < 1792) src0 = C_QL + (n - 1536);
        else if (n < 2048) { const int j = n - 1792; if (j < 128) src0 = C_KV + j; else if (j == 128) src0 = C_KPE; else if (j == 160) { src0 = C_FL; w.nvalid = 8; } else { src0 = 0; w.nvalid = 0; } }
        else src0 = C_G + (n - 2048);
        w.src = p.w_in + (size_t)(64 * kb) * IN_COLS + src0; w.ldw = IN_COLS; w.dst = WSP(bf16, WS_WIN) + (size_t)n * 1024 + 64 * kb; w.ldt = 1024;
#if GATE_FP8
        if (n >= 2048) { w.fp8 = 1; w.dst = (bf16*)(WSP(unsigned char, WS_WIN8) + (size_t)(n - 2048) * 1024 + 64 * kb); }
#endif
        return w; }
    r -= I_WIN;
    if (r < I_WQ) { const int db = r % 24, kb = r / 24, n = 32 * db; const int src0 = (n < 512) ? (n >> 6) * 96 + (n & 63) : ((n - 512) >> 5) * 96 + 64;
        w.src = p.w_q_b + (size_t)(64 * kb) * 768 + src0; w.ldw = 768; w.ksc = p.g_q_a + 64 * kb; w.dst = WSP(bf16, WS_WQ) + (size_t)n * 256 + 64 * kb; w.ldt = 256; return w; }
    r -= I_WQ;
    if (r < I_WKV) { const int db = r & 31, kb = r >> 5, n = 32 * db; const int nn = n & 511; const int src0 = (nn >> 6) * 128 + (n >= 512 ? 64 : 0) + (nn & 63);
        w.src = p.w_kv_b + (size_t)((kb < 2) ? 64 * kb : 0) * 1024 + src0; w.ldw = 1024; w.ksc = p.g_kv_a + ((kb < 2) ? 64 * kb : 0); w.nvalid = (kb < 2) ? 32 : 0; w.dst = WSP(bf16, WS_WKV) + (size_t)n * 256 + 64 * kb; w.ldt = 256; return w; }
    r -= I_WKV;
    if (r < I_WF) { const int db = r & 31, kb = r >> 5; w.src = p.w_fox + (size_t)(64 * kb) * 1024 + 32 * db; w.ldw = 1024; w.dst = WSP(bf16, WS_WF) + (size_t)(32 * db) * 512 + 64 * kb; w.ldt = 512; return w; }
    r -= I_WF;
    if (r < I_WM) { const int db = r & 31, kb = r >> 5; w.src = p.w_mla + (size_t)(64 * kb) * 1024 + 32 * db; w.ldw = 1024; w.dst = WSP(bf16, WS_WM) + (size_t)(32 * db) * 512 + 64 * kb; w.ldt = 512; return w; }
    r -= I_WM;
    if (r < I_WO) { const int db = r & 31, kb = r >> 5; w.src = p.w_o + (size_t)(64 * kb) * 1024 + 32 * db; w.ldw = 1024; w.ldt = 1024;
#if WO_FP8
        w.fp8 = 1; w.dst = (bf16*)(WSP(unsigned char, WS_WO) + (size_t)(32 * db) * 1024 + 64 * kb);
#else
        w.dst = WSP(bf16, WS_WO) + (size_t)(32 * db) * 1024 + 64 * kb;
#endif
        return w; }
    r -= I_WO;
    if (r < I_GU) { const int e = r >> 10, rr = r & 1023, db = rr & 63, kb = rr >> 6, n = 32 * db; const int src0 = ((n >> 7) & 1) * 1024 + (n >> 8) * 128 + (n & 127);
        w.src = p.w_gu + (size_t)e * 1024 * 2048 + (size_t)(64 * kb) * 2048 + src0; w.ldw = 2048; w.ldt = 1024;
#if MOE_FP8
        w.fp8 = 1; w.dst = (bf16*)(WSP(unsigned char, WS_WGU) + (size_t)e * 2048 * 1024 + (size_t)n * 1024 + 64 * kb);
#else
        w.dst = WSP(bf16, WS_WGU) + (size_t)e * 2048 * 1024 + (size_t)n * 1024 + 64 * kb;
#endif
        return w; }
    r -= I_GU;
    { const int e = r >> 9, rr = r & 511, db = rr & 31, kb = rr >> 5;
        w.src = p.w_down + (size_t)e * 1024 * 1024 + (size_t)(64 * kb) * 1024 + 32 * db; w.ldw = 1024; w.ldt = 1024;
#if MOE_FP8
        w.fp8 = 1; w.dst = (bf16*)(WSP(unsigned char, WS_WD) + (size_t)e * 1024 * 1024 + (size_t)(32 * db) * 1024 + 64 * kb);
#else
        w.dst = WSP(bf16, WS_WD) + (size_t)e * 1024 * 1024 + (size_t)(32 * db) * 1024 + 64 * kb;
#endif
        return w; }
}
struct BgConv {
    const P* p; LAS unsigned char* scr; unsigned stage; int it, step, stride, age; bool active, pend; WItem w;
    __device__ __forceinline__ void init(const P& p_, LAS unsigned char* scr_, LAS unsigned char* stage_, int it0, int stride_) { p = &p_; scr = scr_; stage = (unsigned)(size_t)stage_; it = it0; stride = stride_; step = 0; age = 0; active = it0 < W_ALL; pend = false; w = wt_decode(p_, active ? it0 : W_SMALL); }
    __device__ __forceinline__ void issue(int lane) {
        if (!active) return;
        const float* g = w.src + (size_t)(8 * step + (lane >> 3)) * w.ldw + 4 * (lane & 7);
#pragma unroll
        for (int j = 0; j < 4; ++j) att::glds16(g + (size_t)(8 * j) * w.ldw, stage + 1024 * j);
        pend = true; age = 0;
    }
    __device__ __forceinline__ void consume(int lane) {
        if (!pend) return;
        pend = false;
        { const LAS unsigned char* sp = (const LAS unsigned char*)(size_t)stage + 16 * lane;
          f32x4 x[4];
#pragma unroll
          for (int j = 0; j < 4; ++j) x[j] = *(const LAS f32x4*)(sp + 1024 * j) * 32.f;
          LDS_WAIT(); asm volatile("" ::: "memory");
          LAS unsigned char* q = scr + (8 * step + (lane >> 3)) * 36 + 4 * (lane & 7);
#pragma unroll
          for (int j = 0; j < 4; ++j) { int b = __builtin_amdgcn_cvt_pk_fp8_f32(x[j][0], x[j][1], 0, false); b = __builtin_amdgcn_cvt_pk_fp8_f32(x[j][2], x[j][3], b, true); *(LAS int*)(q + 8 * 36 * j) = b; } }
        step += 4;
        if (step < 8) return;
        LDS_WAIT(); asm volatile("" ::: "memory");
        const int c = lane & 7, ng = lane >> 3;
        unsigned d[8];
#pragma unroll
        for (int q = 0; q < 8; ++q) d[q] = *(const LAS unsigned*)(scr + (8 * c + q) * 36 + 4 * ng);
        unsigned t[2][4];
#pragma unroll
        for (int h = 0; h < 2; ++h) {
            const unsigned p01l = __builtin_amdgcn_perm(d[4 * h + 1], d[4 * h], 0x05010400u), p01h = __builtin_amdgcn_perm(d[4 * h + 1], d[4 * h], 0x07030602u);
            const unsigned p23l = __builtin_amdgcn_perm(d[4 * h + 3], d[4 * h + 2], 0x05010400u), p23h = __builtin_amdgcn_perm(d[4 * h + 3], d[4 * h + 2], 0x07030602u);
            t[h][0] = __builtin_amdgcn_perm(p23l, p01l, 0x05040100u); t[h][1] = __builtin_amdgcn_perm(p23l, p01l, 0x07060302u);
            t[h][2] = __builtin_amdgcn_perm(p23h, p01h, 0x05040100u); t[h][3] = __builtin_amdgcn_perm(p23h, p01h, 0x07060302u); }
        unsigned char* dst = (unsigned char*)w.dst;
#pragma unroll
        for (int j = 0; j < 4; ++j) *(u32x2*)(dst + (size_t)(4 * ng + j) * w.ldt + 8 * c) = (u32x2){t[0][j], t[1][j]};
        LDS_WAIT(); asm volatile("" ::: "memory");
        step = 0; it += stride; active = it < W_ALL; if (active) w = wt_decode(*p, it);
    }
};
__device__ __forceinline__ void wt_load(const WItem& w, f32x4 (&v)[8], int lane) {
    const int n4 = lane & 7;
#pragma unroll
    for (int i = 0; i < 8; ++i) { const int kk = 8 * i + (lane >> 3); v[i] = (f32x4){0.f, 0.f, 0.f, 0.f};
        if (4 * n4 < w.nvalid) { v[i] = *(const f32x4*)(w.src + (size_t)kk * w.ldw + 4 * n4); if (w.ksc) v[i] = v[i] * w.ksc[kk]; } }
}
__device__ __forceinline__ void wt_store(const WItem& w, const f32x4 (&v)[8], LAS float* scr, int lane) {
    const int n4 = lane & 7;
#pragma unroll
    for (int i = 0; i < 8; ++i) { const int kk = 8 * i + (lane >> 3); LAS float* s = scr + kk * 33 + 4 * n4; s[0] = v[i][0]; s[1] = v[i][1]; s[2] = v[i][2]; s[3] = v[i][3]; }
    LDS_WAIT(); asm volatile("" ::: "memory");
    const int c = lane & 7;
#pragma unroll
    for (int j = 0; j < 4; ++j) { const int n = (lane >> 3) + 8 * j; const LAS float* s = scr + (8 * c) * 33 + n;
        if (w.fp8) { *(u32x2*)((unsigned char*)w.dst + (size_t)n * w.ldt + 8 * c) = pack8_fp8((f32x4){s[0 * 33], s[1 * 33], s[2 * 33], s[3 * 33]} * 32.f, (f32x4){s[4 * 33], s[5 * 33], s[6 * 33], s[7 * 33]} * 32.f); }
        else { u32x4 o; o.x = cvt_pk_bf16(s[0 * 33], s[1 * 33]); o.y = cvt_pk_bf16(s[2 * 33], s[3 * 33]); o.z = cvt_pk_bf16(s[4 * 33], s[5 * 33]); o.w = cvt_pk_bf16(s[6 * 33], s[7 * 33]);
            *(u32x4*)(w.dst + (size_t)n * w.ldt + 8 * c) = o; } }
    LDS_WAIT(); asm volatile("" ::: "memory");
}
__device__ __forceinline__ void wt_convert_range(const P& p, Frame& F, int lo, int hi) {
    LAS float* scr = (LAS float*)(F.lds + F.wave * 16384);
    const int gw = F.vcu * NWAVES + F.wave, NGW = F.G * NWAVES;
    int it = lo + gw; f32x4 va[8], vb[8];
    WItem wa = wt_decode(p, it < hi ? it : lo), wb = wa;
    if (it < hi) wt_load(wa, va, (F.tid & 63));
    while (it < hi) {
        const int nx = it + NGW;
        if (nx < hi) { wb = wt_decode(p, nx); wt_load(wb, vb, (F.tid & 63)); }
        wt_store(wa, va, scr, (F.tid & 63));
        it = nx; if (it >= hi) break;
        const int nx2 = it + NGW;
        if (nx2 < hi) { wa = wt_decode(p, nx2); wt_load(wa, va, (F.tid & 63)); }
        wt_store(wb, vb, scr, (F.tid & 63));
        it = nx2;
    }
}
__device__ __forceinline__ void p0_prologue(const P& p, Frame& F) {
    LAS float* scr = (LAS float*)(F.lds + F.wave * 16384);
    const int gw = F.vcu * NWAVES + F.wave, NGW = F.G * NWAVES;
    constexpr int NITEMS = W_SMALL;
    {
        int it = gw; f32x4 va[8], vb[8];
        WItem wa = wt_decode(p, it < NITEMS ? it : 0), wb = wa;
        if (it < NITEMS) wt_load(wa, va, (F.tid & 63));
        while (it < NITEMS) {
            const int nx = it + NGW;
            if (nx < NITEMS) { wb = wt_decode(p, nx); wt_load(wb, vb, (F.tid & 63)); }
            wt_store(wa, va, scr, (F.tid & 63));
            it = nx; if (it >= NITEMS) break;
            const int nx2 = it + NGW;
            if (nx2 < NITEMS) { wa = wt_decode(p, nx2); wt_load(wa, va, (F.tid & 63)); }
            wt_store(wb, vb, scr, (F.tid & 63));
            it = nx2;
        }
    }
    for (int m0 = gw; m0 < NTOK; m0 += 2 * NGW) {
        f32x4 v[2][4];
#pragma unroll
        for (int q = 0; q < 2; ++q) { const int mrow = (m0 + q * NGW < NTOK) ? m0 + q * NGW : m0; const f32x4* xr = (const f32x4*)(p.x + (size_t)mrow * DM) + (F.tid & 63);
#pragma unroll
            for (int j = 0; j < 4; ++j) v[q][j] = xr[64 * j]; }
#pragma unroll
        for (int q = 0; q < 2; ++q) { const int mrow = m0 + q * NGW; if (mrow >= NTOK) break;
            float s = 0.f;
#pragma unroll
            for (int j = 0; j < 4; ++j) s += (v[q][j].x * v[q][j].x + v[q][j].y * v[q][j].y) + (v[q][j].z * v[q][j].z + v[q][j].w * v[q][j].w);
            const float rs = 1.f / sqrtf(wave_sum(s) * (1.f / DM) + EPS);
            const f32x4* gr = (const f32x4*)p.g_attn + (F.tid & 63); u32x2* o8 = (u32x2*)(WSP(bf16, WS_H) + (size_t)mrow * DM) + (F.tid & 63);
#pragma unroll
            for (int j = 0; j < 4; ++j) { const f32x4 g = gr[64 * j]; const f32x4 hv = (f32x4){v[q][j].x * rs * g.x, v[q][j].y * rs * g.y, v[q][j].z * rs * g.z, v[q][j].w * rs * g.w};
                u32x2 w; w.x = cvt_pk_bf16(hv.x, hv.y); w.y = cvt_pk_bf16(hv.z, hv.w); o8[64 * j] = w;
#if GATE_FP8
                { int b8 = __builtin_amdgcn_cvt_pk_fp8_f32(hv.x, hv.y, 0, false); b8 = __builtin_amdgcn_cvt_pk_fp8_f32(hv.z, hv.w, b8, true); ((unsigned*)(WSP(unsigned char, WS_H8) + (size_t)mrow * DM))[(F.tid & 63) + 64 * j] = (unsigned)b8; }
#endif
            } }
    }
    if (blockIdx.x == 0 && F.tid < 64) WSP(unsigned, WS_MISC)[GM_KMAX + F.tid] = 0u;
    if (blockIdx.x == 0 && F.tid < 32) WSP(int, WS_MISC)[GM_CUR + F.tid] = 0;
    for (int idx = (F.vcu * NWAVES * 64) + F.tid; idx < NTOK * 16; idx += F.G * NWAVES * 64) {
        const int tok = idx >> 4, j = idx & 15;
        const float inv_freq = powf(10000.0f, -(float)j / 16.0f); const float ang = (float)p.pos[tok] * inv_freq;
        float* cs = WSP(float, WS_CS) + (size_t)tok * 32; cs[j] = cosf(ang); cs[16 + j] = sinf(ang);
    }
}
__device__ __forceinline__ void p2a_rows(const P& p, Frame& F) {
    const int gw = F.vcu * NWAVES + F.wave, l = (F.tid & 63); const int bb = gw >> 8, r0 = bb * SEQ + (gw & 255);
    float kmx = 0.f;
    for (int jb = 0; jb < 16; jb += 4) {
        u32x4 wv[4], kv[4];
#pragma unroll
        for (int q = 0; q < 4; ++q) { const int mrow = r0 + 256 * (jb + q); wv[q] = *((const u32x4*)(WSP(const bf16, WS_QL) + (size_t)mrow * 512) + l); kv[q] = *((const u32x4*)(WSP(const bf16, WS_KF) + (size_t)mrow * 512) + l); }
#pragma unroll
        for (int q = 0; q < 4; ++q) { const int mrow = r0 + 256 * (jb + q); const u32x4 w = wv[q];
            { const u32x4 k = kv[q]; const float k8[8] = {bflo(k.x), bfhi(k.x), bflo(k.y), bfhi(k.y), bflo(k.z), bfhi(k.z), bflo(k.w), bfhi(k.w)}; float ks = 0.f;
#pragma unroll
              for (int i = 0; i < 8; ++i) ks += k8[i] * k8[i];
              ks += __shfl_xor(ks, 1); ks += __shfl_xor(ks, 2); ks += __shfl_xor(ks, 4); kmx = fmaxf(kmx, ks); }
            float v[8] = {bflo(w.x), bfhi(w.x), bflo(w.y), bfhi(w.y), bflo(w.z), bfhi(w.z), bflo(w.w), bfhi(w.w)};
            float s = 0.f;
#pragma unroll
            for (int i = 0; i < 8; ++i) s += v[i] * v[i];
            const float sq = wave_sum(l < 32 ? s : 0.f), sk = wave_sum((l >= 32 && l < 48) ? s : 0.f);
            if (l == 0) { float* rs = WSP(float, WS_SSQ) + (size_t)mrow * 2; rs[0] = 1.f / sqrtf(sq * (1.f / 256) + EPS); rs[1] = 1.f / sqrtf(sk * (1.f / 128) + EPS); }
            float pv[8];
#pragma unroll
            for (int i = 0; i < 8; ++i) pv[i] = __shfl_xor(v[i], 2);
            if (l >= 48 && l < 52) {
                const int jq = 8 * (l - 48); const float* cs = WSP(const float, WS_CS) + (size_t)mrow * 32 + (jq & 15); const float sg = (jq < 16) ? -1.f : 1.f;
                float o[8];
#pragma unroll
                for (int i = 0; i < 8; ++i) o[i] = v[i] * cs[i] + sg * pv[i] * cs[16 + i];
                u32x4 ow; ow.x = cvt_pk_bf16(o[0], o[1]); ow.y = cvt_pk_bf16(o[2], o[3]); ow.z = cvt_pk_bf16(o[4], o[5]); ow.w = cvt_pk_bf16(o[6], o[7]);
                *(u32x4*)(WSP(bf16, WS_KPE) + (size_t)mrow * 32 + jq) = ow;
            }
            if (l == 52) {
                float* lf = WSP(float, WS_LOGF) + (size_t)mrow * 8;
#pragma unroll
                for (int i = 0; i < 8; ++i) { const float z = v[i] + p.b_fgate[i]; lf[i] = fminf(z, 0.f) - log1pf(expf(-fabsf(z))); }
            }
        }
    }
    if ((l & 7) == 0) atomicMax(WSP(unsigned, WS_MISC) + GM_KMAX + bb * 8 + (l >> 3), __float_as_uint(kmx));
}
__device__ __forceinline__ void p2_cumsum(const P& p, Frame& F, int bh) {
    const int b = bh >> 3, h = bh & 7, t = F.tid;
    const float* lf = WSP(const float, WS_LOGF) + ((size_t)b * SEQ + 8 * t) * 8 + h;
    float v[8], tot = 0.f;
#pragma unroll
    for (int i = 0; i < 8; ++i) { v[i] = lf[i * 8]; tot += v[i]; }
    float inc = tot;
#pragma unroll
    for (int o = 1; o < 64; o <<= 1) { const float x = __shfl_up(inc, o); if ((F.tid & 63) >= o) inc += x; }
    LAS float* wt = (LAS float*)(F.lds);
    if ((F.tid & 63) == 63) wt[F.wave] = inc;
    __syncthreads();
    float run = inc - tot;
    for (int w = 0; w < F.wave; ++w) run += wt[w];
    float* kb = WSP(float, WS_KB) + (size_t)bh * SEQ + 8 * t;
#pragma unroll
    for (int i = 0; i < 8; ++i) { run += v[i]; kb[i] = -run * LOG2E; }
    __syncthreads();
}
__device__ __forceinline__ void p6_router(const P& p, Frame& F) {
    LAS bf16x8* WRH = (LAS bf16x8*)F.lds; LAS bf16x8* WRL = WRH + 4096;
    for (int f = F.tid; f < 4096; f += NWAVES * 64) { const int ln = f & 63, nb = (f >> 6) & 1, ks = f >> 7; const float* src = p.w_router + (size_t)(32 * ks + 8 * (ln >> 4)) * 32 + 16 * nb + (ln & 15);
        bf16x8 h, lo;
#pragma unroll
        for (int j = 0; j < 8; ++j) { const float w = src[j * 32]; const unsigned hb = f2bf(w); h[j] = (short)hb; lo[j] = (short)f2bf(w - bf2f((bf16)hb)); }
        WRH[f] = h; WRL[f] = lo; }
    volatile LAS unsigned* hist = F.MISC + 32;
    if (F.tid < 32) hist[F.tid] = 0u;
    __syncthreads();
    const int wg = blockIdx.x, lane = (F.tid & 63), tr = lane & 15, kq = lane >> 4;
    const int tok0 = wg * 128 + F.wave * 16;
    const bf16* xr = WSP(const bf16, WS_X1) + (size_t)(tok0 + tr) * DM + 8 * kq;
    const float* gr = p.g_ffn + 8 * kq;
    f32x4 acc0 = {0.f, 0.f, 0.f, 0.f}, acc1 = {0.f, 0.f, 0.f, 0.f}; float ss = 0.f;
#pragma unroll 4
    for (int ks = 0; ks < 32; ++ks) {
        const u32x4 xw = *(const u32x4*)(xr + 32 * ks); const f32x4 x0 = (f32x4){bflo(xw.x), bfhi(xw.x), bflo(xw.y), bfhi(xw.y)}, x1 = (f32x4){bflo(xw.z), bfhi(xw.z), bflo(xw.w), bfhi(xw.w)}, g0 = *(const f32x4*)(gr + 32 * ks), g1 = *(const f32x4*)(gr + 32 * ks + 4);
        ss += (x0[0] * x0[0] + x0[1] * x0[1]) + (x0[2] * x0[2] + x0[3] * x0[3]) + (x1[0] * x1[0] + x1[1] * x1[1]) + (x1[2] * x1[2] + x1[3] * x1[3]);
        const f32x4 a0 = x0 * g0, a1 = x1 * g1;
        bf16x8 ah, al;
#pragma unroll
        for (int j = 0; j < 4; ++j) { const unsigned h0 = f2bf(a0[j]), h1 = f2bf(a1[j]); ah[j] = (short)h0; ah[4 + j] = (short)h1; al[j] = (short)f2bf(a0[j] - bf2f((bf16)h0)); al[4 + j] = (short)f2bf(a1[j] - bf2f((bf16)h1)); }
        const bf16x8 bh0 = WRH[(ks * 2 + 0) * 64 + lane], bh1 = WRH[(ks * 2 + 1) * 64 + lane], bl0 = WRL[(ks * 2 + 0) * 64 + lane], bl1 = WRL[(ks * 2 + 1) * 64 + lane];
        acc0 = __builtin_amdgcn_mfma_f32_16x16x32_bf16(ah, bh0, acc0, 0, 0, 0); acc1 = __builtin_amdgcn_mfma_f32_16x16x32_bf16(ah, bh1, acc1, 0, 0, 0);
        acc0 = __builtin_amdgcn_mfma_f32_16x16x32_bf16(al, bh0, acc0, 0, 0, 0); acc1 = __builtin_amdgcn_mfma_f32_16x16x32_bf16(al, bh1, acc1, 0, 0, 0);
        acc0 = __builtin_amdgcn_mfma_f32_16x16x32_bf16(ah, bl0, acc0, 0, 0, 0); acc1 = __builtin_amdgcn_mfma_f32_16x16x32_bf16(ah, bl1, acc1, 0, 0, 0);
    }
    ss += __shfl_xor(ss, 16); ss += __shfl_xor(ss, 32);
    const float rs = 1.f / sqrtf(ss * (1.f / DM) + EPS);
    LAS float* LG = (LAS float*)(F.lds + ROWTAB_OFF) + F.wave * 544;
#pragma unroll
    for (int r = 0; r < 4; ++r) { LG[(4 * kq + r) * 32 + tr] = acc0[r]; LG[(4 * kq + r) * 32 + 16 + tr] = acc1[r]; }
    if (kq == 0) LG[512 + tr] = rs;
    LDS_WAIT(); asm volatile("" ::: "memory");
    int idx[4] = {0, 0, 0, 0}, rnk[4] = {0, 0, 0, 0}; float wgt[4] = {0.f, 0.f, 0.f, 0.f};
    if (lane < 16) {
        const float rst = LG[512 + lane]; float lg[32];
#pragma unroll
        for (int c = 0; c < 8; ++c) { const f32x4 v = *(const LAS f32x4*)(LG + lane * 32 + 4 * c); const f32x4 b = *(const f32x4*)(p.b_router + 4 * c);
            lg[4 * c] = v[0] * rst + b[0]; lg[4 * c + 1] = v[1] * rst + b[1]; lg[4 * c + 2] = v[2] * rst + b[2]; lg[4 * c + 3] = v[3] * rst + b[3]; }
        float val[4];
#pragma unroll
        for (int k = 0; k < 4; ++k) { float bv = -INFINITY; int bi = 0;
#pragma unroll
            for (int e = 0; e < 32; ++e) { const bool tk = lg[e] > bv; bv = tk ? lg[e] : bv; bi = tk ? e : bi; }
            idx[k] = bi; val[k] = bv;
#pragma unroll
            for (int e = 0; e < 32; ++e) lg[e] = (e == bi) ? -INFINITY : lg[e]; }
        float ex[4], sum = 0.f;
#pragma unroll
        for (int k = 0; k < 4; ++k) { ex[k] = expf(val[k] - val[0]); sum += ex[k]; }
        const float inv = 1.f / sum; const int tok = tok0 + lane;
        *(u32x4*)(WSP(int, WS_TOPI) + tok * 4) = (u32x4){(unsigned)idx[0], (unsigned)idx[1], (unsigned)idx[2], (unsigned)idx[3]};
        *(f32x4*)(WSP(float, WS_TOPW) + tok * 4) = (f32x4){ex[0] * inv, ex[1] * inv, ex[2] * inv, ex[3] * inv};
#pragma unroll
        for (int k = 0; k < 4; ++k) { rnk[k] = (int)__hip_atomic_fetch_add((LAS unsigned*)(F.lds + MISC_OFF) + 32 + idx[k], 1u, __ATOMIC_RELAXED, __HIP_MEMORY_SCOPE_WORKGROUP); wgt[k] = ex[k] * inv; }
    }
#if MOE_FP8
    unsigned char* H2 = WSP(unsigned char, WS_H2) + (size_t)(tok0 + tr) * DM + 8 * kq;
#else
    bf16* H2 = WSP(bf16, WS_H2) + (size_t)(tok0 + tr) * DM + 8 * kq;
#endif
#pragma unroll 4
    for (int ks = 0; ks < 32; ++ks) {
        const u32x4 xw = *(const u32x4*)(xr + 32 * ks); const f32x4 x0 = (f32x4){bflo(xw.x), bfhi(xw.x), bflo(xw.y), bfhi(xw.y)}, x1 = (f32x4){bflo(xw.z), bfhi(xw.z), bflo(xw.w), bfhi(xw.w)}, g0 = *(const f32x4*)(gr + 32 * ks), g1 = *(const f32x4*)(gr + 32 * ks + 4);
#if MOE_FP8
        *(u32x2*)(H2 + 32 * ks) = pack8_fp8(x0 * g0 * rs, x1 * g1 * rs); }
#else
        *(u32x4*)(H2 + 32 * ks) = pack8(x0 * g0 * rs, x1 * g1 * rs); }
#endif
    __syncthreads();
#if FUSED_ROWS
    volatile LAS int* gbase = (volatile LAS int*)(F.MISC + 64);
    if (F.tid < 32) gbase[F.tid] = atomicAdd(WSP(int, WS_MISC) + GM_CUR + F.tid, (int)hist[F.tid]);
    __syncthreads();
    if (lane < 16) { const int tok = tok0 + lane;
#pragma unroll
        for (int k = 0; k < 4; ++k) { const size_t pos = (size_t)idx[k] * ESTR + gbase[idx[k]] + rnk[k];
            WSP(int, WS_EROWTOK)[pos] = tok; WSP(int, WS_EROWSLOT)[pos] = tok * 4 + k; WSP(float, WS_EROWW)[pos] = wgt[k]; } }
#else
    if (F.tid < 32) WSP(int, WS_MISC)[GM_CNT + wg * 32 + F.tid] = (int)hist[F.tid];
#endif
    __syncthreads();
}
__device__ __forceinline__ void p7_rows(const P& p, Frame& F) {
    const int wg = blockIdx.x, tid = F.tid;
    LAS int* part = (LAS int*)F.lds;
    LAS int* tot = part + 512; LAS int* pre = tot + 32; LAS int* pstart = pre + 32; LAS int* base = pstart + 33; LAS unsigned* lcnt = (LAS unsigned*)(base + 32);
    const int* cnt = WSP(const int, WS_MISC) + GM_CNT;
    { const int e = tid & 31, j = tid >> 5; int s = 0;
#pragma unroll
      for (int w = 0; w < 16; ++w) s += cnt[(j * 16 + w) * 32 + e];
      part[j * 32 + e] = s; }
    __syncthreads();
    if (tid < 32) { int t = 0, pr = 0;
        for (int j = 0; j < 16; ++j) { if (j < (wg >> 4)) pr += part[j * 32 + tid]; t += part[j * 32 + tid]; }
        for (int w = (wg & ~15); w < wg; ++w) pr += cnt[w * 32 + tid];
        tot[tid] = t; pre[tid] = pr; lcnt[tid] = 0u; }
    __syncthreads();
    if (tid == 0) { int s = 0; for (int e = 0; e < 32; ++e) { pstart[e] = s; s += ((tot[e] + 255) >> 8) << 8; } pstart[32] = s; }
    __syncthreads();
    if (tid < 32) base[tid] = pstart[tid] + pre[tid];
    __syncthreads();
    { const int a = wg * 512 + tid; const int e = WSP(const int, WS_TOPI)[a]; const float w = WSP(const float, WS_TOPW)[a];
      const int pos = base[e] + (int)__hip_atomic_fetch_add(lcnt + e, 1u, __ATOMIC_RELAXED, __HIP_MEMORY_SCOPE_WORKGROUP);
      WSP(int, WS_ROWTOK)[pos] = a >> 2; WSP(int, WS_ROWSLOT)[pos] = a; WSP(float, WS_ROWW)[pos] = w; }
    if (wg < 32) { const int e = wg; const int s0 = pstart[e] + tot[e], s1 = pstart[e + 1];
        for (int r = s0 + tid; r < s1; r += NWAVES * 64) { WSP(int, WS_ROWTOK)[r] = 0; WSP(int, WS_ROWSLOT)[r] = NTOK * 4; WSP(float, WS_ROWW)[r] = 0.f; } }
    if (wg == 0) {
        if (tid == 0) WSP(int, WS_MISC)[GM_NBLK] = pstart[32] >> 8;
        if (tid < 32) { for (int bk = pstart[tid] >> 8; bk < (pstart[tid + 1] >> 8); ++bk) WSP(int, WS_MISC)[GM_BLKE + bk] = tid; }
    }
    __syncthreads();
}
__device__ __forceinline__ void moe_setup(const P& p, Frame& F, pg8::MoeOrder& S, int shift, int gc_log2, bool gather) {
    LAS int* blke = (LAS int*)(F.lds + BLKE_OFF); LAS int* rowtab = (LAS int*)(F.lds + ROWTAB_OFF);
#if FUSED_ROWS
    volatile LAS int* cntL = (volatile LAS int*)(F.MISC + 32); volatile LAS int* bst = (volatile LAS int*)(F.MISC + 64);
    if (F.tid < 64) {
        const int l = F.tid, c = (l < 32) ? WSP(const int, WS_MISC)[GM_CUR + l] : 0, nb = (c + 255) >> 8;
        int inc = nb;
#pragma unroll
        for (int d = 1; d < 32; d <<= 1) { const int o = __shfl_up(inc, d); if (l >= d) inc += o; }
        if (l < 32) { cntL[l] = c; bst[l] = inc - nb; }
        if (l == 31) bst[32] = inc;
    }
    __syncthreads();
    const int nblk = bst[32];
    for (int i = F.tid; i < MAXBLK; i += NWAVES * 64) { int e = 0;
#pragma unroll
        for (int st = 16; st >= 1; st >>= 1) { if (bst[e + st] <= i) e += st; }
        blke[i] = (i < nblk) ? e : 0; }
    __syncthreads();
    S.init(nblk, F.G, (int)blockIdx.x, shift, gc_log2, (const LAS int*)blke);
    if (gather) {
        for (int i = 0; i < ROWTAB_UNITS; ++i) { const int rb = S.rb_of(i); if (rb >= nblk) break;
            if (F.tid < 256) { const int e = blke[rb], pos = ((rb - bst[e]) << 8) + F.tid; rowtab[i * 256 + F.tid] = (pos < cntL[e]) ? WSP(const int, WS_EROWTOK)[(size_t)e * ESTR + pos] : 0; } }
        { LAS unsigned short* bl = (LAS unsigned short*)(F.lds + BIASL_OFF);
          for (int i = 0; i < ROWTAB_UNITS; ++i) { pg8::Unit u_; if (!S.next(i, u_)) break;
              if (F.tid < 256) bl[i * 256 + F.tid] = (unsigned short)f2bf(p.b_gu[(size_t)u_.e * 2048 + (F.tid < 128 ? 0 : 1024 - 128) + u_.pn * 128 + F.tid]); } }
        if (blockIdx.x < 32) { const int e = (int)blockIdx.x, c0_ = cntL[e], c1_ = ((c0_ + 255) >> 8) << 8;
            for (int q = c0_ + F.tid; q < c1_; q += NWAVES * 64) { WSP(int, WS_EROWSLOT)[(size_t)e * ESTR + q] = NTOK * 4; WSP(float, WS_EROWW)[(size_t)e * ESTR + q] = 0.f; } }
    }
#else
    const int nblk = WSP(const int, WS_MISC)[GM_NBLK];
    for (int i = F.tid; i < MAXBLK; i += NWAVES * 64) blke[i] = (i < nblk) ? WSP(const int, WS_MISC)[GM_BLKE + i] : 0;
    S.init(nblk, F.G, (int)blockIdx.x, shift, gc_log2, (const LAS int*)blke);
    if (gather) {
        for (int i = 0; i < ROWTAB_UNITS; ++i) { const int rb = S.rb_of(i); if (rb >= nblk) break;
            if (F.tid < 256) rowtab[i * 256 + F.tid] = WSP(const int, WS_ROWTOK)[rb * 256 + F.tid]; }
    }
#endif
    __syncthreads();
}
__device__ __forceinline__ void p10_final(const P& p, Frame& F) {
    const int gw = F.vcu * NWAVES + F.wave, NGW = F.G * NWAVES, lane = F.tid & 63;
#if Z_FP8
    typedef float f32x2 __attribute__((ext_vector_type(2)));
    for (int m0 = gw; m0 < NTOK; m0 += 2 * NGW) {
        f32x4 v[2][4]; unsigned z[2][4][4];
#pragma unroll
        for (int q = 0; q < 2; ++q) { const int mrow = (m0 + q * NGW < NTOK) ? m0 + q * NGW : m0;
            const u32x2* xr = (const u32x2*)(WSP(const bf16, WS_X1) + (size_t)mrow * DM) + lane;
#pragma unroll
            for (int j = 0; j < 4; ++j) { const u32x2 xw = xr[64 * j]; v[q][j] = (f32x4){bflo(xw.x), bfhi(xw.x), bflo(xw.y), bfhi(xw.y)};
#pragma unroll
                for (int k = 0; k < 4; ++k) z[q][j][k] = *((const unsigned*)(WSP(const unsigned char, WS_Z) + ((size_t)mrow * 4 + k) * 1024) + lane + 64 * j); } }
#pragma unroll
        for (int q = 0; q < 2; ++q) { const int mrow = m0 + q * NGW; if (mrow >= NTOK) break;
            float s = 0.f;
#pragma unroll
            for (int j = 0; j < 4; ++j) { f32x4 a = {0.f, 0.f, 0.f, 0.f};
#pragma unroll
                for (int k = 0; k < 4; ++k) { const f32x2 lo = __builtin_amdgcn_cvt_pk_f32_fp8((int)z[q][j][k], false), hi = __builtin_amdgcn_cvt_pk_f32_fp8((int)z[q][j][k], true); a.x += lo.x; a.y += lo.y; a.z += hi.x; a.w += hi.y; }
                v[q][j] = v[q][j] + a * 0.0625f;
                s += (v[q][j].x * v[q][j].x + v[q][j].y * v[q][j].y) + (v[q][j].z * v[q][j].z + v[q][j].w * v[q][j].w); }
            const float rs = 1.f / sqrtf(wave_sum(s) * (1.f / DM) + EPS);
            f32x4* xo = (f32x4*)(p.out + (size_t)mrow * DM) + lane; const f32x4* gr = (const f32x4*)p.g_final + lane;
#pragma unroll
            for (int j = 0; j < 4; ++j) { const f32x4 g = gr[64 * j]; xo[64 * j] = (f32x4){v[q][j].x * rs * g.x, v[q][j].y * rs * g.y, v[q][j].z * rs * g.z, v[q][j].w * rs * g.w}; }
        }
    }
#else
    for (int m0 = gw; m0 < NTOK; m0 += 2 * NGW) {
        f32x4 v[2][4]; u32x2 z[2][4][4];
#pragma unroll
        for (int q = 0; q < 2; ++q) { const int mrow = (m0 + q * NGW < NTOK) ? m0 + q * NGW : m0;
            const u32x2* xr = (const u32x2*)(WSP(const bf16, WS_X1) + (size_t)mrow * DM) + lane;
#pragma unroll
            for (int j = 0; j < 4; ++j) { const u32x2 xw = xr[64 * j]; v[q][j] = (f32x4){bflo(xw.x), bfhi(xw.x), bflo(xw.y), bfhi(xw.y)};
#pragma unroll
                for (int k = 0; k < 4; ++k) z[q][j][k] = *((const u32x2*)(WSP(const bf16, WS_Z) + ((size_t)mrow * 4 + k) * 1024) + lane + 64 * j); } }
#pragma unroll
        for (int q = 0; q < 2; ++q) { const int mrow = m0 + q * NGW; if (mrow >= NTOK) break;
            float s = 0.f;
#pragma unroll
            for (int j = 0; j < 4; ++j) {
#pragma unroll
                for (int k = 0; k < 4; ++k) { v[q][j].x += bflo(z[q][j][k].x); v[q][j].y += bfhi(z[q][j][k].x); v[q][j].z += bflo(z[q][j][k].y); v[q][j].w += bfhi(z[q][j][k].y); }
                s += (v[q][j].x * v[q][j].x + v[q][j].y * v[q][j].y) + (v[q][j].z * v[q][j].z + v[q][j].w * v[q][j].w); }
            const float rs = 1.f / sqrtf(wave_sum(s) * (1.f / DM) + EPS);
            f32x4* xo = (f32x4*)(p.out + (size_t)mrow * DM) + lane; const f32x4* gr = (const f32x4*)p.g_final + lane;
#pragma unroll
            for (int j = 0; j < 4; ++j) { const f32x4 g = gr[64 * j]; xo[64 * j] = (f32x4){v[q][j].x * rs * g.x, v[q][j].y * rs * g.y, v[q][j].z * rs * g.z, v[q][j].w * rs * g.w}; }
        }
    }
#endif
}

constexpr int NPHASE = 12;
struct Args { P p; int ph_lo, ph_hi; };
__global__ void __launch_bounds__(NWAVES * 64, 2) mk_fwd(Args args) {
    extern __shared__ __attribute__((aligned(16))) unsigned char lds_raw[];
    const P& p = args.p;
    Frame F;
    F.lds = (LAS unsigned char*)lds_raw; F.MISC = (volatile LAS unsigned*)(F.lds + MISC_OFF);
    F.tid = threadIdx.x; F.wave = __builtin_amdgcn_readfirstlane(F.tid >> 6);
    F.G = gridDim.x; { const int bx = blockIdx.x; F.vcu = (F.G % 8 == 0) ? (bx % 8) * (F.G / 8) + bx / 8 : bx; }
    for (int u = F.tid; u < 256; u += NWAVES * 64) F.MISC[u] = 0u;
    __syncthreads();
    const int lo = args.ph_lo, hi = args.ph_hi;
    const bool one = (hi - lo) > 1;
    XcdBarrier bar; bar.bar = (unsigned*)(p.ws + WS_CTL) + 4096; bar.x = 0; bar.st = nullptr;
    if (one) bar = xcd_barrier_post((unsigned*)(p.ws + WS_CTL) + 4096, F.MISC + 8);
#ifndef PH_MASK
#define PH_MASK 0xfff
#endif
#define IN(k) (((PH_MASK >> (k)) & 1) && lo <= (k) && (k) < hi)
#define SEAM(k) do { if (IN(k) && IN((k) + 1)) xcd_barrier(bar); } while (0)
    using namespace pg8;
    const int bx = (int)blockIdx.x;
    if (IN(0)) { p0_prologue(p, F); } SEAM(0);
    if (IN(1)) {
#if GATE_FP8
        { Gemm g{WSP(const bf16, WS_H), WSP(const bf16, WS_WIN), 1024, 1024}; StaticOrder S; S.init(NTOK, 2048, F.G, bx);
          EpiInproj<false> E{p.ws};
          gemm_phase<EpiInproj<false>, StaticOrder, true, false>(F.lds, g, S, E, nullptr); }
        { Gemm g{WSP(const bf16, WS_H8), WSP(const bf16, WS_WIN8), 1024, 1024}; StaticOrder S; S.init(NTOK, 2048, F.G, bx);
          EpiInproj<true> E{p.ws};
          gemm_phase8<EpiInproj<true>, StaticOrder, true, false>(F.lds, g, S, E, nullptr); }
#else
        Gemm g{WSP(const bf16, WS_H), WSP(const bf16, WS_WIN), 1024, 1024}; StaticOrder S; S.init(NTOK, 4096, F.G, bx);
        EpiInproj<false> E{p.ws};
        gemm_phase<EpiInproj<false>, StaticOrder, true, false>(F.lds, g, S, E, nullptr);
#endif
    } SEAM(1);
    if (IN(2)) { p2a_rows(p, F); } SEAM(2);
    if (IN(3)) {
        if (F.vcu < 64) p2_cumsum(p, F, F.vcu);
        { Gemm g{WSP(const bf16, WS_QL), WSP(const bf16, WS_WQ), 256, 512}; StaticOrder S; S.init(NTOK, 768, F.G, (F.G == 256) ? (((bx & 7) + 6) & 7) * 32 + (bx >> 3) : bx);
          EpiQup E{WSP(bf16, WS_QM), WSP(const float, WS_SSQ), WSP(const float, WS_CS)};
          gemm_phase<EpiQup, StaticOrder, true, false>(F.lds, g, S, E, nullptr); }
        { Gemm g{WSP(const bf16, WS_QL) + 256, WSP(const bf16, WS_WKV), 256, 512}; StaticOrder S; S.init(NTOK, 1024, F.G, bx);
          EpiKvup E{WSP(bf16, WS_KN), WSP(const float, WS_SSQ)};
          gemm_phase<EpiKvup, StaticOrder, true, false>(F.lds, g, S, E, nullptr); }
    } SEAM(3);
    if (IN(4)) {
        BgConv cv; cv.init(p, F.lds + ROWTAB_OFF + F.wave * 2304, F.lds + att::BG_STAGE_OFF + F.wave * 4096, W_SMALL + F.vcu * NWAVES + F.wave, F.G * NWAVES);
        for (int j = F.vcu; j < 2048; j += F.G) {
            const int br = j >> 10, jj = j & 1023, r = jj >> 8, bh = (jj & 255) >> 2, s = jj & 3;
            const int qb = (r == 0) ? s : (r == 1) ? 7 - s : (r == 2) ? 8 + s : 15 - s;
            if (br == 0) att::attn_unit<64, true>(cv, F.lds, bh >> 3, bh & 7, qb, WSP(const bf16, WS_QF), WSP(const bf16, WS_KF), WSP(const bf16, WS_KPE), WSP(const bf16, WS_VF), WSP(const float, WS_KB), WSP(bf16, WS_YF), __uint_as_float(WSP(const unsigned, WS_MISC)[GM_KMAX + bh]));
            else att::attn_unit<96, false>(cv, F.lds, bh >> 3, bh & 7, qb, WSP(const bf16, WS_QM), WSP(const bf16, WS_KN), WSP(const bf16, WS_KPE), WSP(const bf16, WS_VM), WSP(const float, WS_KB), WSP(bf16, WS_YM), 0.f);
        }
        VM_WAIT(); cv.consume(F.tid & 63);
        while (cv.active) { cv.issue(F.tid & 63); VM_WAIT(); cv.consume(F.tid & 63); }
    } SEAM(4);
    if (IN(5)) {
        { Gemm g{WSP(const bf16, WS_YF), WSP(const bf16, WS_WF), 512, 512}; StaticOrder S; S.init(NTOK, 1024, F.G, bx);
          EpiMerge<0> E{WSP(bf16, WS_T0), WSP(bf16, WS_MG), WSP(const bf16, WS_G), p.b_merge};
          gemm_phase<EpiMerge<0>, StaticOrder, true, false>(F.lds, g, S, E, nullptr); }
        { Gemm g{WSP(const bf16, WS_YM), WSP(const bf16, WS_WM), 512, 512}; StaticOrder S; S.init(NTOK, 1024, F.G, bx);
          EpiMerge<1> E{WSP(bf16, WS_T0), WSP(bf16, WS_MG), WSP(const bf16, WS_G), p.b_merge};
          gemm_phase<EpiMerge<1>, StaticOrder, true, false>(F.lds, g, S, E, nullptr); }
    } SEAM(5);
    if (IN(6)) {
        StaticOrder S; S.init(NTOK, 1024, F.G, bx);
        EpiWo E{p.x, WSP(bf16, WS_X1)};
#if WO_FP8
        Gemm g{WSP(const bf16, WS_MG), WSP(const bf16, WS_WO), 1024, 1024, 0x7B7B7B7B};
        gemm_phase8<EpiWo, StaticOrder, true, false>(F.lds, g, S, E, nullptr);
#else
        Gemm g{WSP(const bf16, WS_MG), WSP(const bf16, WS_WO), 1024, 1024};
        gemm_phase<EpiWo, StaticOrder, true, false>(F.lds, g, S, E, nullptr);
#endif
    } SEAM(6);
    if (IN(7)) { p6_router(p, F); } SEAM(7);
#if !FUSED_ROWS
    if (IN(8)) { p7_rows(p, F); } SEAM(8);
#endif
    if (IN(9)) {
        MoeOrder S; moe_setup(p, F, S, 3, 1, true);
        Gemm g{WSP(const bf16, WS_H2), WSP(const bf16, WS_WGU), 1024, 1024};
        EpiSwiglu<MOE_FP8 != 0> E{WSP(bf16, WS_ACT), p.b_gu, (const LAS unsigned short*)(F.lds + BIASL_OFF)};
#if MOE_FP8
        gemm_phase8<EpiSwiglu<true>, MoeOrder, false, true>(F.lds, g, S, E, (const LAS int*)(F.lds + ROWTAB_OFF));
#else
        gemm_phase<EpiSwiglu<false>, MoeOrder, false, true>(F.lds, g, S, E, (const LAS int*)(F.lds + ROWTAB_OFF));
#endif
    } SEAM(9);
    if (IN(10)) {
        MoeOrder S; moe_setup(p, F, S, 2, 0, false);
        Gemm g{WSP(const bf16, WS_ACT), WSP(const bf16, WS_WD), 1024, 1024};
#if FUSED_ROWS
        EpiDown<MOE_FP8 != 0> E{WSP(bf16, WS_Z), p.b_down, WSP(const int, WS_EROWSLOT), WSP(const float, WS_EROWW), (const volatile LAS int*)(F.MISC + 32), (const volatile LAS int*)(F.MISC + 64)};
#else
        EpiDown<MOE_FP8 != 0> E{WSP(bf16, WS_Z), p.b_down, WSP(const int, WS_ROWSLOT), WSP(const float, WS_ROWW), nullptr, nullptr};
#endif
#if MOE_FP8
        gemm_phase8<EpiDown<true>, MoeOrder, true, false>(F.lds, g, S, E, nullptr);
#else
        gemm_phase<EpiDown<false>, MoeOrder, true, false>(F.lds, g, S, E, nullptr);
#endif
    } SEAM(10);
    if (IN(11)) { p10_final(p, F); }
#undef IN
#undef SEAM
}

extern "C" void kernel_launch(void* const* d_in, const int* in_sizes, int n_in, void* d_out, int out_size, void* d_ws, size_t ws_size, hipStream_t stream) {
    static int grid = 0;
    if (grid == 0) {
        if (n_in != 21 || out_size != NTOK * DM || ws_size < WS_END) { fprintf(stderr, "kernel_launch: unexpected sizes n_in %d out %d ws %zu\n", n_in, out_size, ws_size); grid = -1; return; }
        int dev = 0, cus = 0, per_cu = 0;
        if (hipGetDevice(&dev) != hipSuccess || hipDeviceGetAttribute(&cus, hipDeviceAttributeMultiprocessorCount, dev) != hipSuccess) { grid = -1; return; }
        if (hipFuncSetAttribute((const void*)mk_fwd, hipFuncAttributeMaxDynamicSharedMemorySize, LDS_BYTES) != hipSuccess) { fprintf(stderr, "kernel_launch: hipFuncSetAttribute failed\n"); grid = -1; return; }
        if (hipOccupancyMaxActiveBlocksPerMultiprocessor(&per_cu, (const void*)mk_fwd, NWAVES * 64, LDS_BYTES) != hipSuccess || per_cu < 1) { fprintf(stderr, "kernel_launch: occupancy query says %d\n", per_cu); }
        (void)hipGetLastError();
        if (cus != 256) { fprintf(stderr, "kernel_launch: built for 256 CUs, found %d\n", cus); grid = -1; return; }
        grid = 256;
    }
    if (grid < 0) return;
    P p{};
    p.x = (const float*)d_in[0]; p.pos = (const int*)d_in[1]; p.g_attn = (const float*)d_in[2]; p.w_in = (const float*)d_in[3]; p.b_fgate = (const float*)d_in[4];
    p.g_q_a = (const float*)d_in[5]; p.w_q_b = (const float*)d_in[6]; p.g_kv_a = (const float*)d_in[7]; p.w_kv_b = (const float*)d_in[8];
    p.w_fox = (const float*)d_in[9]; p.w_mla = (const float*)d_in[10]; p.b_merge = (const float*)d_in[11]; p.w_o = (const float*)d_in[12];
    p.g_ffn = (const float*)d_in[13]; p.w_router = (const float*)d_in[14]; p.b_router = (const float*)d_in[15];
    p.w_gu = (const float*)d_in[16]; p.b_gu = (const float*)d_in[17]; p.w_down = (const float*)d_in[18]; p.b_down = (const float*)d_in[19]; p.g_final = (const float*)d_in[20];
    p.out = (float*)d_out; p.ws = (unsigned char*)d_ws;
    (void)hipMemsetAsync((char*)d_ws + WS_CTL, 0, 64 * 1024, stream);
    Args a{}; a.p = p;
    a.ph_lo = 0; a.ph_hi = NPHASE;
    hipLaunchKernelGGL(mk_fwd, dim3(grid), dim3(NWAVES * 64), LDS_BYTES, stream, a);
}
```

```cpp
#include <hip/hip_runtime.h>
#include <cstdio>
#include <cstdint>

constexpr int DM = 1024, BATCH = 8, SEQ = 4096, NTOK = BATCH * SEQ;
constexpr int NE = 32, TOPK = 4, FF = 1024;
constexpr int IN_COLS = 4008;
constexpr int C_QF = 0, C_KF = 512, C_VF = 1024, C_FL = 1536, C_QL = 1544, C_KV = 1800, C_KPE = 1928, C_G = 1960;
constexpr float EPS = 1e-6f;
constexpr size_t SSQ2 = (size_t)NTOK * 4;
constexpr float LOG2E = 1.4426950408889634f;
constexpr float C2F = 0.125f * LOG2E;
constexpr float C2M = 0.10206207261596577f * LOG2E;

typedef unsigned short bf16;
__device__ __forceinline__ unsigned f2bf(float f) { unsigned u = __builtin_bit_cast(unsigned, f); return (u + 0x7fffu + ((u >> 16) & 1u)) >> 16; }
__device__ __forceinline__ float bf2f(bf16 b) { return __builtin_bit_cast(float, (unsigned)b << 16); }

constexpr size_t MiB = 1u << 20;
constexpr size_t WS_CTL = 0;
constexpr size_t WS_WIN = 2 * MiB, WS_WQ = 10 * MiB, WS_WKV = 10 * MiB + 512 * 1024, WS_WF = 11 * MiB, WS_WM = 12 * MiB, WS_WO = 13 * MiB;
constexpr size_t WS_WGU = 16 * MiB, WS_WD = 144 * MiB;
constexpr size_t WS_SSQ = 208 * MiB, WS_KPE = 209 * MiB, WS_LOGF = 211 * MiB, WS_CS = 212 * MiB, WS_KB = 216 * MiB, WS_TOPI = 217 * MiB, WS_TOPW = 217 * MiB + 512 * 1024;
constexpr size_t WS_ROWTOK = 218 * MiB, WS_ROWSLOT = 219 * MiB, WS_ROWW = 220 * MiB, WS_MISC = 221 * MiB;
constexpr size_t WS_T0 = 224 * MiB, WS_H2 = 224 * MiB, WS_MG = 288 * MiB;
constexpr size_t WS_A = 352 * MiB, WS_H = 352 * MiB, WS_QF = 416 * MiB, WS_KF = 448 * MiB, WS_VF = 480 * MiB, WS_QL = 512 * MiB, WS_QM = 544 * MiB, WS_ACT = 480 * MiB, WS_X1 = 352 * MiB;
constexpr size_t WS_B = 624 * MiB, WS_G = 624 * MiB, WS_KN = 752 * MiB, WS_VM = 784 * MiB, WS_YF = 816 * MiB, WS_YM = 848 * MiB, WS_Z = 624 * MiB;
constexpr size_t WS_H8 = 288 * MiB;
constexpr size_t WS_WIN8 = 2 * MiB + 4 * MiB;
constexpr size_t WS_END = 896 * MiB;

struct P {
    const float* x; const int* pos; const float* g_attn; const float* w_in; const float* b_fgate; const float* g_q_a; const float* w_q_b; const float* g_kv_a; const float* w_kv_b;
    const float* w_fox; const float* w_mla; const float* b_merge; const float* w_o; const float* g_ffn; const float* w_router; const float* b_router;
    const float* w_gu; const float* b_gu; const float* w_down; const float* b_down; const float* g_final;
    float* out; unsigned char* ws;
};
#define WSP(T, off) ((T*)(p.ws + (off)))

__device__ __forceinline__ float wave_sum(float v) {
#pragma unroll
    for (int o = 1; o < 64; o <<= 1) v += __shfl_xor(v, o);
    return v;
}

#ifndef GATE_FP8
#define GATE_FP8 1
#endif
#ifndef Z_FP8
#define G_FP8 1
#define WO_FP8 1
#define FUSED_ROWS 1
#define Z_FP8 1
#endif
#ifndef MOE_FP8
#define MOE_FP8 1
#endif
#define GAS __attribute__((address_space(1)))
#define LAS __attribute__((address_space(3)))
typedef unsigned u32x4 __attribute__((ext_vector_type(4)));
typedef unsigned u32x2 __attribute__((ext_vector_type(2)));
typedef float f32x4 __attribute__((ext_vector_type(4)));
typedef float f32x16 __attribute__((ext_vector_type(16)));
typedef short bf16x8 __attribute__((ext_vector_type(8)));
typedef short s16x4 __attribute__((ext_vector_type(4)));
typedef int v8i32 __attribute__((ext_vector_type(8)));
typedef int v4i32 __attribute__((ext_vector_type(4)));
typedef GAS unsigned gu32;
#define RLX_AGENT __ATOMIC_RELAXED, __HIP_MEMORY_SCOPE_AGENT
#define LDS_WAIT() asm volatile("s_waitcnt lgkmcnt(0)" ::: "memory")
#define VM_WAIT() asm volatile("s_waitcnt vmcnt(0)" ::: "memory")
__device__ __forceinline__ unsigned cvt_pk_bf16(float lo, float hi) { unsigned r; asm volatile("v_cvt_pk_bf16_f32 %0, %1, %2" : "=v"(r) : "v"(lo), "v"(hi)); return r; }
__device__ __forceinline__ u32x4 pack8(f32x4 a, f32x4 b) { u32x4 w; w.x = cvt_pk_bf16(a[0], a[1]); w.y = cvt_pk_bf16(a[2], a[3]); w.z = cvt_pk_bf16(b[0], b[1]); w.w = cvt_pk_bf16(b[2], b[3]); return w; }
__device__ __forceinline__ u32x2 pack8_fp8(f32x4 a, f32x4 b) { int w0 = __builtin_amdgcn_cvt_pk_fp8_f32(a[0], a[1], 0, false); w0 = __builtin_amdgcn_cvt_pk_fp8_f32(a[2], a[3], w0, true);
    int w1 = __builtin_amdgcn_cvt_pk_fp8_f32(b[0], b[1], 0, false); w1 = __builtin_amdgcn_cvt_pk_fp8_f32(b[2], b[3], w1, true); return (u32x2){(unsigned)w0, (unsigned)w1}; }
__device__ __forceinline__ float bflo(unsigned w) { return __builtin_bit_cast(float, w << 16); }
__device__ __forceinline__ float bfhi(unsigned w) { return __builtin_bit_cast(float, w & 0xffff0000u); }
typedef float f32x2 __attribute__((ext_vector_type(2)));
__device__ __forceinline__ f32x2 fsigmoid2(f32x2 z) { const f32x2 t = z * (-LOG2E); f32x2 e; e.x = __builtin_amdgcn_exp2f(t.x); e.y = __builtin_amdgcn_exp2f(t.y); const f32x2 d = e + 1.f; f32x2 r; r.x = __builtin_amdgcn_rcpf(d.x); r.y = __builtin_amdgcn_rcpf(d.y); return r; }
__device__ __forceinline__ unsigned lane_xor1(unsigned v) { return (unsigned)__builtin_amdgcn_mov_dpp((int)v, 0xB1, 0xF, 0xF, true); }
__device__ __forceinline__ float fsigmoid(float z) { return __builtin_amdgcn_rcpf(1.f + __builtin_amdgcn_exp2f(-z * LOG2E)); }

constexpr int RING_BYTES = 131072;
constexpr int MISC_OFF = RING_BYTES;
constexpr int BLKE_OFF = MISC_OFF + 1024;
constexpr int ROWTAB_OFF = BLKE_OFF + 2304;
constexpr int ROWTAB_UNITS = 18;
constexpr int LDS_BYTES = ROWTAB_OFF + ROWTAB_UNITS * 1024;
static_assert(LDS_BYTES <= 160 * 1024, "LDS");
static_assert(WS_VF - WS_KF == WS_KF - WS_QF, "QF/KF/VF equally spaced");
constexpr int NWAVES = 8;
constexpr int MAXBLK = 544;
constexpr int GM_NBLK = 0, GM_BLKE = 64, GM_CNT = 1024, GM_KMAX = 40000;
constexpr int GM_CUR = GM_CNT;
constexpr int ESTR = NTOK + 256;
constexpr size_t WS_EROWTOK = 80 * MiB, WS_EROWSLOT = 85 * MiB, WS_EROWW = 90 * MiB;

namespace pg8 {
#define PG8_LAS __attribute__((address_space(3)))
typedef unsigned short bf16_t;
constexpr int BM = 256, BK = 64, HALF = 128, HTB = HALF * BK * 2, STAGE_BYTES = 8 * HTB, NXCD = 8, WGM = 8;
__host__ __device__ __forceinline__ int lds_byte(int r, int c) { const int st = (r >> 4) * 2 + (c >> 5), rr = r & 15, cc = c & 31, ob = rr * 64 + cc * 2; return st * 1024 + (ob ^ (((ob >> 9) & 1) << 5)); }
__host__ __device__ __forceinline__ void stage_rc(int b, int& R, int& C) { const int st = b / 1024, sb = b % 1024, swz = sb ^ (((sb >> 9) & 1) << 5); R = (st >> 1) * 16 + swz / 64; C = (st & 1) * 32 + (swz % 64) / 2; }
__host__ __device__ __forceinline__ int perm32(int rho) { const int n = rho >> 4, i = rho & 15; return 8 * (i >> 2) + 4 * n + (i & 3); }

struct Unit { int pm, pn, bt, e; };
struct Gemm { const bf16_t* A; const bf16_t* Bt; int K, lda; int ascale = 0x7F7F7F7F; };

struct StaticOrder {
    int nM, nN, nwg, G, c;
    __device__ void init(int M, int N, int G_, int c_) { nM = M / BM; nN = N / BM; nwg = nM * nN; G = G_; c = c_; }
    __device__ bool next(int i, Unit& u) const {
        const long L = (long)i * G + c; if (L >= nwg) return false;
        int wgid = (int)L; { const int q = nwg / NXCD, r = nwg % NXCD, xcd = wgid % NXCD, off = wgid / NXCD; wgid = (xcd < r ? xcd * (q + 1) : r * (q + 1) + (xcd - r) * q) + off; }
        const int nig = WGM * nN, gid = wgid / nig, fm = gid * WGM, gsz = (nM - fm) < WGM ? (nM - fm) : WGM;
        u.pm = fm + ((wgid % nig) % gsz); u.pn = (wgid % nig) / gsz; u.bt = u.pn; u.e = 0; return true;
    }
};
struct LinearOrder {
    int nunits, G, c, shift;
    __device__ bool next(int i, Unit& u) const { const int idx = c + i * G; if (idx >= nunits) return false; u.pm = idx >> shift; u.pn = idx & ((1 << shift) - 1); u.bt = u.pn; u.e = 0; return true; }
};
struct MoeOrder {
    int nblk, s, g8, xr, gr, pn0, cpxs, shift; const PG8_LAS int* blke;
    __device__ void init(int nblk_, int G, int c, int shift_, int gc_log2, const PG8_LAS int* blke_) {
        nblk = nblk_; shift = shift_; blke = blke_; g8 = G >> 3; s = c >> 3; const int x = c & 7; gr = 8 >> gc_log2; xr = x & (gr - 1); const int xc = x / gr; cpxs = shift_ - gc_log2; pn0 = xc << cpxs; }
    __device__ int rb_of(int i) const { const int j = s + i * g8; return (j >> cpxs) * gr + xr; }
    __device__ bool next(int i, Unit& u) const {
        const int j = s + i * g8, rb = (j >> cpxs) * gr + xr; if (rb >= nblk) return false;
        const int pn = pn0 + (j & ((1 << cpxs) - 1)), e = blke[rb];
        u.pm = rb; u.pn = pn; u.e = e; u.bt = (e << shift) + pn; return true;
    }
};

template <class Epi, class Sched, bool ALIGN_EPI, bool GATHER>
__device__ __forceinline__ void gemm_phase(PG8_LAS unsigned char* lds, const Gemm g, const Sched& S, const Epi& E, const PG8_LAS int* rowtab) {
    int tid_ = threadIdx.x; asm volatile("" : "+v"(tid_));
    const int tid = tid_, wid = __builtin_amdgcn_readfirstlane(tid >> 6), lane = tid & 63, wr = wid >> 2, wc = wid & 3, fr = lane & 15, fq = lane >> 4;
    const int K = g.K, nt = K / BK, lda = g.lda;
    unsigned voffA[2], voffB[2]; int RA[2]; unsigned CA2[2];
#pragma unroll
    for (int i = 0; i < 2; ++i) { int R, C; stage_rc(tid * 16 + i * 8192, R, C); const int Rb = Epi::WIDE ? (64 * (R >> 5) + perm32(R & 31)) : Epi::PERM ? ((R & ~31) + perm32(R & 31)) : R;
        voffA[i] = (unsigned)(R * lda + C) * 2u; voffB[i] = (unsigned)(Rb * K + C) * 2u; RA[i] = R; CA2[i] = (unsigned)C * 2u; }
    const size_t kstep = (size_t)(BK * 2);
    const size_t hstepA = (size_t)HALF * lda * 2, tstepA = 2 * hstepA;
    const size_t hstepB = (size_t)(Epi::WIDE ? 32 : HALF) * K * 2, tstepB = (size_t)2 * HALF * K * 2;
    const unsigned ldsw = (unsigned)wid * 1024u;
    const int aoff = lds_byte(wr * 64 + fr, fq * 8), boff = lds_byte(wc * 32 + fr, fq * 8);
    unsigned va[2][2], vn[2][2];
#define PG8_SA(b, h) (((b) * 2 + (h)) * HTB)
#define PG8_SB(b, h) ((4 + (b) * 2 + (h)) * HTB)
#define PG8_STAGE(bufoff, gbase, voff) do { _Pragma("unroll") for (int _i = 0; _i < 2; ++_i) \
        __builtin_amdgcn_global_load_lds((const unsigned*)((const char*)(gbase) + (voff)[_i]), (PG8_LAS unsigned*)(lds + (bufoff) + ldsw + _i * 8192), 16, 0, 0); } while (0)
#define PG8_STAGE_A(bufoff, gbase, h, NXT) do { if constexpr (GATHER) { unsigned o_[2]; o_[0] = (NXT) ? vn[h][0] : va[h][0]; o_[1] = (NXT) ? vn[h][1] : va[h][1]; PG8_STAGE(bufoff, gbase, o_); } \
        else { PG8_STAGE(bufoff, (gbase) + (h) * hstepA, voffA); } } while (0)
#define PG8_LDA(dst, b, h) do { _Pragma("unroll") for (int m = 0; m < 4; ++m) _Pragma("unroll") for (int k = 0; k < 2; ++k) dst[m][k] = *(const PG8_LAS bf16x8*)(lds + PG8_SA(b, h) + aoff + m * 2048 + k * 1024); } while (0)
#define PG8_LDB(dst, b, h) do { _Pragma("unroll") for (int n = 0; n < 2; ++n) _Pragma("unroll") for (int k = 0; k < 2; ++k) dst[n][k] = *(const PG8_LAS bf16x8*)(lds + PG8_SB(b, h) + boff + n * 2048 + k * 1024); } while (0)
#define PG8_MMA(ai, bj, At, Bt) do { __builtin_amdgcn_s_setprio(1); _Pragma("unroll") for (int m = 0; m < 4; ++m) _Pragma("unroll") for (int n = 0; n < 2; ++n) _Pragma("unroll") for (int k = 0; k < 2; ++k) \
        acc[ai][bj][m][n] = __builtin_amdgcn_mfma_f32_16x16x32_bf16(Bt[n][k], At[m][k], acc[ai][bj][m][n], 0, 0, 0); __builtin_amdgcn_s_setprio(0); } while (0)
#define PG8_WAIT_V(n) asm volatile("s_waitcnt vmcnt(" #n ")" ::: "memory")
#define PG8_WAIT_L(n) asm volatile("s_waitcnt lgkmcnt(" #n ")" ::: "memory")
#define PG8_BAR __builtin_amdgcn_s_barrier()
#define PG8_SCHED __builtin_amdgcn_sched_barrier(0)
#define PG8_ROWOFF(dst, ui_) do { _Pragma("unroll") for (int h_ = 0; h_ < 2; ++h_) _Pragma("unroll") for (int i_ = 0; i_ < 2; ++i_) \
        dst[h_][i_] = (unsigned)rowtab[(ui_) * 256 + h_ * 128 + RA[i_]] * (unsigned)(lda * 2) + CA2[i_]; } while (0)
    Unit cur, nxt; int ui = 0;
    if (!S.next(0, cur)) return;
    f32x4 acc[2][2][4][2];
#pragma unroll
    for (int a = 0; a < 2; ++a)
#pragma unroll
        for (int b = 0; b < 2; ++b)
#pragma unroll
            for (int m = 0; m < 4; ++m)
#pragma unroll
                for (int n = 0; n < 2; ++n) acc[a][b][m][n] = (f32x4){0.f, 0.f, 0.f, 0.f};
    bf16x8 At[4][2], B0[2][2], B1[2][2];
    const char* cA = (const char*)g.A + (GATHER ? (size_t)0 : (size_t)cur.pm * tstepA); const char* cB = (const char*)g.Bt + (size_t)cur.bt * tstepB;
    if constexpr (GATHER) { PG8_ROWOFF(va, 0); }
    PG8_STAGE(PG8_SB(0, 0), cB, voffB); PG8_STAGE(PG8_SB(0, 1), cB + hstepB, voffB); PG8_STAGE_A(PG8_SA(0, 0), cA, 0, false); PG8_STAGE_A(PG8_SA(0, 1), cA, 1, false);
    if (wr == 1) PG8_BAR;
    PG8_WAIT_V(2); PG8_BAR;
    PG8_STAGE(PG8_SB(1, 0), cB + kstep, voffB); PG8_STAGE_A(PG8_SA(1, 0), cA + kstep, 0, false); PG8_STAGE(PG8_SB(1, 1), cB + hstepB + kstep, voffB);
    PG8_WAIT_V(6); PG8_BAR;
    for (;;) {
        const bool has_next = S.next(ui + 1, nxt);
        const char* nA = has_next ? (const char*)g.A + (GATHER ? (size_t)0 : (size_t)nxt.pm * tstepA) : cA; const char* nB = has_next ? (const char*)g.Bt + (size_t)nxt.bt * tstepB : cB;
        if constexpr (GATHER) { if (has_next) { PG8_ROWOFF(vn, ui + 1); } else {
#pragma unroll
            for (int h_ = 0; h_ < 2; ++h_)
#pragma unroll
                for (int i_ = 0; i_ < 2; ++i_) vn[h_][i_] = va[h_][i_]; } }
        for (int t = 0; t < nt; t += 2) {
            const bool last = (t == nt - 2);
            const char* a1 = cA + (size_t)(t + 1) * kstep;
            const char* a2 = last ? nA : cA + (size_t)(t + 2) * kstep; const char* b2 = last ? nB : cB + (size_t)(t + 2) * kstep;
            const char* a3 = a2 + kstep; const char* b3 = b2 + kstep;
            PG8_LDB(B0, 0, 0); PG8_LDB(B1, 0, 1); PG8_SCHED; PG8_LDA(At, 0, 0); PG8_STAGE_A(PG8_SA(1, 1), a1, 1, false);
            PG8_WAIT_V(8); PG8_WAIT_L(0); PG8_BAR; PG8_MMA(0, 0, At, B0); PG8_MMA(0, 1, At, B1); PG8_BAR; PG8_SCHED;
            PG8_LDA(At, 0, 1); PG8_STAGE(PG8_SB(0, 0), b2, voffB); PG8_STAGE(PG8_SB(0, 1), b2 + hstepB, voffB); PG8_STAGE_A(PG8_SA(0, 0), a2, 0, last);
            PG8_WAIT_V(8); PG8_WAIT_L(0); PG8_BAR; PG8_MMA(1, 0, At, B0); PG8_MMA(1, 1, At, B1); PG8_BAR; PG8_SCHED;
            PG8_LDB(B0, 1, 0); PG8_LDB(B1, 1, 1); PG8_SCHED; PG8_LDA(At, 1, 0); PG8_STAGE_A(PG8_SA(0, 1), a2, 1, last);
            PG8_WAIT_V(8); PG8_WAIT_L(0); PG8_BAR; PG8_MMA(0, 0, At, B0); PG8_MMA(0, 1, At, B1); PG8_BAR; PG8_SCHED;
            PG8_LDA(At, 1, 1); PG8_STAGE(PG8_SB(1, 0), b3, voffB); PG8_STAGE(PG8_SB(1, 1), b3 + hstepB, voffB); PG8_STAGE_A(PG8_SA(1, 0), a3, 0, last);
            PG8_WAIT_V(8); PG8_WAIT_L(0); PG8_BAR; PG8_MMA(1, 0, At, B0); PG8_MMA(1, 1, At, B1); PG8_BAR; PG8_SCHED;
        }
        if constexpr (ALIGN_EPI) { if (wr == 0) PG8_BAR; }
        E(acc, cur, wr, wc, fr, fq);
        if (!has_next) break;
#pragma unroll
        for (int a = 0; a < 2; ++a)
#pragma unroll
            for (int b = 0; b < 2; ++b)
#pragma unroll
                for (int m = 0; m < 4; ++m)
#pragma unroll
                    for (int n = 0; n < 2; ++n) acc[a][b][m][n] = (f32x4){0.f, 0.f, 0.f, 0.f};
        cur = nxt; cA = nA; cB = nB; ++ui;
        if constexpr (GATHER) {
#pragma unroll
            for (int h_ = 0; h_ < 2; ++h_)
#pragma unroll
                for (int i_ = 0; i_ < 2; ++i_) va[h_][i_] = vn[h_][i_]; }
        if constexpr (ALIGN_EPI) { if (wr == 1) PG8_BAR; }
    }
    PG8_WAIT_V(0);
    if constexpr (!ALIGN_EPI) { if (wr == 0) PG8_BAR; }
    PG8_BAR;
#undef PG8_SA
#undef PG8_SB
#undef PG8_STAGE
#undef PG8_STAGE_A
#undef PG8_LDA
#undef PG8_LDB
#undef PG8_MMA
#undef PG8_WAIT_V
#undef PG8_WAIT_L
#undef PG8_BAR
#undef PG8_SCHED
#undef PG8_ROWOFF
}

template <class Epi, class Sched, bool ALIGN_EPI, bool GATHER>
__device__ __forceinline__ void gemm_phase8(PG8_LAS unsigned char* lds, const Gemm g, const Sched& S, const Epi& E, const PG8_LAS int* rowtab) {
    int tid_ = threadIdx.x; asm volatile("" : "+v"(tid_));
    const int tid = tid_, wid = __builtin_amdgcn_readfirstlane(tid >> 6), lane = tid & 63, wr = wid >> 2, wc = wid & 3, fr = lane & 15, fq = lane >> 4;
    int K_ = g.K; asm volatile("" : "+s"(K_));
    const int K = K_, nt = K / 128, lda = g.lda;
    unsigned voffA[2], voffB[2]; int RA[2]; unsigned CA2[2];
#pragma unroll
    for (int i = 0; i < 2; ++i) { const int u = tid * 16 + i * 8192; const int R = 16 * (u >> 11) + ((u & 1023) >> 6), J = 4 * ((u >> 10) & 1) + (((u & 63) >> 4) ^ ((R >> 2) & 3)); const int Rb = Epi::WIDE ? (64 * (R >> 5) + perm32(R & 31)) : Epi::PERM ? ((R & ~31) + perm32(R & 31)) : R;
        voffA[i] = (unsigned)(R * lda + J * 16); voffB[i] = (unsigned)(Rb * K + J * 16); RA[i] = R; CA2[i] = (unsigned)(J * 16); }
    const size_t kstep = (size_t)128;
    const size_t hstepA = (size_t)HALF * lda, tstepA = 2 * hstepA;
    const size_t hstepB = (size_t)(Epi::WIDE ? 32 : HALF) * K, tstepB = (size_t)2 * HALF * K;
    const unsigned ldsw = (unsigned)wid * 1024u;
    const int aoff0 = wr * 8192 + fr * 64 + 16 * (fq ^ ((fr >> 2) & 3)), boff0 = wc * 4096 + fr * 64 + 16 * (fq ^ ((fr >> 2) & 3));
    unsigned va[2][2], vn[2][2];
#define PG8_SA(b, h) (((b) * 2 + (h)) * HTB)
#define PG8_SB(b, h) ((4 + (b) * 2 + (h)) * HTB)
#define PG8_STAGE(bufoff, gbase, voff) do { _Pragma("unroll") for (int _i = 0; _i < 2; ++_i) \
        __builtin_amdgcn_global_load_lds((const unsigned*)((const char*)(gbase) + (voff)[_i]), (PG8_LAS unsigned*)(lds + (bufoff) + ldsw + _i * 8192), 16, 0, 0); } while (0)
#define PG8_STAGE_A(bufoff, gbase, h, NXT) do { if constexpr (GATHER) { unsigned o_[2]; o_[0] = (NXT) ? vn[h][0] : va[h][0]; o_[1] = (NXT) ? vn[h][1] : va[h][1]; PG8_STAGE(bufoff, gbase, o_); } \
        else { PG8_STAGE(bufoff, (gbase) + (h) * hstepA, voffA); } } while (0)
#define PG8_LDA(dst, b, h) do { _Pragma("unroll") for (int m = 0; m < 4; ++m) { const v4i32 lo_ = *(const PG8_LAS v4i32*)(lds + PG8_SA(b, h) + aoff0 + m * 2048), hi_ = *(const PG8_LAS v4i32*)(lds + PG8_SA(b, h) + aoff0 + m * 2048 + 1024); dst[m] = __builtin_shufflevector(lo_, hi_, 0, 1, 2, 3, 4, 5, 6, 7); } } while (0)
#define PG8_LDB(dst, b, h) do { _Pragma("unroll") for (int n = 0; n < 2; ++n) { const v4i32 lo_ = *(const PG8_LAS v4i32*)(lds + PG8_SB(b, h) + boff0 + n * 2048), hi_ = *(const PG8_LAS v4i32*)(lds + PG8_SB(b, h) + boff0 + n * 2048 + 1024); dst[n] = __builtin_shufflevector(lo_, hi_, 0, 1, 2, 3, 4, 5, 6, 7); } } while (0)
#define PG8_F8(F_) ((v8i32){(int)F_[0][0], (int)F_[0][1], (int)F_[0][2], (int)F_[0][3], (int)F_[1][0], (int)F_[1][1], (int)F_[1][2], (int)F_[1][3]})
#define PG8_MMA(ai, bj, At, Bt) do { __builtin_amdgcn_s_setprio(1); _Pragma("unroll") for (int m = 0; m < 4; ++m) _Pragma("unroll") for (int n = 0; n < 2; ++n) \
        asm volatile("v_mfma_scale_f32_16x16x128_f8f6f4 %0, %1, %2, %0, %3, %4 op_sel_hi:[0,0,0]" : "+v"(acc[ai][bj][m][n]) : "v"(Bt[n]), "v"(At[m]), "v"(sclw_), "v"(scl_));     __builtin_amdgcn_s_setprio(0); } while (0)
#define PG8_WAIT_V(n) asm volatile("s_waitcnt vmcnt(" #n ")" ::: "memory")
#define PG8_WAIT_L(n) asm volatile("s_waitcnt lgkmcnt(" #n ")" ::: "memory")
#define PG8_BAR __builtin_amdgcn_s_barrier()
#define PG8_SCHED __builtin_amdgcn_sched_barrier(0)
#define PG8_ROWOFF(dst, ui_) do { _Pragma("unroll") for (int h_ = 0; h_ < 2; ++h_) _Pragma("unroll") for (int i_ = 0; i_ < 2; ++i_) \
        dst[h_][i_] = (unsigned)rowtab[(ui_) * 256 + h_ * 128 + RA[i_]] * (unsigned)lda + CA2[i_]; } while (0)
    Unit cur, nxt; int ui = 0;
    if (!S.next(0, cur)) return;
    int scl_ = g.ascale, sclw_ = 0x7A7A7A7A; asm volatile("" : "+v"(scl_), "+v"(sclw_));
    float z_ = 0.f; asm volatile("" : "+v"(z_));
    f32x4 acc[2][2][4][2];
#pragma unroll
    for (int a = 0; a < 2; ++a)
#pragma unroll
        for (int b = 0; b < 2; ++b)
#pragma unroll
            for (int m = 0; m < 4; ++m)
#pragma unroll
                for (int n = 0; n < 2; ++n) acc[a][b][m][n] = (f32x4){z_, z_, z_, z_};
    v8i32 At[4], B0[2], B1[2];
    const char* cA = (const char*)g.A + (GATHER ? (size_t)0 : (size_t)cur.pm * tstepA); const char* cB = (const char*)g.Bt + (size_t)cur.bt * tstepB;
    if constexpr (GATHER) { PG8_ROWOFF(va, 0); }
    PG8_STAGE(PG8_SB(0, 0), cB, voffB); PG8_STAGE(PG8_SB(0, 1), cB + hstepB, voffB); PG8_STAGE_A(PG8_SA(0, 0), cA, 0, false); PG8_STAGE_A(PG8_SA(0, 1), cA, 1, false);
    if (wr == 1) PG8_BAR;
    PG8_WAIT_V(2); PG8_BAR;
    PG8_STAGE(PG8_SB(1, 0), cB + kstep, voffB); PG8_STAGE_A(PG8_SA(1, 0), cA + kstep, 0, false); PG8_STAGE(PG8_SB(1, 1), cB + hstepB + kstep, voffB);
    PG8_WAIT_V(6); PG8_BAR;
    for (;;) {
        const bool has_next = S.next(ui + 1, nxt);
        const char* nA = has_next ? (const char*)g.A + (GATHER ? (size_t)0 : (size_t)nxt.pm * tstepA) : cA; const char* nB = has_next ? (const char*)g.Bt + (size_t)nxt.bt * tstepB : cB;
        asm volatile("" : "+s"(nB));
        if constexpr (GATHER) { if (has_next) { PG8_ROWOFF(vn, ui + 1); } else {
#pragma unroll
            for (int h_ = 0; h_ < 2; ++h_)
#pragma unroll
                for (int i_ = 0; i_ < 2; ++i_) vn[h_][i_] = va[h_][i_]; } }
#pragma unroll 1
        for (int t = 0; t < nt; t += 2) {
            const bool last = (t == nt - 2);
            const char* a1 = cA + (size_t)(t + 1) * kstep;
            const char* a2 = last ? nA : cA + (size_t)(t + 2) * kstep; const char* b2 = last ? nB : cB + (size_t)(t + 2) * kstep;
            const char* a3 = a2 + kstep; const char* b3 = b2 + kstep;
            PG8_LDB(B0, 0, 0); PG8_LDB(B1, 0, 1); PG8_SCHED; PG8_LDA(At, 0, 0); PG8_STAGE_A(PG8_SA(1, 1), a1, 1, false);
            PG8_WAIT_V(8); PG8_WAIT_L(0); PG8_BAR; PG8_MMA(0, 0, At, B0); PG8_MMA(0, 1, At, B1); PG8_BAR; PG8_SCHED;
            PG8_LDA(At, 0, 1); PG8_STAGE(PG8_SB(0, 0), b2, voffB); PG8_STAGE(PG8_SB(0, 1), b2 + hstepB, voffB); PG8_STAGE_A(PG8_SA(0, 0), a2, 0, last);
            PG8_WAIT_V(8); PG8_WAIT_L(0); PG8_BAR; PG8_MMA(1, 0, At, B0); PG8_MMA(1, 1, At, B1); PG8_BAR; PG8_SCHED;
            PG8_LDB(B0, 1, 0); PG8_LDB(B1, 1, 1); PG8_SCHED; PG8_LDA(At, 1, 0); PG8_STAGE_A(PG8_SA(0, 1), a2, 1, last);
            PG8_WAIT_V(8); PG8_WAIT_L(0); PG8_BAR; PG8_MMA(0, 0, At, B0); PG8_MMA(0, 1, At, B1); PG8_BAR; PG8_SCHED;
            PG8_LDA(At, 1, 1); PG8_STAGE(PG8_SB(1, 0), b3, voffB); PG8_STAGE(PG8_SB(1, 1), b3 + hstepB, voffB); PG8_STAGE_A(PG8_SA(1, 0), a3, 0, last);
            PG8_WAIT_V(8); PG8_WAIT_L(0); PG8_BAR; PG8_MMA(1, 0, At, B0); PG8_MMA(1, 1, At, B1); PG8_BAR; PG8_SCHED;
        }
        if constexpr (ALIGN_EPI) { if (wr == 0) PG8_BAR; }
        asm volatile("s_nop 15\n\ts_nop 7" ::: "memory");
        E(acc, cur, wr, wc, fr, fq);
        if (!has_next) break;
#pragma unroll
        for (int a = 0; a < 2; ++a)
#pragma unroll
            for (int b = 0; b < 2; ++b)
#pragma unroll
                for (int m = 0; m < 4; ++m)
#pragma unroll
                    for (int n = 0; n < 2; ++n) acc[a][b][m][n] = (f32x4){z_, z_, z_, z_};
        cur = nxt; cA = nA; cB = nB; ++ui;
        if constexpr (GATHER) {
#pragma unroll
            for (int h_ = 0; h_ < 2; ++h_)
#pragma unroll
                for (int i_ = 0; i_ < 2; ++i_) va[h_][i_] = vn[h_][i_]; }
        if constexpr (ALIGN_EPI) { if (wr == 1) PG8_BAR; }
    }
    PG8_WAIT_V(0);
    if constexpr (!ALIGN_EPI) { if (wr == 0) PG8_BAR; }
    PG8_BAR;
#undef PG8_SA
#undef PG8_SB
#undef PG8_STAGE
#undef PG8_STAGE_A
#undef PG8_LDA
#undef PG8_LDB
#undef PG8_MMA
#undef PG8_WAIT_V
#undef PG8_WAIT_L
#undef PG8_BAR
#undef PG8_SCHED
#undef PG8_ROWOFF
#undef PG8_F8
}


typedef const f32x4 (&AccRef)[2][2][4][2];
#define EPI_ROWS(...) _Pragma("unroll") for (int ai = 0; ai < 2; ++ai) _Pragma("unroll") for (int m = 0; m < 4; ++m) { const int row = u.pm * BM + ai * HALF + wr * 64 + m * 16 + fr; __VA_ARGS__ }

template <bool F8> struct EpiInproj {
    static constexpr bool PERM = true, WIDE = !F8;
    unsigned char* ws;
    __device__ __forceinline__ void operator()(AccRef acc, const Unit& u, int wr, int wc, int fr, int fq) const {
        if constexpr (F8) {
            unsigned char* gb = ws + WS_G + (size_t)(u.pn * 256 + wc * 32 + 8 * fq);
            EPI_ROWS(
                unsigned char* rp = gb + (size_t)row * 2048;
                _Pragma("unroll") for (int bj = 0; bj < 2; ++bj) *(u32x2*)(rp + bj * HALF) = pack8_fp8(acc[ai][bj][m][0], acc[ai][bj][m][1]);
            )
            return;
        }
        const int pn = u.pn; const bool odd = fr & 1;
#if G_FP8
        if (pn >= 8) {
            unsigned char* gb = ws + WS_G + (size_t)((pn - 8) * 256 + wc * 64 + 8 * fq + (odd ? 32 : 0));
            EPI_ROWS(
                const u32x2 x0 = pack8_fp8(acc[ai][0][m][0], acc[ai][0][m][1]), x1 = pack8_fp8(acc[ai][1][m][0], acc[ai][1][m][1]);
                const u32x2 snd = odd ? x0 : x1; u32x2 rcv; rcv.x = lane_xor1(snd.x); rcv.y = lane_xor1(snd.y);
                unsigned char* rp = gb + (size_t)(row & ~1) * 2048;
                *(u32x2*)rp = odd ? rcv : x0; *(u32x2*)(rp + 2048) = odd ? x1 : rcv;
            )
            return;
        }
#endif
        const size_t off = pn < 6 ? WS_QF + (size_t)(pn >> 1) * (WS_KF - WS_QF) : pn < 8 ? WS_QL : WS_G;
        const int ld = pn < 8 ? 512 : 2048, col0 = (pn < 6 ? (pn & 1) : pn < 8 ? (pn - 6) : (pn - 8)) * 256 + wc * 64 + 8 * fq + (odd ? 32 : 0);
        const float sc = (pn < 2 ? C2F : 1.f);
        bf16_t* base = (bf16_t*)(ws + off) + col0;
        EPI_ROWS(
            const u32x4 x0 = pack8(acc[ai][0][m][0] * sc, acc[ai][0][m][1] * sc), x1 = pack8(acc[ai][1][m][0] * sc, acc[ai][1][m][1] * sc);
            const u32x4 snd = odd ? x0 : x1; u32x4 rcv; rcv.x = lane_xor1(snd.x); rcv.y = lane_xor1(snd.y); rcv.z = lane_xor1(snd.z); rcv.w = lane_xor1(snd.w);
            bf16_t* rp = base + (size_t)(row & ~1) * ld;
            *(u32x4*)rp = odd ? rcv : x0; *(u32x4*)(rp + ld) = odd ? x1 : rcv;
        )
    }
};
struct EpiQup {
    static constexpr bool PERM = true, WIDE = false;
    bf16_t* QM; const float *SSQ, *CS;
    __device__ __forceinline__ void operator()(AccRef acc, const Unit& u, int wr, int wc, int fr, int fq) const {
        const int pn = u.pn;
        if (pn < 2) {
            EPI_ROWS(
                const float rs = C2M * SSQ[(size_t)row * 2];
                _Pragma("unroll") for (int bj = 0; bj < 2; ++bj) { const int c = pn * 256 + bj * HALF + wc * 32 + 8 * fq, h = c >> 6, d = c & 63;
                    *(u32x4*)(QM + (size_t)row * 768 + h * 96 + d) = pack8(acc[ai][bj][m][0] * rs, acc[ai][bj][m][1] * rs); }
            )
        } else {
            const float sgn = (fq < 2) ? -1.f : 1.f;
            EPI_ROWS(
                const float rs = C2M * SSQ[(size_t)row * 2];
                const float* cs = CS + (size_t)row * 32 + ((8 * fq) & 15);
                f32x4 c0 = *(const f32x4*)(cs) * rs, c1 = *(const f32x4*)(cs + 4) * rs, s0 = *(const f32x4*)(cs + 16) * (rs * sgn), s1 = *(const f32x4*)(cs + 20) * (rs * sgn);
                _Pragma("unroll") for (int bj = 0; bj < 2; ++bj) { const int h = 4 * bj + wc; f32x4 o0, o1;
                    _Pragma("unroll") for (int i = 0; i < 4; ++i) {
                        const float v0 = acc[ai][bj][m][0][i], v1 = acc[ai][bj][m][1][i]; const float p0 = __shfl_xor(v0, 32), p1 = __shfl_xor(v1, 32);
                        o0[i] = v0 * c0[i] + p0 * s0[i]; o1[i] = v1 * c1[i] + p1 * s1[i]; }
                    *(u32x4*)(QM + (size_t)row * 768 + h * 96 + 64 + 8 * fq) = pack8(o0, o1); }
            )
        }
    }
};
struct EpiKvup {
    static constexpr bool PERM = true, WIDE = false;
    bf16_t* KN; const float* SSQ;
    __device__ __forceinline__ void operator()(AccRef acc, const Unit& u, int wr, int wc, int fr, int fq) const {
        bf16_t* base = KN + (size_t)(u.pn >> 1) * ((WS_VM - WS_KN) / 2) + (u.pn & 1) * 256 + wc * 32 + 8 * fq;
        EPI_ROWS(
            const float rs = SSQ[(size_t)row * 2 + 1];
            _Pragma("unroll") for (int bj = 0; bj < 2; ++bj) *(u32x4*)(base + (size_t)row * 512 + bj * HALF) = pack8(acc[ai][bj][m][0] * rs, acc[ai][bj][m][1] * rs);
        )
    }
};
template <int STEP> struct EpiMerge {
    static constexpr bool PERM = true, WIDE = true;
    bf16_t *T0, *MG; const bf16_t* G; const float* b_merge;
    __device__ __forceinline__ void operator()(AccRef acc, const Unit& u, int wr, int wc, int fr, int fq) const {
        const int c0 = u.pn * 256 + wc * 64 + 8 * fq; const bool odd = fr & 1;
        f32x4 bm[2][2];
        _Pragma("unroll") for (int bj = 0; bj < 2; ++bj) { bm[bj][0] = *(const f32x4*)(b_merge + STEP * 1024 + c0 + bj * 32); bm[bj][1] = *(const f32x4*)(b_merge + STEP * 1024 + c0 + bj * 32 + 4); }
        _Pragma("unroll") for (int ai = 0; ai < 2; ++ai) {
            u32x4 tv[4][2];
#if G_FP8
            u32x2 gv[4][2];
#else
            u32x4 gv[4][2];
#endif
            _Pragma("unroll") for (int m = 0; m < 4; ++m) _Pragma("unroll") for (int bj = 0; bj < 2; ++bj) { const size_t row = (size_t)(u.pm * BM + ai * HALF + wr * 64 + m * 16 + fr);
#if G_FP8
                gv[m][bj] = *(const u32x2*)((const unsigned char*)G + row * 2048 + STEP * 1024 + c0 + bj * 32);
#else
                gv[m][bj] = *(const u32x4*)(G + row * 2048 + STEP * 1024 + c0 + bj * 32);
#endif
                if (STEP == 1) tv[m][bj] = *(const u32x4*)(T0 + row * 1024 + c0 + bj * 32); }
            _Pragma("unroll") for (int m = 0; m < 4; ++m) { const size_t row = (size_t)(u.pm * BM + ai * HALF + wr * 64 + m * 16 + fr); u32x4 xo[2];
              _Pragma("unroll") for (int bj = 0; bj < 2; ++bj) {
                const f32x4 bm0 = bm[bj][0], bm1 = bm[bj][1];
                f32x4 a = acc[ai][bj][m][0], b = acc[ai][bj][m][1];
#if G_FP8
                { const u32x2 g = gv[m][bj];
                  const f32x2 g01 = __builtin_amdgcn_cvt_pk_f32_fp8((int)g.x, false), g23 = __builtin_amdgcn_cvt_pk_f32_fp8((int)g.x, true), g45 = __builtin_amdgcn_cvt_pk_f32_fp8((int)g.y, false), g67 = __builtin_amdgcn_cvt_pk_f32_fp8((int)g.y, true);
                  const f32x2 s01 = fsigmoid2(g01 + (f32x2){bm0[0], bm0[1]}), s23 = fsigmoid2(g23 + (f32x2){bm0[2], bm0[3]}), s45 = fsigmoid2(g45 + (f32x2){bm1[0], bm1[1]}), s67 = fsigmoid2(g67 + (f32x2){bm1[2], bm1[3]});
                  const f32x2 a01 = (f32x2){a[0], a[1]} * s01, a23 = (f32x2){a[2], a[3]} * s23, b01 = (f32x2){b[0], b[1]} * s45, b23 = (f32x2){b[2], b[3]} * s67;
                  a = (f32x4){a01.x, a01.y, a23.x, a23.y}; b = (f32x4){b01.x, b01.y, b23.x, b23.y}; }
#else
                const u32x4 g = gv[m][bj];
                a[0] *= fsigmoid(bflo(g.x) + bm0[0]); a[1] *= fsigmoid(bfhi(g.x) + bm0[1]); a[2] *= fsigmoid(bflo(g.y) + bm0[2]); a[3] *= fsigmoid(bfhi(g.y) + bm0[3]);
                b[0] *= fsigmoid(bflo(g.z) + bm1[0]); b[1] *= fsigmoid(bfhi(g.z) + bm1[1]); b[2] *= fsigmoid(bflo(g.w) + bm1[2]); b[3] *= fsigmoid(bfhi(g.w) + bm1[3]);
#endif
                if (STEP == 1) { const u32x4 t = tv[m][bj];
                    a[0] += bflo(t.x); a[1] += bfhi(t.x); a[2] += bflo(t.y); a[3] += bfhi(t.y); b[0] += bflo(t.z); b[1] += bfhi(t.z); b[2] += bflo(t.w); b[3] += bfhi(t.w);
#if WO_FP8
                    { _Pragma("unroll") for (int i = 0; i < 4; ++i) { a[i] = fminf(fmaxf(a[i] * 16.f, -448.f), 448.f); b[i] = fminf(fmaxf(b[i] * 16.f, -448.f), 448.f); }
                      const u32x2 q8 = pack8_fp8(a, b); xo[bj] = (u32x4){q8.x, q8.y, 0u, 0u}; } }
#else
                    xo[bj] = pack8(a, b); }
#endif
                else xo[bj] = pack8(a, b); }
#if WO_FP8
              if (STEP == 1) { const u32x2 s2 = odd ? (u32x2){xo[0].x, xo[0].y} : (u32x2){xo[1].x, xo[1].y}; u32x2 r2; r2.x = lane_xor1(s2.x); r2.y = lane_xor1(s2.y);
                unsigned char* rp = (unsigned char*)MG + (row & ~(size_t)1) * 1024 + c0 + (odd ? 32 : 0);
                *(u32x2*)rp = odd ? r2 : (u32x2){xo[0].x, xo[0].y}; *(u32x2*)(rp + 1024) = odd ? (u32x2){xo[1].x, xo[1].y} : r2; } else
#endif
              { const u32x4 snd = odd ? xo[0] : xo[1]; u32x4 rcv; rcv.x = lane_xor1(snd.x); rcv.y = lane_xor1(snd.y); rcv.z = lane_xor1(snd.z); rcv.w = lane_xor1(snd.w);
                bf16_t* rp = (STEP == 1 ? MG : T0) + (row & ~(size_t)1) * 1024 + c0 + (odd ? 32 : 0);
                *(u32x4*)rp = odd ? rcv : xo[0]; *(u32x4*)(rp + 1024) = odd ? xo[1] : rcv; } }
        }
    }
};
template <int MB> struct EpiWoT {
    static constexpr bool PERM = true, WIDE = (MB == 2);
    const float* x; bf16_t* X1;
    __device__ __forceinline__ void operator()(AccRef acc, const Unit& u, int wr, int wc, int fr, int fq) const {
        if constexpr (MB == 1) {
            const int c0 = u.pn * 256 + wc * 32 + 8 * fq;
            EPI_ROWS(
                const float* xl = x + (size_t)row * 1024 + c0; asm volatile("" : "+v"(xl));
                _Pragma("unroll") for (int bj = 0; bj < 2; ++bj) { const f32x4 xa = *(const f32x4*)(xl + bj * HALF), xb = *(const f32x4*)(xl + bj * HALF + 4);
                    *(u32x4*)(X1 + (size_t)row * 1024 + c0 + bj * HALF) = pack8(xa + acc[ai][bj][m][0], xb + acc[ai][bj][m][1]); }
            )
        } else {
        const int c0 = u.pn * 256 + wc * 64 + 8 * fq; const bool odd = fr & 1;
        _Pragma("unroll") for (int ai = 0; ai < 2; ++ai) _Pragma("unroll") for (int mh = 0; mh < 2; ++mh) {
            f32x4 xv[2][2][2];
            _Pragma("unroll") for (int mm = 0; mm < 2; ++mm) _Pragma("unroll") for (int bj = 0; bj < 2; ++bj) { const size_t off = (size_t)(u.pm * BM + ai * HALF + wr * 64 + (2 * mh + mm) * 16 + fr) * 1024 + c0 + bj * 32;
                xv[mm][bj][0] = *(const f32x4*)(x + off); xv[mm][bj][1] = *(const f32x4*)(x + off + 4); }
            _Pragma("unroll") for (int mm = 0; mm < 2; ++mm) { const int m = 2 * mh + mm; const size_t row = (size_t)(u.pm * BM + ai * HALF + wr * 64 + m * 16 + fr);
                const u32x4 x0 = pack8(xv[mm][0][0] + acc[ai][0][m][0], xv[mm][0][1] + acc[ai][0][m][1]), x1 = pack8(xv[mm][1][0] + acc[ai][1][m][0], xv[mm][1][1] + acc[ai][1][m][1]);
                const u32x4 snd = odd ? x0 : x1; u32x4 rcv; rcv.x = lane_xor1(snd.x); rcv.y = lane_xor1(snd.y); rcv.z = lane_xor1(snd.z); rcv.w = lane_xor1(snd.w);
                bf16_t* rp = X1 + (row & ~(size_t)1) * 1024 + c0 + (odd ? 32 : 0);
                *(u32x4*)rp = odd ? rcv : x0; *(u32x4*)(rp + 1024) = odd ? x1 : rcv; }
        }
        }
    }
};
#if WO_FP8
typedef EpiWoT<1> EpiWo;
#else
typedef EpiWoT<2> EpiWo;
#endif
template <bool F8> struct EpiSwiglu {
    static constexpr bool PERM = true, WIDE = false;
    bf16_t* ACT; const float* b_gu;
    __device__ __forceinline__ void operator()(AccRef acc, const Unit& u, int wr, int wc, int fr, int fq) const {
        const int c = u.pn * 128 + wc * 32 + 8 * fq; const float* bg = b_gu + (size_t)u.e * 2048 + c; const float sc = 1.f;
        const f32x4 g0 = *(const f32x4*)(bg), g1 = *(const f32x4*)(bg + 4), u0 = *(const f32x4*)(bg + 1024), u1 = *(const f32x4*)(bg + 1028);
        EPI_ROWS(
            f32x4 ga = acc[ai][0][m][0] * sc + g0, gb = acc[ai][0][m][1] * sc + g1, ua = acc[ai][1][m][0] * sc + u0, ub = acc[ai][1][m][1] * sc + u1, oa, ob;
            _Pragma("unroll") for (int i = 0; i < 4; ++i) {
                const f32x2 x = (f32x2){fminf(ga[i], 7.f), fminf(gb[i], 7.f)}, y = (f32x2){fminf(fmaxf(ua[i], -7.f), 7.f), fminf(fmaxf(ub[i], -7.f), 7.f)};
                const f32x2 r = (y + 1.f) * x * fsigmoid2(x * 1.702f);
                oa[i] = r.x; ob[i] = r.y; }
            if (F8) *(u32x2*)((unsigned char*)ACT + (size_t)row * 1024 + c) = pack8_fp8(oa, ob);
            else *(u32x4*)(ACT + (size_t)row * 1024 + c) = pack8(oa, ob);
        )
    }
};
template <bool F8> struct EpiDown {
    static constexpr bool PERM = true, WIDE = false;
    bf16_t* Z; const float* b_down; const int* ROWSLOT; const float* ROWW; const volatile PG8_LAS int* cntL; const volatile PG8_LAS int* bst;
    __device__ __forceinline__ void operator()(AccRef acc, const Unit& u, int wr, int wc, int fr, int fq) const {
        const int c0 = u.pn * 256 + wc * 32 + 8 * fq; const float* bd = b_down + (size_t)u.e * 1024 + c0; const float sc = 1.f;
#if FUSED_ROWS
        const int eb = u.e * ESTR + ((u.pm - bst[u.e]) << 8) - u.pm * BM;
#endif
        f32x4 bv[2][2];
        _Pragma("unroll") for (int bj = 0; bj < 2; ++bj) _Pragma("unroll") for (int n = 0; n < 2; ++n) bv[bj][n] = *(const f32x4*)(bd + bj * HALF + 4 * n);
        EPI_ROWS(
#if FUSED_ROWS
            const int slot = ROWSLOT[eb + row]; const float w = ROWW[eb + row];
#else
            const int slot = ROWSLOT[row]; const float w = ROWW[row];
#endif
#if Z_FP8
            const float w16 = w * 16.f;
            _Pragma("unroll") for (int bj = 0; bj < 2; ++bj)
                { f32x4 za = (acc[ai][bj][m][0] * sc + bv[bj][0]) * w16, zb = (acc[ai][bj][m][1] * sc + bv[bj][1]) * w16;
                    _Pragma("unroll") for (int i = 0; i < 4; ++i) { za[i] = fminf(fmaxf(za[i], -448.f), 448.f); zb[i] = fminf(fmaxf(zb[i], -448.f), 448.f); }
                    *(u32x2*)((unsigned char*)Z + (size_t)slot * 1024 + c0 + bj * HALF) = pack8_fp8(za, zb); }
#else
            _Pragma("unroll") for (int bj = 0; bj < 2; ++bj)
                *(u32x4*)(Z + (size_t)slot * 1024 + c0 + bj * HALF) = pack8((acc[ai][bj][m][0] * sc + bv[bj][0]) * w, (acc[ai][bj][m][1] * sc + bv[bj][1]) * w);
#endif
        )
    }
};
#undef EPI_ROWS
}

namespace att {
constexpr int KB_OFF = 0, K_OFF = 16384, KSLOT = 12288, V_OFF = K_OFF + 2 * KSLOT, VSLOT = 8192, OST_OFF = V_OFF + 2 * VSLOT, OST_W = 4608, ATT_LDS = OST_OFF + 8 * OST_W + 64;
constexpr int BG_STAGE_OFF = 96 * 1024;
static_assert(ATT_LDS <= BG_STAGE_OFF && BG_STAGE_OFF + 32768 <= RING_BYTES, "attention LDS");
typedef short v4i16_t __attribute__((ext_vector_type(4)));
__device__ __forceinline__ s16x4 vtr(const LAS unsigned char* p) { return __builtin_bit_cast(s16x4, __builtin_amdgcn_ds_read_tr16_b64_v4i16((LAS v4i16_t*)p)); }
__device__ __forceinline__ float xor32(float v) { return __shfl_xor(v, 32); }
__device__ __forceinline__ void glds16(const void* gsrc, unsigned lds_dst) { unsigned keep;
    asm volatile("s_mov_b32 %0, m0\n\ts_mov_b32 m0, %2\n\ts_nop 0\n\tglobal_load_lds_dwordx4 %1, off\n\ts_mov_b32 m0, %0" : "=&s"(keep) : "v"(gsrc), "s"(lds_dst) : "memory"); }

template <int DQ, bool FOX, class CV>
__device__ __forceinline__ void attn_unit(CV& cv, LAS unsigned char* lds, int b, int h, int qb, const bf16* Q, const bf16* K, const bf16* KP, const bf16* V, const float* KBg, bf16* O, float kmax2) {
    constexpr int QP = FOX ? 512 : 768, ND = DQ / 16;
    int tid_ = threadIdx.x; asm volatile("" : "+v"(tid_));
    const int tid = tid_, lane = tid & 63, r32 = lane & 31, hi = lane >> 5; const int wid = __builtin_amdgcn_readfirstlane(tid >> 6);
    const size_t rowbase = (size_t)b * SEQ; const int q0 = qb * 256, NT = q0 / 64 + 4, qw0 = q0 + 32 * wid, my_last = (qw0 + 31) >> 6;
    if (FOX) { const f32x4* src = (const f32x4*)(KBg + (size_t)(b * 8 + h) * SEQ); LAS f32x4* dst = (LAS f32x4*)(lds + KB_OFF);
        for (int i = tid; i < NT * 16; i += 512) dst[i] = src[i]; }
    bf16x8 qr[ND];
    { const bf16* Qw = Q + (rowbase + qw0 + r32) * QP + h * DQ + hi * 8;
#pragma unroll
      for (int d0 = 0; d0 < ND; ++d0) qr[d0] = *(const bf16x8*)(Qw + d0 * 16);
#pragma unroll
      for (int d0 = 0; d0 < ND; ++d0) asm volatile("" : "+v"(qr[d0])); }
    const bf16* ksrc = K + (rowbase + lane) * 512 + h * 64 + wid * 8;
    const bf16* kpsrc = KP + (rowbase + lane) * 32 + (wid & 3) * 8;
    const bf16* vsrc = V + (rowbase + 16 * (wid & 3) + (lane >> 2)) * 512 + h * 64 + (wid >> 2) * 32 + (lane & 3) * 8;
    const unsigned ldsb = (unsigned)(size_t)lds;
#define ATT_ISSUE(t, buf) do { \
        glds16(ksrc + (size_t)(t) * 64 * 512, (unsigned)__builtin_amdgcn_readfirstlane(ldsb + K_OFF + (buf) * KSLOT + wid * 1024)); \
        if (DQ > 64 && wid < 4) glds16(kpsrc + (size_t)(t) * 64 * 32, (unsigned)__builtin_amdgcn_readfirstlane(ldsb + K_OFF + (buf) * KSLOT + (8 + wid) * 1024)); \
        glds16(vsrc + (size_t)(t) * 64 * 512, (unsigned)__builtin_amdgcn_readfirstlane(ldsb + V_OFF + (buf) * VSLOT + wid * 1024)); } while (0)
    float m = 0.f, l = 0.f; f32x16 o0 = {}, o1 = {}, negm = {};
    float bq = 0.f; bool wdone = false;
    volatile LAS int* dflag = (volatile LAS int*)(lds + OST_OFF + 8 * OST_W);
    if (FOX) {
        float qs = 0.f;
#pragma unroll
        for (int d0 = 0; d0 < ND; ++d0)
#pragma unroll
            for (int j = 0; j < 8; ++j) { const float v = bf2f((bf16)qr[d0][j]); qs += v * v; }
        qs += xor32(qs);
        bq = sqrtf(qs) * sqrtf(kmax2) + 1.f;
        if (lane == 0) dflag[wid] = 0x7fffffff;
    }
    ATT_ISSUE(NT - 1, 0);
    if (wid >= 4) __builtin_amdgcn_s_setprio(1);
    for (int it = 0; it < NT; ++it) {
        const int t = NT - 1 - it;
        const bool full = (it == 0) || !(cv.pend && cv.age == 0);
        if (full) VM_WAIT(); else asm volatile("s_waitcnt vmcnt(4)" ::: "memory");
        LDS_WAIT(); __builtin_amdgcn_s_barrier(); asm volatile("" ::: "memory");
        if (FOX && it > 0) { int mxf = 0;
#pragma unroll
            for (int w8 = 0; w8 < 8; ++w8) mxf = max(mxf, dflag[w8]);
            if (mxf < it) break; }
        if (cv.pend) { if (full) cv.consume(lane); else cv.age = 1; }
        if (it + 1 < NT) ATT_ISSUE(t - 1, (it + 1) & 1);
        if (!FOX && !cv.pend) cv.issue(lane);
        __builtin_amdgcn_sched_barrier(0);
        if (t <= my_last && !wdone) {
            const LAS unsigned char* Kb = lds + K_OFF + (it & 1) * KSLOT + hi * 1024 + r32 * 16;
            const LAS unsigned char* vp = lds + V_OFF + (it & 1) * VSLOT + ((lane >> 4) & 1) * 32 + (lane & 3) * 8 + (4 * hi + ((lane & 15) >> 2)) * 64;
            bf16x8 kf[2 * ND]; s16x4 vt[16];
#pragma unroll
            for (int d0 = 0; d0 < ND; ++d0) { kf[2 * d0] = *(const LAS bf16x8*)(Kb + d0 * 2048); kf[2 * d0 + 1] = *(const LAS bf16x8*)(Kb + d0 * 2048 + 512); }
            f32x16 p0, p1;
            if (FOX) {
                const LAS float* kbt = (const LAS float*)(lds + KB_OFF) + t * 64 + 4 * hi;
#pragma unroll
                for (int g = 0; g < 4; ++g) { const f32x4 a = *(const LAS f32x4*)(kbt + 8 * g), c = *(const LAS f32x4*)(kbt + 32 + 8 * g);
                    const f32x2 mm = (f32x2){m, m};
                    const f32x2 a01 = (f32x2){a[0], a[1]} - mm, a23 = (f32x2){a[2], a[3]} - mm, c01 = (f32x2){c[0], c[1]} - mm, c23 = (f32x2){c[2], c[3]} - mm;
                    p0[4 * g] = a01.x; p0[4 * g + 1] = a01.y; p0[4 * g + 2] = a23.x; p0[4 * g + 3] = a23.y; p1[4 * g] = c01.x; p1[4 * g + 1] = c01.y; p1[4 * g + 2] = c23.x; p1[4 * g + 3] = c23.y; }
            }
#pragma unroll
            for (int k = 0; k < 4; ++k) { vt[4 * k] = vtr(vp + k * 1024); vt[4 * k + 1] = vtr(vp + k * 1024 + 512); vt[4 * k + 2] = vtr(vp + 4096 + k * 1024); vt[4 * k + 3] = vtr(vp + 4096 + k * 1024 + 512); }
            __builtin_amdgcn_sched_barrier(0);
            if (!FOX) { p0 = negm; p1 = negm; }
#pragma unroll
            for (int d0 = 0; d0 < ND; ++d0) {
                p0 = __builtin_amdgcn_mfma_f32_32x32x16_bf16(kf[2 * d0], qr[d0], p0, 0, 0, 0); p1 = __builtin_amdgcn_mfma_f32_32x32x16_bf16(kf[2 * d0 + 1], qr[d0], p1, 0, 0, 0); }
            const bool first = (t == my_last);
            if (FOX && first) { const int qabs = qw0 + r32, kv0 = t * 64 + 4 * hi;
#pragma unroll
                for (int r = 0; r < 16; ++r) { const int kv = kv0 + (r & 3) + 8 * (r >> 2); if (kv > qabs) p0[r] = -INFINITY; if (kv + 32 > qabs) p1[r] = -INFINITY; } }
            asm volatile("s_nop 15\n\ts_nop 3" : "+v"(p0), "+v"(p1));
            float mx;
            asm("v_max_f32 %0, %1, %2" : "=v"(mx) : "v"(p0[0]), "v"(p1[0]));
#pragma unroll
            for (int r = 1; r < 16; ++r) asm("v_max3_f32 %0, %1, %2, %3" : "=v"(mx) : "v"(mx), "v"(p0[r]), "v"(p1[r]));
            mx = fmaxf(mx, xor32(mx));
            if (first || __any(mx > 6.f)) {
                const float dl = first ? mx : fmaxf(mx, 0.f), al = __builtin_amdgcn_exp2f(-dl);
                m += dl; l *= al;
#pragma unroll
                for (int r = 0; r < 16; ++r) { p0[r] -= dl; p1[r] -= dl; o0[r] *= al; o1[r] *= al; negm[r] = -m; }
            }
            float sum = 0.f;
#pragma unroll
            for (int r = 0; r < 16; ++r) { p0[r] = __builtin_amdgcn_exp2f(p0[r]); p1[r] = __builtin_amdgcn_exp2f(p1[r]); sum += p0[r] + p1[r]; }
            l += sum;
            u32x4 pw[4];
#pragma unroll
            for (int k = 0; k < 2; ++k) {
                pw[k] = (u32x4){cvt_pk_bf16(p0[8 * k], p0[8 * k + 1]), cvt_pk_bf16(p0[8 * k + 2], p0[8 * k + 3]), cvt_pk_bf16(p0[8 * k + 4], p0[8 * k + 5]), cvt_pk_bf16(p0[8 * k + 6], p0[8 * k + 7])};
                pw[2 + k] = (u32x4){cvt_pk_bf16(p1[8 * k], p1[8 * k + 1]), cvt_pk_bf16(p1[8 * k + 2], p1[8 * k + 3]), cvt_pk_bf16(p1[8 * k + 4], p1[8 * k + 5]), cvt_pk_bf16(p1[8 * k + 6], p1[8 * k + 7])}; }
#pragma unroll
            for (int k = 0; k < 4; ++k) {
                const s16x4 a0 = vt[4 * k], a1 = vt[4 * k + 1], c0 = vt[4 * k + 2], c1 = vt[4 * k + 3];
                const bf16x8 vf0 = (bf16x8){a0[0], a0[1], a0[2], a0[3], a1[0], a1[1], a1[2], a1[3]}, vf1 = (bf16x8){c0[0], c0[1], c0[2], c0[3], c1[0], c1[1], c1[2], c1[3]};
                const bf16x8 pk = __builtin_bit_cast(bf16x8, pw[k]);
                o0 = __builtin_amdgcn_mfma_f32_32x32x16_bf16(vf0, pk, o0, 0, 0, 0); o1 = __builtin_amdgcn_mfma_f32_32x32x16_bf16(vf1, pk, o1, 0, 0, 0); }
            if (FOX && t > 0) { const float kbn = ((const LAS float*)(lds + KB_OFF))[64 * t - 1];
                if (__all(bq + kbn - m <= -40.f)) { wdone = true; if (lane == 0) dflag[wid] = it; } }
        }
    }
#undef ATT_ISSUE
    __builtin_amdgcn_s_setprio(0);
    l += xor32(l); const float il = 1.f / l;
    LAS bf16* stg = (LAS bf16*)(lds + OST_OFF + wid * OST_W);
#pragma unroll
    for (int g = 0; g < 4; ++g) {
        u32x2 w0, w1; w0.x = cvt_pk_bf16(o0[4 * g] * il, o0[4 * g + 1] * il); w0.y = cvt_pk_bf16(o0[4 * g + 2] * il, o0[4 * g + 3] * il);
        w1.x = cvt_pk_bf16(o1[4 * g] * il, o1[4 * g + 1] * il); w1.y = cvt_pk_bf16(o1[4 * g + 2] * il, o1[4 * g + 3] * il);
        *(LAS u32x2*)(stg + r32 * 72 + 8 * g + 4 * hi) = w0; *(LAS u32x2*)(stg + r32 * 72 + 32 + 8 * g + 4 * hi) = w1; }
    LDS_WAIT();
    bf16* Ow = O + (rowbase + qw0) * 512 + h * 64;
#pragma unroll
    for (int i = 0; i < 4; ++i) { const int row = i * 8 + (lane >> 3), ch = lane & 7; const u32x4 v = *(const LAS u32x4*)(stg + row * 72 + ch * 8); *(u32x4*)(Ow + (size_t)row * 512 + ch * 8) = v; }
    __syncthreads();
}
}

#define XB_TMO      128
#define XB_XCNT(j)  (256  + 64 * (j))
#define XB_XSUB(j)  (1280 + 64 * (j))
#define XB_XGEN(j)  (2304 + 64 * (j))
#define XB_TOP      3328
#define XB_TOPGEN   3392
#define XCD_BAR_WORDS 3456
#define XB_SPIN_CAP (1u << 18)
__device__ __forceinline__ unsigned xb_ld(unsigned* p)              { return __hip_atomic_load(p, __ATOMIC_RELAXED, __HIP_MEMORY_SCOPE_AGENT); }
__device__ __forceinline__ unsigned xb_add(unsigned* p, unsigned v) { return __hip_atomic_fetch_add(p, v, __ATOMIC_RELAXED, __HIP_MEMORY_SCOPE_AGENT); }
__device__ __forceinline__ unsigned xb_xcc_id() { return (unsigned)__builtin_amdgcn_s_getreg((3 << 11) | 20) & 0xFu; }
#define XB_SPIN(cond, bar) do { unsigned _sp = 0; while (cond) { __builtin_amdgcn_s_sleep(1); \
    if ((++_sp & 255u) == 0u) { if (xb_ld(&(bar)[XB_TMO])) break; if (_sp > XB_SPIN_CAP) { atomicAdd(&(bar)[XB_TMO], 1u); break; } } } } while (0)
struct XcdBarrier { unsigned* bar; unsigned x; volatile LAS unsigned* st; };
__device__ __forceinline__ XcdBarrier xcd_barrier_post(unsigned* bar, volatile LAS unsigned* st) {
    XcdBarrier b; b.bar = bar; b.x = xb_xcc_id(); b.st = st;
    if (threadIdx.x == 0) (void)xb_add(&bar[XB_XCNT(b.x)], 1u);
    return b;
}
__device__ __forceinline__ void xcd_barrier_complete(unsigned* bar, unsigned x, unsigned& nloc, unsigned& nx) {
    const unsigned G = gridDim.x * gridDim.y * gridDim.z;
    unsigned sum, cnt, mine, sp = 0u;
    for (;;) {
        sum = 0u; cnt = 0u; mine = 0u;
#pragma unroll
        for (unsigned j = 0; j < 16; ++j) { const unsigned c = xb_ld(&bar[XB_XCNT(j)]); sum += c; cnt += (c > 0u) ? 1u : 0u; mine = (j == x) ? c : mine; }
        if (sum == G) break;
        __builtin_amdgcn_s_sleep(1);
        if ((++sp & 255u) == 0u) { if (xb_ld(&bar[XB_TMO])) break; if (sp > XB_SPIN_CAP) { atomicAdd(&bar[XB_TMO], 1u); break; } }
    }
    nloc = mine > 0u ? mine : 1u; nx = cnt > 0u ? cnt : 1u;
}
__device__ __forceinline__ void xcd_barrier(const XcdBarrier& b) {
    asm volatile("s_waitcnt vmcnt(0)" ::: "memory");
    __syncthreads();
    if (threadIdx.x == 0) {
        unsigned* bar = b.bar;
        __builtin_amdgcn_s_waitcnt(0);
        unsigned nloc = b.st[0], nx = b.st[1];
        if (nloc == 0u) { xcd_barrier_complete(bar, b.x, nloc, nx); b.st[0] = nloc; b.st[1] = nx; }
        const unsigned old = xb_add(&bar[XB_XSUB(b.x)], 1u);
        const unsigned gen = old / nloc;
        if (old + 1u == (gen + 1u) * nloc) {
            __builtin_amdgcn_fence(__ATOMIC_RELEASE, "agent");
            asm volatile("s_waitcnt vmcnt(0)" ::: "memory");
            const unsigned og = xb_add(&bar[XB_TOP], 1u);
            const unsigned tg = og / nx;
            if (og + 1u == (tg + 1u) * nx) xb_add(&bar[XB_TOPGEN], 1u);
            else XB_SPIN(xb_ld(&bar[XB_TOPGEN]) == tg, bar);
            __builtin_amdgcn_fence(__ATOMIC_ACQUIRE, "agent");
            xb_add(&bar[XB_XGEN(b.x)], 1u);
            asm volatile("s_waitcnt vmcnt(0)" ::: "memory");
        } else {
            XB_SPIN(xb_ld(&bar[XB_XGEN(b.x)]) == gen, bar);
            __builtin_amdgcn_fence(__ATOMIC_ACQUIRE, "agent");
            asm volatile("s_waitcnt vmcnt(0)" ::: "memory");
        }
    }
    __syncthreads();
}

struct Frame { LAS unsigned char* lds; volatile LAS unsigned* MISC; int tid, wave, vcu, G; };

constexpr int W_SMALL = 128 * 16 + 24 * 4 + 32 * 4 + 32 * 8 + 32 * 8 + 32 * 16, W_ALL = W_SMALL + 32 * 64 * 16 + 32 * 32 * 16;
struct WItem { const float* src; const float* ksc; bf16* dst; int ldw, ldt, nvalid, fp8; };
__device__ __forceinline__ WItem wt_decode(const P& p, int it) {
    constexpr int I_WIN = 128 * 16, I_WQ = 24 * 4, I_WKV = 32 * 4, I_WF = 32 * 8, I_WM = 32 * 8, I_WO = 32 * 16, I_GU = 32 * 64 * 16;
    WItem w; w.ksc = nullptr; w.nvalid = 32; w.fp8 = 0; int r = it;
    if (r < I_WIN) { const int db = r & 127, kb = r >> 7, n = 32 * db; int src0;
        if (n < 1536) src0 = n; else if (n < 1792) src0 = C_QL + (n - 1536);
        else if (n < 2048) { const int j = n - 1792; if (j < 128) src0 = C_KV + j; else if (j == 128) src0 = C_KPE; else if (j == 160) { src0 = C_FL; w.nvalid = 8; } else { src0 = 0; w.nvalid = 0; } }
        else src0 = C_G + (n - 2048);
        w.src = p.w_in + (size_t)(64 * kb) * IN_COLS + src0; w.ldw = IN_COLS; w.dst = WSP(bf16, WS_WIN) + (size_t)n * 1024 + 64 * kb; w.ldt = 1024;
#if GATE_FP8
        if (n >= 2048) { w.fp8 = 1; w.dst = (bf16*)(WSP(unsigned char, WS_WIN8) + (size_t)(n - 2048) * 1024 + 64 * kb); }
#endif
        return w; }
    r -= I_WIN;
    if (r < I_WQ) { const int db = r % 24, kb = r / 24, n = 32 * db; const int src0 = (n < 512) ? (n >> 6) * 96 + (n & 63) : ((n - 512) >> 5) * 96 + 64;
        w.src = p.w_q_b + (size_t)(64 * kb) * 768 + src0; w.ldw = 768; w.ksc = p.g_q_a + 64 * kb; w.dst = WSP(bf16, WS_WQ) + (size_t)n * 256 + 64 * kb; w.ldt = 256; return w; }
    r -= I_WQ;
    if (r < I_WKV) { const int db = r & 31, kb = r >> 5, n = 32 * db; const int nn = n & 511; const int src0 = (nn >> 6) * 128 + (n >= 512 ? 64 : 0) + (nn & 63);
        w.src = p.w_kv_b + (size_t)((kb < 2) ? 64 * kb : 0) * 1024 + src0; w.ldw = 1024; w.ksc = p.g_kv_a + ((kb < 2) ? 64 * kb : 0); w.nvalid = (kb < 2) ? 32 : 0; w.dst = WSP(bf16, WS_WKV) + (size_t)n * 256 + 64 * kb; w.ldt = 256; return w; }
    r -= I_WKV;
    if (r < I_WF) { const int db = r & 31, kb = r >> 5; w.src = p.w_fox + (size_t)(64 * kb) * 1024 + 32 * db; w.ldw = 1024; w.dst = WSP(bf16, WS_WF) + (size_t)(32 * db) * 512 + 64 * kb; w.ldt = 512; return w; }
    r -= I_WF;
    if (r < I_WM) { const int db = r & 31, kb = r >> 5; w.src = p.w_mla + (size_t)(64 * kb) * 1024 + 32 * db; w.ldw = 1024; w.dst = WSP(bf16, WS_WM) + (size_t)(32 * db) * 512 + 64 * kb; w.ldt = 512; return w; }
    r -= I_WM;
    if (r < I_WO) { const int db = r & 31, kb = r >> 5; w.src = p.w_o + (size_t)(64 * kb) * 1024 + 32 * db; w.ldw = 1024; w.ldt = 1024;
#if WO_FP8
        w.fp8 = 1; w.dst = (bf16*)(WSP(unsigned char, WS_WO) + (size_t)(32 * db) * 1024 + 64 * kb);
#else
        w.dst = WSP(bf16, WS_WO) + (size_t)(32 * db) * 1024 + 64 * kb;
#endif
        return w; }
    r -= I_WO;
    if (r < I_GU) { const int e = r >> 10, rr = r & 1023, db = rr & 63, kb = rr >> 6, n = 32 * db; const int src0 = ((n >> 7) & 1) * 1024 + (n >> 8) * 128 + (n & 127);
        w.src = p.w_gu + (size_t)e * 1024 * 2048 + (size_t)(64 * kb) * 2048 + src0; w.ldw = 2048; w.ldt = 1024;
#if MOE_FP8
        w.fp8 = 1; w.dst = (bf16*)(WSP(unsigned char, WS_WGU) + (size_t)e * 2048 * 1024 + (size_t)n * 1024 + 64 * kb);
#else
        w.dst = WSP(bf16, WS_WGU) + (size_t)e * 2048 * 1024 + (size_t)n * 1024 + 64 * kb;
#endif
        return w; }
    r -= I_GU;
    { const int e = r >> 9, rr = r & 511, db = rr & 31, kb = rr >> 5;
        w.src = p.w_down + (size_t)e * 1024 * 1024 + (size_t)(64 * kb) * 1024 + 32 * db; w.ldw = 1024; w.ldt = 1024;
#if MOE_FP8
        w.fp8 = 1; w.dst = (bf16*)(WSP(unsigned char, WS_WD) + (size_t)e * 1024 * 1024 + (size_t)(32 * db) * 1024 + 64 * kb);
#else
        w.dst = WSP(bf16, WS_WD) + (size_t)e * 1024 * 1024 + (size_t)(32 * db) * 1024 + 64 * kb;
#endif
        return w; }
}
struct BgConv {
    const P* p; LAS unsigned char* scr; unsigned stage; int it, step, stride, age; bool active, pend; WItem w;
    __device__ __forceinline__ void init(const P& p_, LAS unsigned char* scr_, LAS unsigned char* stage_, int it0, int stride_) { p = &p_; scr = scr_; stage = (unsigned)(size_t)stage_; it = it0; stride = stride_; step = 0; age = 0; active = it0 < W_ALL; pend = false; w = wt_decode(p_, active ? it0 : W_SMALL); }
    __device__ __forceinline__ void issue(int lane) {
        if (!active) return;
        const float* g = w.src + (size_t)(8 * step + (lane >> 3)) * w.ldw + 4 * (lane & 7);
#pragma unroll
        for (int j = 0; j < 4; ++j) att::glds16(g + (size_t)(8 * j) * w.ldw, stage + 1024 * j);
        pend = true; age = 0;
    }
    __device__ __forceinline__ void consume(int lane) {
        if (!pend) return;
        pend = false;
        { const LAS unsigned char* sp = (const LAS unsigned char*)(size_t)stage + 16 * lane;
          f32x4 x[4];
#pragma unroll
          for (int j = 0; j < 4; ++j) x[j] = *(const LAS f32x4*)(sp + 1024 * j) * 32.f;
          LDS_WAIT(); asm volatile("" ::: "memory");
          LAS unsigned char* q = scr + (8 * step + (lane >> 3)) * 36 + 4 * (lane & 7);
#pragma unroll
          for (int j = 0; j < 4; ++j) { int b = __builtin_amdgcn_cvt_pk_fp8_f32(x[j][0], x[j][1], 0, false); b = __builtin_amdgcn_cvt_pk_fp8_f32(x[j][2], x[j][3], b, true); *(LAS int*)(q + 8 * 36 * j) = b; } }
        step += 4;
        if (step < 8) return;
        LDS_WAIT(); asm volatile("" ::: "memory");
        const int c = lane & 7, ng = lane >> 3;
        unsigned d[8];
#pragma unroll
        for (int q = 0; q < 8; ++q) d[q] = *(const LAS unsigned*)(scr + (8 * c + q) * 36 + 4 * ng);
        unsigned t[2][4];
#pragma unroll
        for (int h = 0; h < 2; ++h) {
            const unsigned p01l = __builtin_amdgcn_perm(d[4 * h + 1], d[4 * h], 0x05010400u), p01h = __builtin_amdgcn_perm(d[4 * h + 1], d[4 * h], 0x07030602u);
            const unsigned p23l = __builtin_amdgcn_perm(d[4 * h + 3], d[4 * h + 2], 0x05010400u), p23h = __builtin_amdgcn_perm(d[4 * h + 3], d[4 * h + 2], 0x07030602u);
            t[h][0] = __builtin_amdgcn_perm(p23l, p01l, 0x05040100u); t[h][1] = __builtin_amdgcn_perm(p23l, p01l, 0x07060302u);
            t[h][2] = __builtin_amdgcn_perm(p23h, p01h, 0x05040100u); t[h][3] = __builtin_amdgcn_perm(p23h, p01h, 0x07060302u); }
        unsigned char* dst = (unsigned char*)w.dst;
#pragma unroll
        for (int j = 0; j < 4; ++j) *(u32x2*)(dst + (size_t)(4 * ng + j) * w.ldt + 8 * c) = (u32x2){t[0][j], t[1][j]};
        LDS_WAIT(); asm volatile("" ::: "memory");
        step = 0; it += stride; active = it < W_ALL; if (active) w = wt_decode(*p, it);
    }
};
__device__ __forceinline__ void wt_load(const WItem& w, f32x4 (&v)[8], int lane) {
    const int n4 = lane & 7;
#pragma unroll
    for (int i = 0; i < 8; ++i) { const int kk = 8 * i + (lane >> 3); v[i] = (f32x4){0.f, 0.f, 0.f, 0.f};
        if (4 * n4 < w.nvalid) { v[i] = *(const f32x4*)(w.src + (size_t)kk * w.ldw + 4 * n4); if (w.ksc) v[i] = v[i] * w.ksc[kk]; } }
}
__device__ __forceinline__ void wt_store(const WItem& w, const f32x4 (&v)[8], LAS float* scr, int lane) {
    const int n4 = lane & 7;
#pragma unroll
    for (int i = 0; i < 8; ++i) { const int kk = 8 * i + (lane >> 3); LAS float* s = scr + kk * 33 + 4 * n4; s[0] = v[i][0]; s[1] = v[i][1]; s[2] = v[i][2]; s[3] = v[i][3]; }
    LDS_WAIT(); asm volatile("" ::: "memory");
    const int c = lane & 7;
#pragma unroll
    for (int j = 0; j < 4; ++j) { const int n = (lane >> 3) + 8 * j; const LAS float* s = scr + (8 * c) * 33 + n;
        if (w.fp8) { *(u32x2*)((unsigned char*)w.dst + (size_t)n * w.ldt + 8 * c) = pack8_fp8((f32x4){s[0 * 33], s[1 * 33], s[2 * 33], s[3 * 33]} * 32.f, (f32x4){s[4 * 33], s[5 * 33], s[6 * 33], s[7 * 33]} * 32.f); }
        else { u32x4 o; o.x = cvt_pk_bf16(s[0 * 33], s[1 * 33]); o.y = cvt_pk_bf16(s[2 * 33], s[3 * 33]); o.z = cvt_pk_bf16(s[4 * 33], s[5 * 33]); o.w = cvt_pk_bf16(s[6 * 33], s[7 * 33]);
            *(u32x4*)(w.dst + (size_t)n * w.ldt + 8 * c) = o; } }
    LDS_WAIT(); asm volatile("" ::: "memory");
}
__device__ __forceinline__ void wt_convert_range(const P& p, Frame& F, int lo, int hi) {
    LAS float* scr = (LAS float*)(F.lds + F.wave * 16384);
    const int gw = F.vcu * NWAVES + F.wave, NGW = F.G * NWAVES;
    int it = lo + gw; f32x4 va[8], vb[8];
    WItem wa = wt_decode(p, it < hi ? it : lo), wb = wa;
    if (it < hi) wt_load(wa, va, (F.tid & 63));
    while (it < hi) {
        const int nx = it + NGW;
        if (nx < hi) { wb = wt_decode(p, nx); wt_load(wb, vb, (F.tid & 63)); }
        wt_store(wa, va, scr, (F.tid & 63));
        it = nx; if (it >= hi) break;
        const int nx2 = it + NGW;
        if (nx2 < hi) { wa = wt_decode(p, nx2); wt_load(wa, va, (F.tid & 63)); }
        wt_store(wb, vb, scr, (F.tid & 63));
        it = nx2;
    }
}
__device__ __forceinline__ void p0_prologue(const P& p, Frame& F) {
    LAS float* scr = (LAS float*)(F.lds + F.wave * 16384);
    const int gw = F.vcu * NWAVES + F.wave, NGW = F.G * NWAVES;
    constexpr int NITEMS = W_SMALL;
    {
        int it = gw; f32x4 va[8], vb[8];
        WItem wa = wt_decode(p, it < NITEMS ? it : 0), wb = wa;
        if (it < NITEMS) wt_load(wa, va, (F.tid & 63));
        while (it < NITEMS) {
            const int nx = it + NGW;
            if (nx < NITEMS) { wb = wt_decode(p, nx); wt_load(wb, vb, (F.tid & 63)); }
            wt_store(wa, va, scr, (F.tid & 63));
            it = nx; if (it >= NITEMS) break;
            const int nx2 = it + NGW;
            if (nx2 < NITEMS) { wa = wt_decode(p, nx2); wt_load(wa, va, (F.tid & 63)); }
            wt_store(wb, vb, scr, (F.tid & 63));
            it = nx2;
        }
    }
    for (int m0 = gw; m0 < NTOK; m0 += 2 * NGW) {
        f32x4 v[2][4];
#pragma unroll
        for (int q = 0; q < 2; ++q) { const int mrow = (m0 + q * NGW < NTOK) ? m0 + q * NGW : m0; const f32x4* xr = (const f32x4*)(p.x + (size_t)mrow * DM) + (F.tid & 63);
#pragma unroll
            for (int j = 0; j < 4; ++j) v[q][j] = xr[64 * j]; }
#pragma unroll
        for (int q = 0; q < 2; ++q) { const int mrow = m0 + q * NGW; if (mrow >= NTOK) break;
            float s = 0.f;
#pragma unroll
            for (int j = 0; j < 4; ++j) s += (v[q][j].x * v[q][j].x + v[q][j].y * v[q][j].y) + (v[q][j].z * v[q][j].z + v[q][j].w * v[q][j].w);
            const float rs = 1.f / sqrtf(wave_sum(s) * (1.f / DM) + EPS);
            const f32x4* gr = (const f32x4*)p.g_attn + (F.tid & 63); u32x2* o8 = (u32x2*)(WSP(bf16, WS_H) + (size_t)mrow * DM) + (F.tid & 63);
#pragma unroll
            for (int j = 0; j < 4; ++j) { const f32x4 g = gr[64 * j]; const f32x4 hv = (f32x4){v[q][j].x * rs * g.x, v[q][j].y * rs * g.y, v[q][j].z * rs * g.z, v[q][j].w * rs * g.w};
                u32x2 w; w.x = cvt_pk_bf16(hv.x, hv.y); w.y = cvt_pk_bf16(hv.z, hv.w); o8[64 * j] = w;
#if GATE_FP8
                { int b8 = __builtin_amdgcn_cvt_pk_fp8_f32(hv.x, hv.y, 0, false); b8 = __builtin_amdgcn_cvt_pk_fp8_f32(hv.z, hv.w, b8, true); ((unsigned*)(WSP(unsigned char, WS_H8) + (size_t)mrow * DM))[(F.tid & 63) + 64 * j] = (unsigned)b8; }
#endif
            } }
    }
    if (blockIdx.x == 0 && F.tid < 64) WSP(unsigned, WS_MISC)[GM_KMAX + F.tid] = 0u;
    if (blockIdx.x == 0 && F.tid < 32) WSP(int, WS_MISC)[GM_CUR + F.tid] = 0;
    for (int idx = (F.vcu * NWAVES * 64) + F.tid; idx < NTOK * 16; idx += F.G * NWAVES * 64) {
        const int tok = idx >> 4, j = idx & 15;
        const float inv_freq = powf(10000.0f, -(float)j / 16.0f); const float ang = (float)p.pos[tok] * inv_freq;
        float* cs = WSP(float, WS_CS) + (size_t)tok * 32; cs[j] = cosf(ang); cs[16 + j] = sinf(ang);
    }
}
__device__ __forceinline__ void p2a_rows(const P& p, Frame& F) {
    const int gw = F.vcu * NWAVES + F.wave, l = (F.tid & 63); const int bb = gw >> 8, r0 = bb * SEQ + (gw & 255);
    float kmx = 0.f;
    for (int jb = 0; jb < 16; jb += 4) {
        u32x4 wv[4], kv[4];
#pragma unroll
        for (int q = 0; q < 4; ++q) { const int mrow = r0 + 256 * (jb + q); wv[q] = *((const u32x4*)(WSP(const bf16, WS_QL) + (size_t)mrow * 512) + l); kv[q] = *((const u32x4*)(WSP(const bf16, WS_KF) + (size_t)mrow * 512) + l); }
#pragma unroll
        for (int q = 0; q < 4; ++q) { const int mrow = r0 + 256 * (jb + q); const u32x4 w = wv[q];
            { const u32x4 k = kv[q]; const float k8[8] = {bflo(k.x), bfhi(k.x), bflo(k.y), bfhi(k.y), bflo(k.z), bfhi(k.z), bflo(k.w), bfhi(k.w)}; float ks = 0.f;
#pragma unroll
              for (int i = 0; i < 8; ++i) ks += k8[i] * k8[i];
              ks += __shfl_xor(ks, 1); ks += __shfl_xor(ks, 2); ks += __shfl_xor(ks, 4); kmx = fmaxf(kmx, ks); }
            float v[8] = {bflo(w.x), bfhi(w.x), bflo(w.y), bfhi(w.y), bflo(w.z), bfhi(w.z), bflo(w.w), bfhi(w.w)};
            float s = 0.f;
#pragma unroll
            for (int i = 0; i < 8; ++i) s += v[i] * v[i];
            const float sq = wave_sum(l < 32 ? s : 0.f), sk = wave_sum((l >= 32 && l < 48) ? s : 0.f);
            if (l == 0) { float* rs = WSP(float, WS_SSQ) + (size_t)mrow * 2; rs[0] = 1.f / sqrtf(sq * (1.f / 256) + EPS); rs[1] = 1.f / sqrtf(sk * (1.f / 128) + EPS); }
            float pv[8];
#pragma unroll
            for (int i = 0; i < 8; ++i) pv[i] = __shfl_xor(v[i], 2);
            if (l >= 48 && l < 52) {
                const int jq = 8 * (l - 48); const float* cs = WSP(const float, WS_CS) + (size_t)mrow * 32 + (jq & 15); const float sg = (jq < 16) ? -1.f : 1.f;
                float o[8];
#pragma unroll
                for (int i = 0; i < 8; ++i) o[i] = v[i] * cs[i] + sg * pv[i] * cs[16 + i];
                u32x4 ow; ow.x = cvt_pk_bf16(o[0], o[1]); ow.y = cvt_pk_bf16(o[2], o[3]); ow.z = cvt_pk_bf16(o[4], o[5]); ow.w = cvt_pk_bf16(o[6], o[7]);
                *(u32x4*)(WSP(bf16, WS_KPE) + (size_t)mrow * 32 + jq) = ow;
            }
            if (l == 52) {
                float* lf = WSP(float, WS_LOGF) + (size_t)mrow * 8;
#pragma unroll
                for (int i = 0; i < 8; ++i) { const float z = v[i] + p.b_fgate[i]; lf[i] = fminf(z, 0.f) - log1pf(expf(-fabsf(z))); }
            }
        }
    }
    if ((l & 7) == 0) atomicMax(WSP(unsigned, WS_MISC) + GM_KMAX + bb * 8 + (l >> 3), __float_as_uint(kmx));
}
__device__ __forceinline__ void p2_cumsum(const P& p, Frame& F, int bh) {
    const int b = bh >> 3, h = bh & 7, t = F.tid;
    const float* lf = WSP(const float, WS_LOGF) + ((size_t)b * SEQ + 8 * t) * 8 + h;
    float v[8], tot = 0.f;
#pragma unroll
    for (int i = 0; i < 8; ++i) { v[i] = lf[i * 8]; tot += v[i]; }
    float inc = tot;
#pragma unroll
    for (int o = 1; o < 64; o <<= 1) { const float x = __shfl_up(inc, o); if ((F.tid & 63) >= o) inc += x; }
    LAS float* wt = (LAS float*)(F.lds);
    if ((F.tid & 63) == 63) wt[F.wave] = inc;
    __syncthreads();
    float run = inc - tot;
    for (int w = 0; w < F.wave; ++w) run += wt[w];
    float* kb = WSP(float, WS_KB) + (size_t)bh * SEQ + 8 * t;
#pragma unroll
    for (int i = 0; i < 8; ++i) { run += v[i]; kb[i] = -run * LOG2E; }
    __syncthreads();
}
__device__ __forceinline__ void p6_router(const P& p, Frame& F) {
    LAS bf16x8* WRH = (LAS bf16x8*)F.lds; LAS bf16x8* WRL = WRH + 4096;
    for (int f = F.tid; f < 4096; f += NWAVES * 64) { const int ln = f & 63, nb = (f >> 6) & 1, ks = f >> 7; const float* src = p.w_router + (size_t)(32 * ks + 8 * (ln >> 4)) * 32 + 16 * nb + (ln & 15);
        bf16x8 h, lo;
#pragma unroll
        for (int j = 0; j < 8; ++j) { const float w = src[j * 32]; const unsigned hb = f2bf(w); h[j] = (short)hb; lo[j] = (short)f2bf(w - bf2f((bf16)hb)); }
        WRH[f] = h; WRL[f] = lo; }
    volatile LAS unsigned* hist = F.MISC + 32;
    if (F.tid < 32) hist[F.tid] = 0u;
    __syncthreads();
    const int wg = blockIdx.x, lane = (F.tid & 63), tr = lane & 15, kq = lane >> 4;
    const int tok0 = wg * 128 + F.wave * 16;
    const bf16* xr = WSP(const bf16, WS_X1) + (size_t)(tok0 + tr) * DM + 8 * kq;
    const float* gr = p.g_ffn + 8 * kq;
    f32x4 acc0 = {0.f, 0.f, 0.f, 0.f}, acc1 = {0.f, 0.f, 0.f, 0.f}; float ss = 0.f;
#pragma unroll 4
    for (int ks = 0; ks < 32; ++ks) {
        const u32x4 xw = *(const u32x4*)(xr + 32 * ks); const f32x4 x0 = (f32x4){bflo(xw.x), bfhi(xw.x), bflo(xw.y), bfhi(xw.y)}, x1 = (f32x4){bflo(xw.z), bfhi(xw.z), bflo(xw.w), bfhi(xw.w)}, g0 = *(const f32x4*)(gr + 32 * ks), g1 = *(const f32x4*)(gr + 32 * ks + 4);
        ss += (x0[0] * x0[0] + x0[1] * x0[1]) + (x0[2] * x0[2] + x0[3] * x0[3]) + (x1[0] * x1[0] + x1[1] * x1[1]) + (x1[2] * x1[2] + x1[3] * x1[3]);
        const f32x4 a0 = x0 * g0, a1 = x1 * g1;
        bf16x8 ah, al;
#pragma unroll
        for (int j = 0; j < 4; ++j) { const unsigned h0 = f2bf(a0[j]), h1 = f2bf(a1[j]); ah[j] = (short)h0; ah[4 + j] = (short)h1; al[j] = (short)f2bf(a0[j] - bf2f((bf16)h0)); al[4 + j] = (short)f2bf(a1[j] - bf2f((bf16)h1)); }
        const bf16x8 bh0 = WRH[(ks * 2 + 0) * 64 + lane], bh1 = WRH[(ks * 2 + 1) * 64 + lane], bl0 = WRL[(ks * 2 + 0) * 64 + lane], bl1 = WRL[(ks * 2 + 1) * 64 + lane];
        acc0 = __builtin_amdgcn_mfma_f32_16x16x32_bf16(ah, bh0, acc0, 0, 0, 0); acc1 = __builtin_amdgcn_mfma_f32_16x16x32_bf16(ah, bh1, acc1, 0, 0, 0);
        acc0 = __builtin_amdgcn_mfma_f32_16x16x32_bf16(al, bh0, acc0, 0, 0, 0); acc1 = __builtin_amdgcn_mfma_f32_16x16x32_bf16(al, bh1, acc1, 0, 0, 0);
        acc0 = __builtin_amdgcn_mfma_f32_16x16x32_bf16(ah, bl0, acc0, 0, 0, 0); acc1 = __builtin_amdgcn_mfma_f32_16x16x32_bf16(ah, bl1, acc1, 0, 0, 0);
    }
    ss += __shfl_xor(ss, 16); ss += __shfl_xor(ss, 32);
    const float rs = 1.f / sqrtf(ss * (1.f / DM) + EPS);
    LAS float* LG = (LAS float*)(F.lds + ROWTAB_OFF) + F.wave * 544;
#pragma unroll
    for (int r = 0; r < 4; ++r) { LG[(4 * kq + r) * 32 + tr] = acc0[r]; LG[(4 * kq + r) * 32 + 16 + tr] = acc1[r]; }
    if (kq == 0) LG[512 + tr] = rs;
    LDS_WAIT(); asm volatile("" ::: "memory");
    int idx[4] = {0, 0, 0, 0}, rnk[4] = {0, 0, 0, 0}; float wgt[4] = {0.f, 0.f, 0.f, 0.f};
    if (lane < 16) {
        const float rst = LG[512 + lane]; float lg[32];
#pragma unroll
        for (int c = 0; c < 8; ++c) { const f32x4 v = *(const LAS f32x4*)(LG + lane * 32 + 4 * c); const f32x4 b = *(const f32x4*)(p.b_router + 4 * c);
            lg[4 * c] = v[0] * rst + b[0]; lg[4 * c + 1] = v[1] * rst + b[1]; lg[4 * c + 2] = v[2] * rst + b[2]; lg[4 * c + 3] = v[3] * rst + b[3]; }
        float val[4];
#pragma unroll
        for (int k = 0; k < 4; ++k) { float bv = -INFINITY; int bi = 0;
#pragma unroll
            for (int e = 0; e < 32; ++e) { const bool tk = lg[e] > bv; bv = tk ? lg[e] : bv; bi = tk ? e : bi; }
            idx[k] = bi; val[k] = bv;
#pragma unroll
            for (int e = 0; e < 32; ++e) lg[e] = (e == bi) ? -INFINITY : lg[e]; }
        float ex[4], sum = 0.f;
#pragma unroll
        for (int k = 0; k < 4; ++k) { ex[k] = expf(val[k] - val[0]); sum += ex[k]; }
        const float inv = 1.f / sum; const int tok = tok0 + lane;
        *(u32x4*)(WSP(int, WS_TOPI) + tok * 4) = (u32x4){(unsigned)idx[0], (unsigned)idx[1], (unsigned)idx[2], (unsigned)idx[3]};
        *(f32x4*)(WSP(float, WS_TOPW) + tok * 4) = (f32x4){ex[0] * inv, ex[1] * inv, ex[2] * inv, ex[3] * inv};
#pragma unroll
        for (int k = 0; k < 4; ++k) { rnk[k] = (int)__hip_atomic_fetch_add((LAS unsigned*)(F.lds + MISC_OFF) + 32 + idx[k], 1u, __ATOMIC_RELAXED, __HIP_MEMORY_SCOPE_WORKGROUP); wgt[k] = ex[k] * inv; }
    }
#if MOE_FP8
    unsigned char* H2 = WSP(unsigned char, WS_H2) + (size_t)(tok0 + tr) * DM + 8 * kq;
#else
    bf16* H2 = WSP(bf16, WS_H2) + (size_t)(tok0 + tr) * DM + 8 * kq;
#endif
#pragma unroll 4
    for (int ks = 0; ks < 32; ++ks) {
        const u32x4 xw = *(const u32x4*)(xr + 32 * ks); const f32x4 x0 = (f32x4){bflo(xw.x), bfhi(xw.x), bflo(xw.y), bfhi(xw.y)}, x1 = (f32x4){bflo(xw.z), bfhi(xw.z), bflo(xw.w), bfhi(xw.w)}, g0 = *(const f32x4*)(gr + 32 * ks), g1 = *(const f32x4*)(gr + 32 * ks + 4);
#if MOE_FP8
        *(u32x2*)(H2 + 32 * ks) = pack8_fp8(x0 * g0 * rs, x1 * g1 * rs); }
#else
        *(u32x4*)(H2 + 32 * ks) = pack8(x0 * g0 * rs, x1 * g1 * rs); }
#endif
    __syncthreads();
#if FUSED_ROWS
    volatile LAS int* gbase = (volatile LAS int*)(F.MISC + 64);
    if (F.tid < 32) gbase[F.tid] = atomicAdd(WSP(int, WS_MISC) + GM_CUR + F.tid, (int)hist[F.tid]);
    __syncthreads();
    if (lane < 16) { const int tok = tok0 + lane;
#pragma unroll
        for (int k = 0; k < 4; ++k) { const size_t pos = (size_t)idx[k] * ESTR + gbase[idx[k]] + rnk[k];
            WSP(int, WS_EROWTOK)[pos] = tok; WSP(int, WS_EROWSLOT)[pos] = tok * 4 + k; WSP(float, WS_EROWW)[pos] = wgt[k]; } }
#else
    if (F.tid < 32) WSP(int, WS_MISC)[GM_CNT + wg * 32 + F.tid] = (int)hist[F.tid];
#endif
    __syncthreads();
}
__device__ __forceinline__ void p7_rows(const P& p, Frame& F) {
    const int wg = blockIdx.x, tid = F.tid;
    LAS int* part = (LAS int*)F.lds;
    LAS int* tot = part + 512; LAS int* pre = tot + 32; LAS int* pstart = pre + 32; LAS int* base = pstart + 33; LAS unsigned* lcnt = (LAS unsigned*)(base + 32);
    const int* cnt = WSP(const int, WS_MISC) + GM_CNT;
    { const int e = tid & 31, j = tid >> 5; int s = 0;
#pragma unroll
      for (int w = 0; w < 16; ++w) s += cnt[(j * 16 + w) * 32 + e];
      part[j * 32 + e] = s; }
    __syncthreads();
    if (tid < 32) { int t = 0, pr = 0;
        for (int j = 0; j < 16; ++j) { if (j < (wg >> 4)) pr += part[j * 32 + tid]; t += part[j * 32 + tid]; }
        for (int w = (wg & ~15); w < wg; ++w) pr += cnt[w * 32 + tid];
        tot[tid] = t; pre[tid] = pr; lcnt[tid] = 0u; }
    __syncthreads();
    if (tid == 0) { int s = 0; for (int e = 0; e < 32; ++e) { pstart[e] = s; s += ((tot[e] + 255) >> 8) << 8; } pstart[32] = s; }
    __syncthreads();
    if (tid < 32) base[tid] = pstart[tid] + pre[tid];
    __syncthreads();
    { const int a = wg * 512 + tid; const int e = WSP(const int, WS_TOPI)[a]; const float w = WSP(const float, WS_TOPW)[a];
      const int pos = base[e] + (int)__hip_atomic_fetch_add(lcnt + e, 1u, __ATOMIC_RELAXED, __HIP_MEMORY_SCOPE_WORKGROUP);
      WSP(int, WS_ROWTOK)[pos] = a >> 2; WSP(int, WS_ROWSLOT)[pos] = a; WSP(float, WS_ROWW)[pos] = w; }
    if (wg < 32) { const int e = wg; const int s0 = pstart[e] + tot[e], s1 = pstart[e + 1];
        for (int r = s0 + tid; r < s1; r += NWAVES * 64) { WSP(int, WS_ROWTOK)[r] = 0; WSP(int, WS_ROWSLOT)[r] = NTOK * 4; WSP(float, WS_ROWW)[r] = 0.f; } }
    if (wg == 0) {
        if (tid == 0) WSP(int, WS_MISC)[GM_NBLK] = pstart[32] >> 8;
        if (tid < 32) { for (int bk = pstart[tid] >> 8; bk < (pstart[tid + 1] >> 8); ++bk) WSP(int, WS_MISC)[GM_BLKE + bk] = tid; }
    }
    __syncthreads();
}
__device__ __forceinline__ void moe_setup(const P& p, Frame& F, pg8::MoeOrder& S, int shift, int gc_log2, bool gather) {
    LAS int* blke = (LAS int*)(F.lds + BLKE_OFF); LAS int* rowtab = (LAS int*)(F.lds + ROWTAB_OFF);
#if FUSED_ROWS
    volatile LAS int* cntL = (volatile LAS int*)(F.MISC + 32); volatile LAS int* bst = (volatile LAS int*)(F.MISC + 64);
    if (F.tid < 64) {
        const int l = F.tid, c = (l < 32) ? WSP(const int, WS_MISC)[GM_CUR + l] : 0, nb = (c + 255) >> 8;
        int inc = nb;
#pragma unroll
        for (int d = 1; d < 32; d <<= 1) { const int o = __shfl_up(inc, d); if (l >= d) inc += o; }
        if (l < 32) { cntL[l] = c; bst[l] = inc - nb; }
        if (l == 31) bst[32] = inc;
    }
    __syncthreads();
    const int nblk = bst[32];
    for (int i = F.tid; i < MAXBLK; i += NWAVES * 64) { int e = 0;
#pragma unroll
        for (int st = 16; st >= 1; st >>= 1) { if (bst[e + st] <= i) e += st; }
        blke[i] = (i < nblk) ? e : 0; }
    __syncthreads();
    S.init(nblk, F.G, (int)blockIdx.x, shift, gc_log2, (const LAS int*)blke);
    if (gather) {
        for (int i = 0; i < ROWTAB_UNITS; ++i) { const int rb = S.rb_of(i); if (rb >= nblk) break;
            if (F.tid < 256) { const int e = blke[rb], pos = ((rb - bst[e]) << 8) + F.tid; rowtab[i * 256 + F.tid] = (pos < cntL[e]) ? WSP(const int, WS_EROWTOK)[(size_t)e * ESTR + pos] : 0; } }
        if (blockIdx.x < 32) { const int e = (int)blockIdx.x, c0_ = cntL[e], c1_ = ((c0_ + 255) >> 8) << 8;
            for (int q = c0_ + F.tid; q < c1_; q += NWAVES * 64) { WSP(int, WS_EROWSLOT)[(size_t)e * ESTR + q] = NTOK * 4; WSP(float, WS_EROWW)[(size_t)e * ESTR + q] = 0.f; } }
    }
#else
    const int nblk = WSP(const int, WS_MISC)[GM_NBLK];
    for (int i = F.tid; i < MAXBLK; i += NWAVES * 64) blke[i] = (i < nblk) ? WSP(const int, WS_MISC)[GM_BLKE + i] : 0;
    S.init(nblk, F.G, (int)blockIdx.x, shift, gc_log2, (const LAS int*)blke);
    if (gather) {
        for (int i = 0; i < ROWTAB_UNITS; ++i) { const int rb = S.rb_of(i); if (rb >= nblk) break;
            if (F.tid < 256) rowtab[i * 256 + F.tid] = WSP(const int, WS_ROWTOK)[rb * 256 + F.tid]; }
    }
#endif
    __syncthreads();
}
__device__ __forceinline__ void p10_final(const P& p, Frame& F) {
    const int gw = F.vcu * NWAVES + F.wave, NGW = F.G * NWAVES, lane = F.tid & 63;
#if Z_FP8
    typedef float f32x2 __attribute__((ext_vector_type(2)));
    for (int m0 = gw; m0 < NTOK; m0 += 2 * NGW) {
        f32x4 v[2][4]; unsigned z[2][4][4];
#pragma unroll
        for (int q = 0; q < 2; ++q) { const int mrow = (m0 + q * NGW < NTOK) ? m0 + q * NGW : m0;
            const u32x2* xr = (const u32x2*)(WSP(const bf16, WS_X1) + (size_t)mrow * DM) + lane;
#pragma unroll
            for (int j = 0; j < 4; ++j) { const u32x2 xw = xr[64 * j]; v[q][j] = (f32x4){bflo(xw.x), bfhi(xw.x), bflo(xw.y), bfhi(xw.y)};
#pragma unroll
                for (int k = 0; k < 4; ++k) z[q][j][k] = *((const unsigned*)(WSP(const unsigned char, WS_Z) + ((size_t)mrow * 4 + k) * 1024) + lane + 64 * j); } }
#pragma unroll
        for (int q = 0; q < 2; ++q) { const int mrow = m0 + q * NGW; if (mrow >= NTOK) break;
            float s = 0.f;
#pragma unroll
            for (int j = 0; j < 4; ++j) { f32x4 a = {0.f, 0.f, 0.f, 0.f};
#pragma unroll
                for (int k = 0; k < 4; ++k) { const f32x2 lo = __builtin_amdgcn_cvt_pk_f32_fp8((int)z[q][j][k], false), hi = __builtin_amdgcn_cvt_pk_f32_fp8((int)z[q][j][k], true); a.x += lo.x; a.y += lo.y; a.z += hi.x; a.w += hi.y; }
                v[q][j] = v[q][j] + a * 0.0625f;
                s += (v[q][j].x * v[q][j].x + v[q][j].y * v[q][j].y) + (v[q][j].z * v[q][j].z + v[q][j].w * v[q][j].w); }
            const float rs = 1.f / sqrtf(wave_sum(s) * (1.f / DM) + EPS);
            f32x4* xo = (f32x4*)(p.out + (size_t)mrow * DM) + lane; const f32x4* gr = (const f32x4*)p.g_final + lane;
#pragma unroll
            for (int j = 0; j < 4; ++j) { const f32x4 g = gr[64 * j]; xo[64 * j] = (f32x4){v[q][j].x * rs * g.x, v[q][j].y * rs * g.y, v[q][j].z * rs * g.z, v[q][j].w * rs * g.w}; }
        }
    }
#else
    for (int m0 = gw; m0 < NTOK; m0 += 2 * NGW) {
        f32x4 v[2][4]; u32x2 z[2][4][4];
#pragma unroll
        for (int q = 0; q < 2; ++q) { const int mrow = (m0 + q * NGW < NTOK) ? m0 + q * NGW : m0;
            const u32x2* xr = (const u32x2*)(WSP(const bf16, WS_X1) + (size_t)mrow * DM) + lane;
#pragma unroll
            for (int j = 0; j < 4; ++j) { const u32x2 xw = xr[64 * j]; v[q][j] = (f32x4){bflo(xw.x), bfhi(xw.x), bflo(xw.y), bfhi(xw.y)};
#pragma unroll
                for (int k = 0; k < 4; ++k) z[q][j][k] = *((const u32x2*)(WSP(const bf16, WS_Z) + ((size_t)mrow * 4 + k) * 1024) + lane + 64 * j); } }
#pragma unroll
        for (int q = 0; q < 2; ++q) { const int mrow = m0 + q * NGW; if (mrow >= NTOK) break;
            float s = 0.f;
#pragma unroll
            for (int j = 0; j < 4; ++j) {
#pragma unroll
                for (int k = 0; k < 4; ++k) { v[q][j].x += bflo(z[q][j][k].x); v[q][j].y += bfhi(z[q][j][k].x); v[q][j].z += bflo(z[q][j][k].y); v[q][j].w += bfhi(z[q][j][k].y); }
                s += (v[q][j].x * v[q][j].x + v[q][j].y * v[q][j].y) + (v[q][j].z * v[q][j].z + v[q][j].w * v[q][j].w); }
            const float rs = 1.f / sqrtf(wave_sum(s) * (1.f / DM) + EPS);
            f32x4* xo = (f32x4*)(p.out + (size_t)mrow * DM) + lane; const f32x4* gr = (const f32x4*)p.g_final + lane;
#pragma unroll
            for (int j = 0; j < 4; ++j) { const f32x4 g = gr[64 * j]; xo[64 * j] = (f32x4){v[q][j].x * rs * g.x, v[q][j].y * rs * g.y, v[q][j].z * rs * g.z, v[q][j].w * rs * g.w}; }
        }
    }
#endif
}

constexpr int NPHASE = 12;
struct Args { P p; int ph_lo, ph_hi; };
__global__ void __launch_bounds__(NWAVES * 64, 2) mk_fwd(Args args) {
    extern __shared__ __attribute__((aligned(16))) unsigned char lds_raw[];
    const P& p = args.p;
    Frame F;
    F.lds = (LAS unsigned char*)lds_raw; F.MISC = (volatile LAS unsigned*)(F.lds + MISC_OFF);
    F.tid = threadIdx.x; F.wave = __builtin_amdgcn_readfirstlane(F.tid >> 6);
    F.G = gridDim.x; { const int bx = blockIdx.x; F.vcu = (F.G % 8 == 0) ? (bx % 8) * (F.G / 8) + bx / 8 : bx; }
    for (int u = F.tid; u < 256; u += NWAVES * 64) F.MISC[u] = 0u;
    __syncthreads();
    const int lo = args.ph_lo, hi = args.ph_hi;
    const bool one = (hi - lo) > 1;
    XcdBarrier bar; bar.bar = (unsigned*)(p.ws + WS_CTL) + 4096; bar.x = 0; bar.st = nullptr;
    if (one) bar = xcd_barrier_post((unsigned*)(p.ws + WS_CTL) + 4096, F.MISC + 8);
#ifndef PH_MASK
#define PH_MASK 0xfff
#endif
#define IN(k) (((PH_MASK >> (k)) & 1) && lo <= (k) && (k) < hi)
#define SEAM(k) do { if (IN(k) && IN((k) + 1)) xcd_barrier(bar); } while (0)
    using namespace pg8;
    const int bx = (int)blockIdx.x;
    if (IN(0)) { p0_prologue(p, F); } SEAM(0);
    if (IN(1)) {
#if GATE_FP8
        { Gemm g{WSP(const bf16, WS_H), WSP(const bf16, WS_WIN), 1024, 1024}; StaticOrder S; S.init(NTOK, 2048, F.G, bx);
          EpiInproj<false> E{p.ws};
          gemm_phase<EpiInproj<false>, StaticOrder, true, false>(F.lds, g, S, E, nullptr); }
        { Gemm g{WSP(const bf16, WS_H8), WSP(const bf16, WS_WIN8), 1024, 1024}; StaticOrder S; S.init(NTOK, 2048, F.G, bx);
          EpiInproj<true> E{p.ws};
          gemm_phase8<EpiInproj<true>, StaticOrder, true, false>(F.lds, g, S, E, nullptr); }
#else
        Gemm g{WSP(const bf16, WS_H), WSP(const bf16, WS_WIN), 1024, 1024}; StaticOrder S; S.init(NTOK, 4096, F.G, bx);
        EpiInproj<false> E{p.ws};
        gemm_phase<EpiInproj<false>, StaticOrder, true, false>(F.lds, g, S, E, nullptr);
#endif
    } SEAM(1);
    if (IN(2)) { p2a_rows(p, F); } SEAM(2);
    if (IN(3)) {
        if (F.vcu < 64) p2_cumsum(p, F, F.vcu);
        { Gemm g{WSP(const bf16, WS_QL), WSP(const bf16, WS_WQ), 256, 512}; StaticOrder S; S.init(NTOK, 768, F.G, (F.G == 256) ? (((bx & 7) + 6) & 7) * 32 + (bx >> 3) : bx);
          EpiQup E{WSP(bf16, WS_QM), WSP(const float, WS_SSQ), WSP(const float, WS_CS)};
          gemm_phase<EpiQup, StaticOrder, true, false>(F.lds, g, S, E, nullptr); }
        { Gemm g{WSP(const bf16, WS_QL) + 256, WSP(const bf16, WS_WKV), 256, 512}; StaticOrder S; S.init(NTOK, 1024, F.G, bx);
          EpiKvup E{WSP(bf16, WS_KN), WSP(const float, WS_SSQ)};
          gemm_phase<EpiKvup, StaticOrder, true, false>(F.lds, g, S, E, nullptr); }
    } SEAM(3);
    if (IN(4)) {
        BgConv cv; cv.init(p, F.lds + ROWTAB_OFF + F.wave * 2304, F.lds + att::BG_STAGE_OFF + F.wave * 4096, W_SMALL + F.vcu * NWAVES + F.wave, F.G * NWAVES);
        for (int j = F.vcu; j < 2048; j += F.G) {
            const int br = j >> 10, jj = j & 1023, r = jj >> 8, bh = (jj & 255) >> 2, s = jj & 3;
            const int qb = (r == 0) ? s : (r == 1) ? 7 - s : (r == 2) ? 8 + s : 15 - s;
            if (br == 0) att::attn_unit<64, true>(cv, F.lds, bh >> 3, bh & 7, qb, WSP(const bf16, WS_QF), WSP(const bf16, WS_KF), WSP(const bf16, WS_KPE), WSP(const bf16, WS_VF), WSP(const float, WS_KB), WSP(bf16, WS_YF), __uint_as_float(WSP(const unsigned, WS_MISC)[GM_KMAX + bh]));
            else att::attn_unit<96, false>(cv, F.lds, bh >> 3, bh & 7, qb, WSP(const bf16, WS_QM), WSP(const bf16, WS_KN), WSP(const bf16, WS_KPE), WSP(const bf16, WS_VM), WSP(const float, WS_KB), WSP(bf16, WS_YM), 0.f);
        }
        VM_WAIT(); cv.consume(F.tid & 63);
        while (cv.active) { cv.issue(F.tid & 63); VM_WAIT(); cv.consume(F.tid & 63); }
    } SEAM(4);
    if (IN(5)) {
        { Gemm g{WSP(const bf16, WS_YF), WSP(const bf16, WS_WF), 512, 512}; StaticOrder S; S.init(NTOK, 1024, F.G, bx);
          EpiMerge<0> E{WSP(bf16, WS_T0), WSP(bf16, WS_MG), WSP(const bf16, WS_G), p.b_merge};
          gemm_phase<EpiMerge<0>, StaticOrder, true, false>(F.lds, g, S, E, nullptr); }
        { Gemm g{WSP(const bf16, WS_YM), WSP(const bf16, WS_WM), 512, 512}; StaticOrder S; S.init(NTOK, 1024, F.G, bx);
          EpiMerge<1> E{WSP(bf16, WS_T0), WSP(bf16, WS_MG), WSP(const bf16, WS_G), p.b_merge};
          gemm_phase<EpiMerge<1>, StaticOrder, true, false>(F.lds, g, S, E, nullptr); }
    } SEAM(5);
    if (IN(6)) {
        StaticOrder S; S.init(NTOK, 1024, F.G, bx);
        EpiWo E{p.x, WSP(bf16, WS_X1)};
#if WO_FP8
        Gemm g{WSP(const bf16, WS_MG), WSP(const bf16, WS_WO), 1024, 1024, 0x7B7B7B7B};
        gemm_phase8<EpiWo, StaticOrder, true, false>(F.lds, g, S, E, nullptr);
#else
        Gemm g{WSP(const bf16, WS_MG), WSP(const bf16, WS_WO), 1024, 1024};
        gemm_phase<EpiWo, StaticOrder, true, false>(F.lds, g, S, E, nullptr);
#endif
    } SEAM(6);
    if (IN(7)) { p6_router(p, F); } SEAM(7);
#if !FUSED_ROWS
    if (IN(8)) { p7_rows(p, F); } SEAM(8);
#endif
    if (IN(9)) {
        MoeOrder S; moe_setup(p, F, S, 3, 1, true);
        Gemm g{WSP(const bf16, WS_H2), WSP(const bf16, WS_WGU), 1024, 1024};
        EpiSwiglu<MOE_FP8 != 0> E{WSP(bf16, WS_ACT), p.b_gu};
#if MOE_FP8
        gemm_phase8<EpiSwiglu<true>, MoeOrder, false, true>(F.lds, g, S, E, (const LAS int*)(F.lds + ROWTAB_OFF));
#else
        gemm_phase<EpiSwiglu<false>, MoeOrder, false, true>(F.lds, g, S, E, (const LAS int*)(F.lds + ROWTAB_OFF));
#endif
    } SEAM(9);
    if (IN(10)) {
        MoeOrder S; moe_setup(p, F, S, 2, 0, false);
        Gemm g{WSP(const bf16, WS_ACT), WSP(const bf16, WS_WD), 1024, 1024};
#if FUSED_ROWS
        EpiDown<MOE_FP8 != 0> E{WSP(bf16, WS_Z), p.b_down, WSP(const int, WS_EROWSLOT), WSP(const float, WS_EROWW), (const volatile LAS int*)(F.MISC + 32), (const volatile LAS int*)(F.MISC + 64)};
#else
        EpiDown<MOE_FP8 != 0> E{WSP(bf16, WS_Z), p.b_down, WSP(const int, WS_ROWSLOT), WSP(const float, WS_ROWW), nullptr, nullptr};
#endif
#if MOE_FP8
        gemm_phase8<EpiDown<true>, MoeOrder, true, false>(F.lds, g, S, E, nullptr);
#else
        gemm_phase<EpiDown<false>, MoeOrder, true, false>(F.lds, g, S, E, nullptr);
#endif
    } SEAM(10);
    if (IN(11)) { p10_final(p, F); }
#undef IN
#undef SEAM
}

extern "C" void kernel_launch(void* const* d_in, const int* in_sizes, int n_in, void* d_out, int out_size, void* d_ws, size_t ws_size, hipStream_t stream) {
    static int grid = 0;
    if (grid == 0) {
        if (n_in != 21 || out_size != NTOK * DM || ws_size < WS_END) { fprintf(stderr, "kernel_launch: unexpected sizes n_in %d out %d ws %zu\n", n_in, out_size, ws_size); grid = -1; return; }
        int dev = 0, cus = 0, per_cu = 0;
        if (hipGetDevice(&dev) != hipSuccess || hipDeviceGetAttribute(&cus, hipDeviceAttributeMultiprocessorCount, dev) != hipSuccess) { grid = -1; return; }
        if (hipFuncSetAttribute((const void*)mk_fwd, hipFuncAttributeMaxDynamicSharedMemorySize, LDS_BYTES) != hipSuccess) { fprintf(stderr, "kernel_launch: hipFuncSetAttribute failed\n"); grid = -1; return; }
        if (hipOccupancyMaxActiveBlocksPerMultiprocessor(&per_cu, (const void*)mk_fwd, NWAVES * 64, LDS_BYTES) != hipSuccess || per_cu < 1) { fprintf(stderr, "kernel_launch: occupancy query says %d\n", per_cu); }
        (void)hipGetLastError();
        if (cus != 256) { fprintf(stderr, "kernel_launch: built for 256 CUs, found %d\n", cus); grid = -1; return; }
        grid = 256;
    }
    if (grid < 0) return;
    P p{};
    p.x = (const float*)d_in[0]; p.pos = (const int*)d_in[1]; p.g_attn = (const float*)d_in[2]; p.w_in = (const float*)d_in[3]; p.b_fgate = (const float*)d_in[4];
    p.g_q_a = (const float*)d_in[5]; p.w_q_b = (const float*)d_in[6]; p.g_kv_a = (const float*)d_in[7]; p.w_kv_b = (const float*)d_in[8];
    p.w_fox = (const float*)d_in[9]; p.w_mla = (const float*)d_in[10]; p.b_merge = (const float*)d_in[11]; p.w_o = (const float*)d_in[12];
    p.g_ffn = (const float*)d_in[13]; p.w_router = (const float*)d_in[14]; p.b_router = (const float*)d_in[15];
    p.w_gu = (const float*)d_in[16]; p.b_gu = (const float*)d_in[17]; p.w_down = (const float*)d_in[18]; p.b_down = (const float*)d_in[19]; p.g_final = (const float*)d_in[20];
    p.out = (float*)d_out; p.ws = (unsigned char*)d_ws;
    (void)hipMemsetAsync((char*)d_ws + WS_CTL, 0, 64 * 1024, stream);
    Args a{}; a.p = p;
    a.ph_lo = 0; a.ph_hi = NPHASE;
    hipLaunchKernelGGL(mk_fwd, dim3(grid), dim3(NWAVES * 64), LDS_BYTES, stream, a);
}
```

```cpp
#include <hip/hip_runtime.h>
#include <cstdio>
#include <cstdint>

constexpr int DM = 1024, BATCH = 8, SEQ = 4096, NTOK = BATCH * SEQ;
constexpr int NE = 32, TOPK = 4, FF = 1024;
constexpr int IN_COLS = 4008;
constexpr int C_QF = 0, C_KF = 512, C_VF = 1024, C_FL = 1536, C_QL = 1544, C_KV = 1800, C_KPE = 1928, C_G = 1960;
constexpr float EPS = 1e-6f;
constexpr size_t SSQ2 = (size_t)NTOK * 4;
constexpr float LOG2E = 1.4426950408889634f;
constexpr float C2F = 0.125f * LOG2E;
constexpr float C2M = 0.10206207261596577f * LOG2E;

typedef unsigned short bf16;
__device__ __forceinline__ unsigned f2bf(float f) { unsigned u = __builtin_bit_cast(unsigned, f); return (u + 0x7fffu + ((u >> 16) & 1u)) >> 16; }
__device__ __forceinline__ float bf2f(bf16 b) { return __builtin_bit_cast(float, (unsigned)b << 16); }

constexpr size_t MiB = 1u << 20;
constexpr size_t WS_CTL = 0;
constexpr size_t WS_WIN = 2 * MiB, WS_WQ = 10 * MiB, WS_WKV = 10 * MiB + 512 * 1024, WS_WF = 11 * MiB, WS_WM = 12 * MiB, WS_WO = 13 * MiB;
constexpr size_t WS_WGU = 16 * MiB, WS_WD = 144 * MiB;
constexpr size_t WS_SSQ = 208 * MiB, WS_KPE = 209 * MiB, WS_LOGF = 211 * MiB, WS_CS = 212 * MiB, WS_KB = 216 * MiB, WS_TOPI = 217 * MiB, WS_TOPW = 217 * MiB + 512 * 1024;
constexpr size_t WS_ROWTOK = 218 * MiB, WS_ROWSLOT = 219 * MiB, WS_ROWW = 220 * MiB, WS_MISC = 221 * MiB;
constexpr size_t WS_T0 = 224 * MiB, WS_H2 = 224 * MiB, WS_MG = 288 * MiB;
constexpr size_t WS_A = 352 * MiB, WS_H = 352 * MiB, WS_QF = 416 * MiB, WS_KF = 448 * MiB, WS_VF = 480 * MiB, WS_QL = 512 * MiB, WS_QM = 544 * MiB, WS_ACT = 480 * MiB, WS_X1 = 352 * MiB;
constexpr size_t WS_B = 624 * MiB, WS_G = 624 * MiB, WS_KN = 752 * MiB, WS_VM = 784 * MiB, WS_YF = 816 * MiB, WS_YM = 848 * MiB, WS_Z = 624 * MiB;
constexpr size_t WS_H8 = 288 * MiB;
constexpr size_t WS_WIN8 = 2 * MiB + 4 * MiB;
constexpr size_t WS_END = 896 * MiB;

struct P {
    const float* x; const int* pos; const float* g_attn; const float* w_in; const float* b_fgate; const float* g_q_a; const float* w_q_b; const float* g_kv_a; const float* w_kv_b;
    const float* w_fox; const float* w_mla; const float* b_merge; const float* w_o; const float* g_ffn; const float* w_router; const float* b_router;
    const float* w_gu; const float* b_gu; const float* w_down; const float* b_down; const float* g_final;
    float* out; unsigned char* ws;
};
#define WSP(T, off) ((T*)(p.ws + (off)))

__device__ __forceinline__ float wave_sum(float v) {
#pragma unroll
    for (int o = 1; o < 64; o <<= 1) v += __shfl_xor(v, o);
    return v;
}

#ifndef GATE_FP8
#define GATE_FP8 1
#endif
#ifndef Z_FP8
#define G_FP8 1
#define WO_FP8 1
#define FUSED_ROWS 1
#define Z_FP8 1
#endif
#ifndef MOE_FP8
#define MOE_FP8 1
#endif
#define GAS __attribute__((address_space(1)))
#define LAS __attribute__((address_space(3)))
typedef unsigned u32x4 __attribute__((ext_vector_type(4)));
typedef unsigned u32x2 __attribute__((ext_vector_type(2)));
typedef float f32x4 __attribute__((ext_vector_type(4)));
typedef float f32x16 __attribute__((ext_vector_type(16)));
typedef short bf16x8 __attribute__((ext_vector_type(8)));
typedef short s16x4 __attribute__((ext_vector_type(4)));
typedef int v8i32 __attribute__((ext_vector_type(8)));
typedef int v4i32 __attribute__((ext_vector_type(4)));
typedef GAS unsigned gu32;
#define RLX_AGENT __ATOMIC_RELAXED, __HIP_MEMORY_SCOPE_AGENT
#define LDS_WAIT() asm volatile("s_waitcnt lgkmcnt(0)" ::: "memory")
#define VM_WAIT() asm volatile("s_waitcnt vmcnt(0)" ::: "memory")
__device__ __forceinline__ unsigned cvt_pk_bf16(float lo, float hi) { unsigned r; asm volatile("v_cvt_pk_bf16_f32 %0, %1, %2" : "=v"(r) : "v"(lo), "v"(hi)); return r; }
__device__ __forceinline__ u32x4 pack8(f32x4 a, f32x4 b) { u32x4 w; w.x = cvt_pk_bf16(a[0], a[1]); w.y = cvt_pk_bf16(a[2], a[3]); w.z = cvt_pk_bf16(b[0], b[1]); w.w = cvt_pk_bf16(b[2], b[3]); return w; }
__device__ __forceinline__ u32x2 pack8_fp8(f32x4 a, f32x4 b) { int w0 = __builtin_amdgcn_cvt_pk_fp8_f32(a[0], a[1], 0, false); w0 = __builtin_amdgcn_cvt_pk_fp8_f32(a[2], a[3], w0, true);
    int w1 = __builtin_amdgcn_cvt_pk_fp8_f32(b[0], b[1], 0, false); w1 = __builtin_amdgcn_cvt_pk_fp8_f32(b[2], b[3], w1, true); return (u32x2){(unsigned)w0, (unsigned)w1}; }
__device__ __forceinline__ float bflo(unsigned w) { return __builtin_bit_cast(float, w << 16); }
__device__ __forceinline__ float bfhi(unsigned w) { return __builtin_bit_cast(float, w & 0xffff0000u); }
typedef float f32x2 __attribute__((ext_vector_type(2)));
__device__ __forceinline__ f32x2 fsigmoid2(f32x2 z) { const f32x2 t = z * (-LOG2E); f32x2 e; e.x = __builtin_amdgcn_exp2f(t.x); e.y = __builtin_amdgcn_exp2f(t.y); const f32x2 d = e + 1.f; f32x2 r; r.x = __builtin_amdgcn_rcpf(d.x); r.y = __builtin_amdgcn_rcpf(d.y); return r; }
__device__ __forceinline__ unsigned lane_xor1(unsigned v) { return (unsigned)__builtin_amdgcn_mov_dpp((int)v, 0xB1, 0xF, 0xF, true); }
__device__ __forceinline__ float fsigmoid(float z) { return __builtin_amdgcn_rcpf(1.f + __builtin_amdgcn_exp2f(-z * LOG2E)); }

constexpr int RING_BYTES = 131072;
constexpr int MISC_OFF = RING_BYTES;
constexpr int BLKE_OFF = MISC_OFF + 1024;
constexpr int ROWTAB_OFF = BLKE_OFF + 2304;
constexpr int ROWTAB_UNITS = 18;
constexpr int LDS_BYTES = ROWTAB_OFF + ROWTAB_UNITS * 1024;
static_assert(LDS_BYTES <= 160 * 1024, "LDS");
static_assert(WS_VF - WS_KF == WS_KF - WS_QF, "QF/KF/VF equally spaced");
constexpr int NWAVES = 8;
constexpr int MAXBLK = 544;
constexpr int GM_NBLK = 0, GM_BLKE = 64, GM_CNT = 1024, GM_KMAX = 40000;
constexpr int GM_CUR = GM_CNT;
constexpr int ESTR = NTOK + 256;
constexpr size_t WS_EROWTOK = 80 * MiB, WS_EROWSLOT = 85 * MiB, WS_EROWW = 90 * MiB;

namespace pg8 {
#define PG8_LAS __attribute__((address_space(3)))
typedef unsigned short bf16_t;
constexpr int BM = 256, BK = 64, HALF = 128, HTB = HALF * BK * 2, STAGE_BYTES = 8 * HTB, NXCD = 8, WGM = 8;
__host__ __device__ __forceinline__ int lds_byte(int r, int c) { const int st = (r >> 4) * 2 + (c >> 5), rr = r & 15, cc = c & 31, ob = rr * 64 + cc * 2; return st * 1024 + (ob ^ (((ob >> 9) & 1) << 5)); }
__host__ __device__ __forceinline__ void stage_rc(int b, int& R, int& C) { const int st = b / 1024, sb = b % 1024, swz = sb ^ (((sb >> 9) & 1) << 5); R = (st >> 1) * 16 + swz / 64; C = (st & 1) * 32 + (swz % 64) / 2; }
__host__ __device__ __forceinline__ int perm32(int rho) { const int n = rho >> 4, i = rho & 15; return 8 * (i >> 2) + 4 * n + (i & 3); }

struct Unit { int pm, pn, bt, e; };
struct Gemm { const bf16_t* A; const bf16_t* Bt; int K, lda; int ascale = 0x7F7F7F7F; };

struct StaticOrder {
    int nM, nN, nwg, G, c;
    __device__ void init(int M, int N, int G_, int c_) { nM = M / BM; nN = N / BM; nwg = nM * nN; G = G_; c = c_; }
    __device__ bool next(int i, Unit& u) const {
        const long L = (long)i * G + c; if (L >= nwg) return false;
        int wgid = (int)L; { const int q = nwg / NXCD, r = nwg % NXCD, xcd = wgid % NXCD, off = wgid / NXCD; wgid = (xcd < r ? xcd * (q + 1) : r * (q + 1) + (xcd - r) * q) + off; }
        const int nig = WGM * nN, gid = wgid / nig, fm = gid * WGM, gsz = (nM - fm) < WGM ? (nM - fm) : WGM;
        u.pm = fm + ((wgid % nig) % gsz); u.pn = (wgid % nig) / gsz; u.bt = u.pn; u.e = 0; return true;
    }
};
struct LinearOrder {
    int nunits, G, c, shift;
    __device__ bool next(int i, Unit& u) const { const int idx = c + i * G; if (idx >= nunits) return false; u.pm = idx >> shift; u.pn = idx & ((1 << shift) - 1); u.bt = u.pn; u.e = 0; return true; }
};
struct MoeOrder {
    int nblk, s, g8, xr, gr, pn0, cpxs, shift; const PG8_LAS int* blke;
    __device__ void init(int nblk_, int G, int c, int shift_, int gc_log2, const PG8_LAS int* blke_) {
        nblk = nblk_; shift = shift_; blke = blke_; g8 = G >> 3; s = c >> 3; const int x = c & 7; gr = 8 >> gc_log2; xr = x & (gr - 1); const int xc = x / gr; cpxs = shift_ - gc_log2; pn0 = xc << cpxs; }
    __device__ int rb_of(int i) const { const int j = s + i * g8; return (j >> cpxs) * gr + xr; }
    __device__ bool next(int i, Unit& u) const {
        const int j = s + i * g8, rb = (j >> cpxs) * gr + xr; if (rb >= nblk) return false;
        const int pn = pn0 + (j & ((1 << cpxs) - 1)), e = blke[rb];
        u.pm = rb; u.pn = pn; u.e = e; u.bt = (e << shift) + pn; return true;
    }
};

template <class Epi, class Sched, bool ALIGN_EPI, bool GATHER>
__device__ __forceinline__ void gemm_phase(PG8_LAS unsigned char* lds, const Gemm g, const Sched& S, const Epi& E, const PG8_LAS int* rowtab) {
    int tid_ = threadIdx.x; asm volatile("" : "+v"(tid_));
    const int tid = tid_, wid = __builtin_amdgcn_readfirstlane(tid >> 6), lane = tid & 63, wr = wid >> 2, wc = wid & 3, fr = lane & 15, fq = lane >> 4;
    const int K = g.K, nt = K / BK, lda = g.lda;
    unsigned voffA[2], voffB[2]; int RA[2]; unsigned CA2[2];
#pragma unroll
    for (int i = 0; i < 2; ++i) { int R, C; stage_rc(tid * 16 + i * 8192, R, C); const int Rb = Epi::WIDE ? (64 * (R >> 5) + perm32(R & 31)) : Epi::PERM ? ((R & ~31) + perm32(R & 31)) : R;
        voffA[i] = (unsigned)(R * lda + C) * 2u; voffB[i] = (unsigned)(Rb * K + C) * 2u; RA[i] = R; CA2[i] = (unsigned)C * 2u; }
    const size_t kstep = (size_t)(BK * 2);
    const size_t hstepA = (size_t)HALF * lda * 2, tstepA = 2 * hstepA;
    const size_t hstepB = (size_t)(Epi::WIDE ? 32 : HALF) * K * 2, tstepB = (size_t)2 * HALF * K * 2;
    const unsigned ldsw = (unsigned)wid * 1024u;
    const int aoff = lds_byte(wr * 64 + fr, fq * 8), boff = lds_byte(wc * 32 + fr, fq * 8);
    unsigned va[2][2], vn[2][2];
#define PG8_SA(b, h) (((b) * 2 + (h)) * HTB)
#define PG8_SB(b, h) ((4 + (b) * 2 + (h)) * HTB)
#define PG8_STAGE(bufoff, gbase, voff) do { _Pragma("unroll") for (int _i = 0; _i < 2; ++_i) \
        __builtin_amdgcn_global_load_lds((const unsigned*)((const char*)(gbase) + (voff)[_i]), (PG8_LAS unsigned*)(lds + (bufoff) + ldsw + _i * 8192), 16, 0, 0); } while (0)
#define PG8_STAGE_A(bufoff, gbase, h, NXT) do { if constexpr (GATHER) { unsigned o_[2]; o_[0] = (NXT) ? vn[h][0] : va[h][0]; o_[1] = (NXT) ? vn[h][1] : va[h][1]; PG8_STAGE(bufoff, gbase, o_); } \
        else { PG8_STAGE(bufoff, (gbase) + (h) * hstepA, voffA); } } while (0)
#define PG8_LDA(dst, b, h) do { _Pragma("unroll") for (int m = 0; m < 4; ++m) _Pragma("unroll") for (int k = 0; k < 2; ++k) dst[m][k] = *(const PG8_LAS bf16x8*)(lds + PG8_SA(b, h) + aoff + m * 2048 + k * 1024); } while (0)
#define PG8_LDB(dst, b, h) do { _Pragma("unroll") for (int n = 0; n < 2; ++n) _Pragma("unroll") for (int k = 0; k < 2; ++k) dst[n][k] = *(const PG8_LAS bf16x8*)(lds + PG8_SB(b, h) + boff + n * 2048 + k * 1024); } while (0)
#define PG8_MMA(ai, bj, At, Bt) do { __builtin_amdgcn_s_setprio(1); _Pragma("unroll") for (int m = 0; m < 4; ++m) _Pragma("unroll") for (int n = 0; n < 2; ++n) _Pragma("unroll") for (int k = 0; k < 2; ++k) \
        acc[ai][bj][m][n] = __builtin_amdgcn_mfma_f32_16x16x32_bf16(Bt[n][k], At[m][k], acc[ai][bj][m][n], 0, 0, 0); __builtin_amdgcn_s_setprio(0); } while (0)
#define PG8_WAIT_V(n) asm volatile("s_waitcnt vmcnt(" #n ")" ::: "memory")
#define PG8_WAIT_L(n) asm volatile("s_waitcnt lgkmcnt(" #n ")" ::: "memory")
#define PG8_BAR __builtin_amdgcn_s_barrier()
#define PG8_SCHED __builtin_amdgcn_sched_barrier(0)
#define PG8_ROWOFF(dst, ui_) do { _Pragma("unroll") for (int h_ = 0; h_ < 2; ++h_) _Pragma("unroll") for (int i_ = 0; i_ < 2; ++i_) \
        dst[h_][i_] = (unsigned)rowtab[(ui_) * 256 + h_ * 128 + RA[i_]] * (unsigned)(lda * 2) + CA2[i_]; } while (0)
    Unit cur, nxt; int ui = 0;
    if (!S.next(0, cur)) return;
    f32x4 acc[2][2][4][2];
#pragma unroll
    for (int a = 0; a < 2; ++a)
#pragma unroll
        for (int b = 0; b < 2; ++b)
#pragma unroll
            for (int m = 0; m < 4; ++m)
#pragma unroll
                for (int n = 0; n < 2; ++n) acc[a][b][m][n] = (f32x4){0.f, 0.f, 0.f, 0.f};
    bf16x8 At[4][2], B0[2][2], B1[2][2];
    const char* cA = (const char*)g.A + (GATHER ? (size_t)0 : (size_t)cur.pm * tstepA); const char* cB = (const char*)g.Bt + (size_t)cur.bt * tstepB;
    if constexpr (GATHER) { PG8_ROWOFF(va, 0); }
    PG8_STAGE(PG8_SB(0, 0), cB, voffB); PG8_STAGE(PG8_SB(0, 1), cB + hstepB, voffB); PG8_STAGE_A(PG8_SA(0, 0), cA, 0, false); PG8_STAGE_A(PG8_SA(0, 1), cA, 1, false);
    if (wr == 1) PG8_BAR;
    PG8_WAIT_V(2); PG8_BAR;
    PG8_STAGE(PG8_SB(1, 0), cB + kstep, voffB); PG8_STAGE_A(PG8_SA(1, 0), cA + kstep, 0, false); PG8_STAGE(PG8_SB(1, 1), cB + hstepB + kstep, voffB);
    PG8_WAIT_V(6); PG8_BAR;
    for (;;) {
        const bool has_next = S.next(ui + 1, nxt);
        const char* nA = has_next ? (const char*)g.A + (GATHER ? (size_t)0 : (size_t)nxt.pm * tstepA) : cA; const char* nB = has_next ? (const char*)g.Bt + (size_t)nxt.bt * tstepB : cB;
        if constexpr (GATHER) { if (has_next) { PG8_ROWOFF(vn, ui + 1); } else {
#pragma unroll
            for (int h_ = 0; h_ < 2; ++h_)
#pragma unroll
                for (int i_ = 0; i_ < 2; ++i_) vn[h_][i_] = va[h_][i_]; } }
        for (int t = 0; t < nt; t += 2) {
            const bool last = (t == nt - 2);
            const char* a1 = cA + (size_t)(t + 1) * kstep;
            const char* a2 = last ? nA : cA + (size_t)(t + 2) * kstep; const char* b2 = last ? nB : cB + (size_t)(t + 2) * kstep;
            const char* a3 = a2 + kstep; const char* b3 = b2 + kstep;
            PG8_LDB(B0, 0, 0); PG8_LDB(B1, 0, 1); PG8_SCHED; PG8_LDA(At, 0, 0); PG8_STAGE_A(PG8_SA(1, 1), a1, 1, false);
            PG8_WAIT_V(8); PG8_WAIT_L(0); PG8_BAR; PG8_MMA(0, 0, At, B0); PG8_MMA(0, 1, At, B1); PG8_BAR; PG8_SCHED;
            PG8_LDA(At, 0, 1); PG8_STAGE(PG8_SB(0, 0), b2, voffB); PG8_STAGE(PG8_SB(0, 1), b2 + hstepB, voffB); PG8_STAGE_A(PG8_SA(0, 0), a2, 0, last);
            PG8_WAIT_V(8); PG8_WAIT_L(0); PG8_BAR; PG8_MMA(1, 0, At, B0); PG8_MMA(1, 1, At, B1); PG8_BAR; PG8_SCHED;
            PG8_LDB(B0, 1, 0); PG8_LDB(B1, 1, 1); PG8_SCHED; PG8_LDA(At, 1, 0); PG8_STAGE_A(PG8_SA(0, 1), a2, 1, last);
            PG8_WAIT_V(8); PG8_WAIT_L(0); PG8_BAR; PG8_MMA(0, 0, At, B0); PG8_MMA(0, 1, At, B1); PG8_BAR; PG8_SCHED;
            PG8_LDA(At, 1, 1); PG8_STAGE(PG8_SB(1, 0), b3, voffB); PG8_STAGE(PG8_SB(1, 1), b3 + hstepB, voffB); PG8_STAGE_A(PG8_SA(1, 0), a3, 0, last);
            PG8_WAIT_V(8); PG8_WAIT_L(0); PG8_BAR; PG8_MMA(1, 0, At, B0); PG8_MMA(1, 1, At, B1); PG8_BAR; PG8_SCHED;
        }
        if constexpr (ALIGN_EPI) { if (wr == 0) PG8_BAR; }
        E(acc, cur, wr, wc, fr, fq);
        if (!has_next) break;
#pragma unroll
        for (int a = 0; a < 2; ++a)
#pragma unroll
            for (int b = 0; b < 2; ++b)
#pragma unroll
                for (int m = 0; m < 4; ++m)
#pragma unroll
                    for (int n = 0; n < 2; ++n) acc[a][b][m][n] = (f32x4){0.f, 0.f, 0.f, 0.f};
        cur = nxt; cA = nA; cB = nB; ++ui;
        if constexpr (GATHER) {
#pragma unroll
            for (int h_ = 0; h_ < 2; ++h_)
#pragma unroll
                for (int i_ = 0; i_ < 2; ++i_) va[h_][i_] = vn[h_][i_]; }
        if constexpr (ALIGN_EPI) { if (wr == 1) PG8_BAR; }
    }
    PG8_WAIT_V(0);
    if constexpr (!ALIGN_EPI) { if (wr == 0) PG8_BAR; }
    PG8_BAR;
#undef PG8_SA
#undef PG8_SB
#undef PG8_STAGE
#undef PG8_STAGE_A
#undef PG8_LDA
#undef PG8_LDB
#undef PG8_MMA
#undef PG8_WAIT_V
#undef PG8_WAIT_L
#undef PG8_BAR
#undef PG8_SCHED
#undef PG8_ROWOFF
}

template <class Epi, class Sched, bool ALIGN_EPI, bool GATHER>
__device__ __forceinline__ void gemm_phase8(PG8_LAS unsigned char* lds, const Gemm g, const Sched& S, const Epi& E, const PG8_LAS int* rowtab) {
    int tid_ = threadIdx.x; asm volatile("" : "+v"(tid_));
    const int tid = tid_, wid = __builtin_amdgcn_readfirstlane(tid >> 6), lane = tid & 63, wr = wid >> 2, wc = wid & 3, fr = lane & 15, fq = lane >> 4;
    int K_ = g.K; asm volatile("" : "+s"(K_));
    const int K = K_, nt = K / 128, lda = g.lda;
    unsigned voffA[2], voffB[2]; int RA[2]; unsigned CA2[2];
#pragma unroll
    for (int i = 0; i < 2; ++i) { const int u = tid * 16 + i * 8192; const int R = 16 * (u >> 11) + ((u & 1023) >> 6), J = 4 * ((u >> 10) & 1) + (((u & 63) >> 4) ^ ((R >> 2) & 3)); const int Rb = Epi::WIDE ? (64 * (R >> 5) + perm32(R & 31)) : Epi::PERM ? ((R & ~31) + perm32(R & 31)) : R;
        voffA[i] = (unsigned)(R * lda + J * 16); voffB[i] = (unsigned)(Rb * K + J * 16); RA[i] = R; CA2[i] = (unsigned)(J * 16); }
    const size_t kstep = (size_t)128;
    const size_t hstepA = (size_t)HALF * lda, tstepA = 2 * hstepA;
    const size_t hstepB = (size_t)(Epi::WIDE ? 32 : HALF) * K, tstepB = (size_t)2 * HALF * K;
    const unsigned ldsw = (unsigned)wid * 1024u;
    const int aoff0 = wr * 8192 + fr * 64 + 16 * (fq ^ ((fr >> 2) & 3)), boff0 = wc * 4096 + fr * 64 + 16 * (fq ^ ((fr >> 2) & 3));
    unsigned va[2][2], vn[2][2];
#define PG8_SA(b, h) (((b) * 2 + (h)) * HTB)
#define PG8_SB(b, h) ((4 + (b) * 2 + (h)) * HTB)
#define PG8_STAGE(bufoff, gbase, voff) do { _Pragma("unroll") for (int _i = 0; _i < 2; ++_i) \
        __builtin_amdgcn_global_load_lds((const unsigned*)((const char*)(gbase) + (voff)[_i]), (PG8_LAS unsigned*)(lds + (bufoff) + ldsw + _i * 8192), 16, 0, 0); } while (0)
#define PG8_STAGE_A(bufoff, gbase, h, NXT) do { if constexpr (GATHER) { unsigned o_[2]; o_[0] = (NXT) ? vn[h][0] : va[h][0]; o_[1] = (NXT) ? vn[h][1] : va[h][1]; PG8_STAGE(bufoff, gbase, o_); } \
        else { PG8_STAGE(bufoff, (gbase) + (h) * hstepA, voffA); } } while (0)
#define PG8_LDA(dst, b, h) do { _Pragma("unroll") for (int m = 0; m < 4; ++m) { const v4i32 lo_ = *(const PG8_LAS v4i32*)(lds + PG8_SA(b, h) + aoff0 + m * 2048), hi_ = *(const PG8_LAS v4i32*)(lds + PG8_SA(b, h) + aoff0 + m * 2048 + 1024); dst[m] = __builtin_shufflevector(lo_, hi_, 0, 1, 2, 3, 4, 5, 6, 7); } } while (0)
#define PG8_LDB(dst, b, h) do { _Pragma("unroll") for (int n = 0; n < 2; ++n) { const v4i32 lo_ = *(const PG8_LAS v4i32*)(lds + PG8_SB(b, h) + boff0 + n * 2048), hi_ = *(const PG8_LAS v4i32*)(lds + PG8_SB(b, h) + boff0 + n * 2048 + 1024); dst[n] = __builtin_shufflevector(lo_, hi_, 0, 1, 2, 3, 4, 5, 6, 7); } } while (0)
#define PG8_F8(F_) ((v8i32){(int)F_[0][0], (int)F_[0][1], (int)F_[0][2], (int)F_[0][3], (int)F_[1][0], (int)F_[1][1], (int)F_[1][2], (int)F_[1][3]})
#define PG8_MMA(ai, bj, At, Bt) do { __builtin_amdgcn_s_setprio(1); _Pragma("unroll") for (int m = 0; m < 4; ++m) _Pragma("unroll") for (int n = 0; n < 2; ++n) \
        asm volatile("v_mfma_scale_f32_16x16x128_f8f6f4 %0, %1, %2, %0, %3, %4 op_sel_hi:[0,0,0]" : "+v"(acc[ai][bj][m][n]) : "v"(Bt[n]), "v"(At[m]), "v"(sclw_), "v"(scl_));     __builtin_amdgcn_s_setprio(0); } while (0)
#define PG8_WAIT_V(n) asm volatile("s_waitcnt vmcnt(" #n ")" ::: "memory")
#define PG8_WAIT_L(n) asm volatile("s_waitcnt lgkmcnt(" #n ")" ::: "memory")
#define PG8_BAR __builtin_amdgcn_s_barrier()
#define PG8_SCHED __builtin_amdgcn_sched_barrier(0)
#define PG8_ROWOFF(dst, ui_) do { _Pragma("unroll") for (int h_ = 0; h_ < 2; ++h_) _Pragma("unroll") for (int i_ = 0; i_ < 2; ++i_) \
        dst[h_][i_] = (unsigned)rowtab[(ui_) * 256 + h_ * 128 + RA[i_]] * (unsigned)lda + CA2[i_]; } while (0)
    Unit cur, nxt; int ui = 0;
    if (!S.next(0, cur)) return;
    int scl_ = g.ascale, sclw_ = 0x7A7A7A7A; asm volatile("" : "+v"(scl_), "+v"(sclw_));
    float z_ = 0.f; asm volatile("" : "+v"(z_));
    f32x4 acc[2][2][4][2];
#pragma unroll
    for (int a = 0; a < 2; ++a)
#pragma unroll
        for (int b = 0; b < 2; ++b)
#pragma unroll
            for (int m = 0; m < 4; ++m)
#pragma unroll
                for (int n = 0; n < 2; ++n) acc[a][b][m][n] = (f32x4){z_, z_, z_, z_};
    v8i32 At[4], B0[2], B1[2];
    const char* cA = (const char*)g.A + (GATHER ? (size_t)0 : (size_t)cur.pm * tstepA); const char* cB = (const char*)g.Bt + (size_t)cur.bt * tstepB;
    if constexpr (GATHER) { PG8_ROWOFF(va, 0); }
    PG8_STAGE(PG8_SB(0, 0), cB, voffB); PG8_STAGE(PG8_SB(0, 1), cB + hstepB, voffB); PG8_STAGE_A(PG8_SA(0, 0), cA, 0, false); PG8_STAGE_A(PG8_SA(0, 1), cA, 1, false);
    if (wr == 1) PG8_BAR;
    PG8_WAIT_V(2); PG8_BAR;
    PG8_STAGE(PG8_SB(1, 0), cB + kstep, voffB); PG8_STAGE_A(PG8_SA(1, 0), cA + kstep, 0, false); PG8_STAGE(PG8_SB(1, 1), cB + hstepB + kstep, voffB);
    PG8_WAIT_V(6); PG8_BAR;
    for (;;) {
        const bool has_next = S.next(ui + 1, nxt);
        const char* nA = has_next ? (const char*)g.A + (GATHER ? (size_t)0 : (size_t)nxt.pm * tstepA) : cA; const char* nB = has_next ? (const char*)g.Bt + (size_t)nxt.bt * tstepB : cB;
        asm volatile("" : "+s"(nB));
        if constexpr (GATHER) { if (has_next) { PG8_ROWOFF(vn, ui + 1); } else {
#pragma unroll
            for (int h_ = 0; h_ < 2; ++h_)
#pragma unroll
                for (int i_ = 0; i_ < 2; ++i_) vn[h_][i_] = va[h_][i_]; } }
#pragma unroll 1
        for (int t = 0; t < nt; t += 2) {
            const bool last = (t == nt - 2);
            const char* a1 = cA + (size_t)(t + 1) * kstep;
            const char* a2 = last ? nA : cA + (size_t)(t + 2) * kstep; const char* b2 = last ? nB : cB + (size_t)(t + 2) * kstep;
            const char* a3 = a2 + kstep; const char* b3 = b2 + kstep;
            PG8_LDB(B0, 0, 0); PG8_LDB(B1, 0, 1); PG8_SCHED; PG8_LDA(At, 0, 0); PG8_STAGE_A(PG8_SA(1, 1), a1, 1, false);
            PG8_WAIT_V(8); PG8_WAIT_L(0); PG8_BAR; PG8_MMA(0, 0, At, B0); PG8_MMA(0, 1, At, B1); PG8_BAR; PG8_SCHED;
            PG8_LDA(At, 0, 1); PG8_STAGE(PG8_SB(0, 0), b2, voffB); PG8_STAGE(PG8_SB(0, 1), b2 + hstepB, voffB); PG8_STAGE_A(PG8_SA(0, 0), a2, 0, last);
            PG8_WAIT_V(8); PG8_WAIT_L(0); PG8_BAR; PG8_MMA(1, 0, At, B0); PG8_MMA(1, 1, At, B1); PG8_BAR; PG8_SCHED;
            PG8_LDB(B0, 1, 0); PG8_LDB(B1, 1, 1); PG8_SCHED; PG8_LDA(At, 1, 0); PG8_STAGE_A(PG8_SA(0, 1), a2, 1, last);
            PG8_WAIT_V(8); PG8_WAIT_L(0); PG8_BAR; PG8_MMA(0, 0, At, B0); PG8_MMA(0, 1, At, B1); PG8_BAR; PG8_SCHED;
            PG8_LDA(At, 1, 1); PG8_STAGE(PG8_SB(1, 0), b3, voffB); PG8_STAGE(PG8_SB(1, 1), b3 + hstepB, voffB); PG8_STAGE_A(PG8_SA(1, 0), a3, 0, last);
            PG8_WAIT_V(8); PG8_WAIT_L(0); PG8_BAR; PG8_MMA(1, 0, At, B0); PG8_MMA(1, 1, At, B1); PG8_BAR; PG8_SCHED;
        }
        if constexpr (ALIGN_EPI) { if (wr == 0) PG8_BAR; }
        asm volatile("s_nop 15\n\ts_nop 7" ::: "memory");
        E(acc, cur, wr, wc, fr, fq);
        if (!has_next) break;
#pragma unroll
        for (int a = 0; a < 2; ++a)
#pragma unroll
            for (int b = 0; b < 2; ++b)
#pragma unroll
                for (int m = 0; m < 4; ++m)
#pragma unroll
                    for (int n = 0; n < 2; ++n) acc[a][b][m][n] = (f32x4){z_, z_, z_, z_};
        cur = nxt; cA = nA; cB = nB; ++ui;
        if constexpr (GATHER) {
#pragma unroll
            for (int h_ = 0; h_ < 2; ++h_)
#pragma unroll
                for (int i_ = 0; i_ < 2; ++i_) va[h_][i_] = vn[h_][i_]; }
        if constexpr (ALIGN_EPI) { if (wr == 1) PG8_BAR; }
    }
    PG8_WAIT_V(0);
    if constexpr (!ALIGN_EPI) { if (wr == 0) PG8_BAR; }
    PG8_BAR;
#undef PG8_SA
#undef PG8_SB
#undef PG8_STAGE
#undef PG8_STAGE_A
#undef PG8_LDA
#undef PG8_LDB
#undef PG8_MMA
#undef PG8_WAIT_V
#undef PG8_WAIT_L
#undef PG8_BAR
#undef PG8_SCHED
#undef PG8_ROWOFF
#undef PG8_F8
}


typedef const f32x4 (&AccRef)[2][2][4][2];
#define EPI_ROWS(...) _Pragma("unroll") for (int ai = 0; ai < 2; ++ai) _Pragma("unroll") for (int m = 0; m < 4; ++m) { const int row = u.pm * BM + ai * HALF + wr * 64 + m * 16 + fr; __VA_ARGS__ }

template <bool F8> struct EpiInproj {
    static constexpr bool PERM = true, WIDE = !F8;
    unsigned char* ws;
    __device__ __forceinline__ void operator()(AccRef acc, const Unit& u, int wr, int wc, int fr, int fq) const {
        if constexpr (F8) {
            unsigned char* gb = ws + WS_G + (size_t)(u.pn * 256 + wc * 32 + 8 * fq);
            EPI_ROWS(
                unsigned char* rp = gb + (size_t)row * 2048;
                _Pragma("unroll") for (int bj = 0; bj < 2; ++bj) *(u32x2*)(rp + bj * HALF) = pack8_fp8(acc[ai][bj][m][0], acc[ai][bj][m][1]);
            )
            return;
        }
        const int pn = u.pn; const bool odd = fr & 1;
#if G_FP8
        if (pn >= 8) {
            unsigned char* gb = ws + WS_G + (size_t)((pn - 8) * 256 + wc * 64 + 8 * fq + (odd ? 32 : 0));
            EPI_ROWS(
                const u32x2 x0 = pack8_fp8(acc[ai][0][m][0], acc[ai][0][m][1]), x1 = pack8_fp8(acc[ai][1][m][0], acc[ai][1][m][1]);
                const u32x2 snd = odd ? x0 : x1; u32x2 rcv; rcv.x = lane_xor1(snd.x); rcv.y = lane_xor1(snd.y);
                unsigned char* rp = gb + (size_t)(row & ~1) * 2048;
                *(u32x2*)rp = odd ? rcv : x0; *(u32x2*)(rp + 2048) = odd ? x1 : rcv;
            )
            return;
        }
#endif
        const size_t off = pn < 6 ? WS_QF + (size_t)(pn >> 1) * (WS_KF - WS_QF) : pn < 8 ? WS_QL : WS_G;
        const int ld = pn < 8 ? 512 : 2048, col0 = (pn < 6 ? (pn & 1) : pn < 8 ? (pn - 6) : (pn - 8)) * 256 + wc * 64 + 8 * fq + (odd ? 32 : 0);
        const float sc = (pn < 2 ? C2F : 1.f);
        bf16_t* base = (bf16_t*)(ws + off) + col0;
        EPI_ROWS(
            const u32x4 x0 = pack8(acc[ai][0][m][0] * sc, acc[ai][0][m][1] * sc), x1 = pack8(acc[ai][1][m][0] * sc, acc[ai][1][m][1] * sc);
            const u32x4 snd = odd ? x0 : x1; u32x4 rcv; rcv.x = lane_xor1(snd.x); rcv.y = lane_xor1(snd.y); rcv.z = lane_xor1(snd.z); rcv.w = lane_xor1(snd.w);
            bf16_t* rp = base + (size_t)(row & ~1) * ld;
            *(u32x4*)rp = odd ? rcv : x0; *(u32x4*)(rp + ld) = odd ? x1 : rcv;
        )
    }
};
struct EpiQup {
    static constexpr bool PERM = true, WIDE = false;
    bf16_t* QM; const float *SSQ, *CS;
    __device__ __forceinline__ void operator()(AccRef acc, const Unit& u, int wr, int wc, int fr, int fq) const {
        const int pn = u.pn;
        if (pn < 2) {
            EPI_ROWS(
                const float rs = C2M * SSQ[(size_t)row * 2];
                _Pragma("unroll") for (int bj = 0; bj < 2; ++bj) { const int c = pn * 256 + bj * HALF + wc * 32 + 8 * fq, h = c >> 6, d = c & 63;
                    *(u32x4*)(QM + (size_t)row * 768 + h * 96 + d) = pack8(acc[ai][bj][m][0] * rs, acc[ai][bj][m][1] * rs); }
            )
        } else {
            const float sgn = (fq < 2) ? -1.f : 1.f;
            EPI_ROWS(
                const float rs = C2M * SSQ[(size_t)row * 2];
                const float* cs = CS + (size_t)row * 32 + ((8 * fq) & 15);
                f32x4 c0 = *(const f32x4*)(cs) * rs, c1 = *(const f32x4*)(cs + 4) * rs, s0 = *(const f32x4*)(cs + 16) * (rs * sgn), s1 = *(const f32x4*)(cs + 20) * (rs * sgn);
                _Pragma("unroll") for (int bj = 0; bj < 2; ++bj) { const int h = 4 * bj + wc; f32x4 o0, o1;
                    _Pragma("unroll") for (int i = 0; i < 4; ++i) {
                        const float v0 = acc[ai][bj][m][0][i], v1 = acc[ai][bj][m][1][i]; const float p0 = __shfl_xor(v0, 32), p1 = __shfl_xor(v1, 32);
                        o0[i] = v0 * c0[i] + p0 * s0[i]; o1[i] = v1 * c1[i] + p1 * s1[i]; }
                    *(u32x4*)(QM + (size_t)row * 768 + h * 96 + 64 + 8 * fq) = pack8(o0, o1); }
            )
        }
    }
};
struct EpiKvup {
    static constexpr bool PERM = true, WIDE = false;
    bf16_t* KN; const float* SSQ;
    __device__ __forceinline__ void operator()(AccRef acc, const Unit& u, int wr, int wc, int fr, int fq) const {
        bf16_t* base = KN + (size_t)(u.pn >> 1) * ((WS_VM - WS_KN) / 2) + (u.pn & 1) * 256 + wc * 32 + 8 * fq;
        EPI_ROWS(
            const float rs = SSQ[(size_t)row * 2 + 1];
            _Pragma("unroll") for (int bj = 0; bj < 2; ++bj) *(u32x4*)(base + (size_t)row * 512 + bj * HALF) = pack8(acc[ai][bj][m][0] * rs, acc[ai][bj][m][1] * rs);
        )
    }
};
template <int STEP> struct EpiMerge {
    static constexpr bool PERM = true, WIDE = true;
    bf16_t *T0, *MG; const bf16_t* G; const float* b_merge;
    __device__ __forceinline__ void operator()(AccRef acc, const Unit& u, int wr, int wc, int fr, int fq) const {
        const int c0 = u.pn * 256 + wc * 64 + 8 * fq; const bool odd = fr & 1;
        f32x4 bm[2][2];
        _Pragma("unroll") for (int bj = 0; bj < 2; ++bj) { bm[bj][0] = *(const f32x4*)(b_merge + STEP * 1024 + c0 + bj * 32); bm[bj][1] = *(const f32x4*)(b_merge + STEP * 1024 + c0 + bj * 32 + 4); }
        _Pragma("unroll") for (int ai = 0; ai < 2; ++ai) {
            u32x4 tv[4][2];
#if G_FP8
            u32x2 gv[4][2];
#else
            u32x4 gv[4][2];
#endif
            _Pragma("unroll") for (int m = 0; m < 4; ++m) _Pragma("unroll") for (int bj = 0; bj < 2; ++bj) { const size_t row = (size_t)(u.pm * BM + ai * HALF + wr * 64 + m * 16 + fr);
#if G_FP8
                gv[m][bj] = *(const u32x2*)((const unsigned char*)G + row * 2048 + STEP * 1024 + c0 + bj * 32);
#else
                gv[m][bj] = *(const u32x4*)(G + row * 2048 + STEP * 1024 + c0 + bj * 32);
#endif
                if (STEP == 1) tv[m][bj] = *(const u32x4*)(T0 + row * 1024 + c0 + bj * 32); }
            _Pragma("unroll") for (int m = 0; m < 4; ++m) { const size_t row = (size_t)(u.pm * BM + ai * HALF + wr * 64 + m * 16 + fr); u32x4 xo[2];
              _Pragma("unroll") for (int bj = 0; bj < 2; ++bj) {
                const f32x4 bm0 = bm[bj][0], bm1 = bm[bj][1];
                f32x4 a = acc[ai][bj][m][0], b = acc[ai][bj][m][1];
#if G_FP8
                { const u32x2 g = gv[m][bj];
                  const f32x2 g01 = __builtin_amdgcn_cvt_pk_f32_fp8((int)g.x, false), g23 = __builtin_amdgcn_cvt_pk_f32_fp8((int)g.x, true), g45 = __builtin_amdgcn_cvt_pk_f32_fp8((int)g.y, false), g67 = __builtin_amdgcn_cvt_pk_f32_fp8((int)g.y, true);
                  const f32x2 s01 = fsigmoid2(g01 + (f32x2){bm0[0], bm0[1]}), s23 = fsigmoid2(g23 + (f32x2){bm0[2], bm0[3]}), s45 = fsigmoid2(g45 + (f32x2){bm1[0], bm1[1]}), s67 = fsigmoid2(g67 + (f32x2){bm1[2], bm1[3]});
                  const f32x2 a01 = (f32x2){a[0], a[1]} * s01, a23 = (f32x2){a[2], a[3]} * s23, b01 = (f32x2){b[0], b[1]} * s45, b23 = (f32x2){b[2], b[3]} * s67;
                  a = (f32x4){a01.x, a01.y, a23.x, a23.y}; b = (f32x4){b01.x, b01.y, b23.x, b23.y}; }
#else
                const u32x4 g = gv[m][bj];
                a[0] *= fsigmoid(bflo(g.x) + bm0[0]); a[1] *= fsigmoid(bfhi(g.x) + bm0[1]); a[2] *= fsigmoid(bflo(g.y) + bm0[2]); a[3] *= fsigmoid(bfhi(g.y) + bm0[3]);
                b[0] *= fsigmoid(bflo(g.z) + bm1[0]); b[1] *= fsigmoid(bfhi(g.z) + bm1[1]); b[2] *= fsigmoid(bflo(g.w) + bm1[2]); b[3] *= fsigmoid(bfhi(g.w) + bm1[3]);
#endif
                if (STEP == 1) { const u32x4 t = tv[m][bj];
                    a[0] += bflo(t.x); a[1] += bfhi(t.x); a[2] += bflo(t.y); a[3] += bfhi(t.y); b[0] += bflo(t.z); b[1] += bfhi(t.z); b[2] += bflo(t.w); b[3] += bfhi(t.w);
#if WO_FP8
                    { _Pragma("unroll") for (int i = 0; i < 4; ++i) { a[i] = fminf(fmaxf(a[i] * 16.f, -448.f), 448.f); b[i] = fminf(fmaxf(b[i] * 16.f, -448.f), 448.f); }
                      const u32x2 q8 = pack8_fp8(a, b); xo[bj] = (u32x4){q8.x, q8.y, 0u, 0u}; } }
#else
                    xo[bj] = pack8(a, b); }
#endif
                else xo[bj] = pack8(a, b); }
#if WO_FP8
              if (STEP == 1) { const u32x2 s2 = odd ? (u32x2){xo[0].x, xo[0].y} : (u32x2){xo[1].x, xo[1].y}; u32x2 r2; r2.x = lane_xor1(s2.x); r2.y = lane_xor1(s2.y);
                unsigned char* rp = (unsigned char*)MG + (row & ~(size_t)1) * 1024 + c0 + (odd ? 32 : 0);
                *(u32x2*)rp = odd ? r2 : (u32x2){xo[0].x, xo[0].y}; *(u32x2*)(rp + 1024) = odd ? (u32x2){xo[1].x, xo[1].y} : r2; } else
#endif
              { const u32x4 snd = odd ? xo[0] : xo[1]; u32x4 rcv; rcv.x = lane_xor1(snd.x); rcv.y = lane_xor1(snd.y); rcv.z = lane_xor1(snd.z); rcv.w = lane_xor1(snd.w);
                bf16_t* rp = (STEP == 1 ? MG : T0) + (row & ~(size_t)1) * 1024 + c0 + (odd ? 32 : 0);
                *(u32x4*)rp = odd ? rcv : xo[0]; *(u32x4*)(rp + 1024) = odd ? xo[1] : rcv; } }
        }
    }
};
template <int MB> struct EpiWoT {
    static constexpr bool PERM = true, WIDE = (MB == 2);
    const float* x; bf16_t* X1;
    __device__ __forceinline__ void operator()(AccRef acc, const Unit& u, int wr, int wc, int fr, int fq) const {
        if constexpr (MB == 1) {
            const int c0 = u.pn * 256 + wc * 32 + 8 * fq;
            EPI_ROWS(
                const float* xl = x + (size_t)row * 1024 + c0; asm volatile("" : "+v"(xl));
                _Pragma("unroll") for (int bj = 0; bj < 2; ++bj) { const f32x4 xa = *(const f32x4*)(xl + bj * HALF), xb = *(const f32x4*)(xl + bj * HALF + 4);
                    *(u32x4*)(X1 + (size_t)row * 1024 + c0 + bj * HALF) = pack8(xa + acc[ai][bj][m][0], xb + acc[ai][bj][m][1]); }
            )
        } else {
        const int c0 = u.pn * 256 + wc * 64 + 8 * fq; const bool odd = fr & 1;
        _Pragma("unroll") for (int ai = 0; ai < 2; ++ai) _Pragma("unroll") for (int mh = 0; mh < 2; ++mh) {
            f32x4 xv[2][2][2];
            _Pragma("unroll") for (int mm = 0; mm < 2; ++mm) _Pragma("unroll") for (int bj = 0; bj < 2; ++bj) { const size_t off = (size_t)(u.pm * BM + ai * HALF + wr * 64 + (2 * mh + mm) * 16 + fr) * 1024 + c0 + bj * 32;
                xv[mm][bj][0] = *(const f32x4*)(x + off); xv[mm][bj][1] = *(const f32x4*)(x + off + 4); }
            _Pragma("unroll") for (int mm = 0; mm < 2; ++mm) { const int m = 2 * mh + mm; const size_t row = (size_t)(u.pm * BM + ai * HALF + wr * 64 + m * 16 + fr);
                const u32x4 x0 = pack8(xv[mm][0][0] + acc[ai][0][m][0], xv[mm][0][1] + acc[ai][0][m][1]), x1 = pack8(xv[mm][1][0] + acc[ai][1][m][0], xv[mm][1][1] + acc[ai][1][m][1]);
                const u32x4 snd = odd ? x0 : x1; u32x4 rcv; rcv.x = lane_xor1(snd.x); rcv.y = lane_xor1(snd.y); rcv.z = lane_xor1(snd.z); rcv.w = lane_xor1(snd.w);
                bf16_t* rp = X1 + (row & ~(size_t)1) * 1024 + c0 + (odd ? 32 : 0);
                *(u32x4*)rp = odd ? rcv : x0; *(u32x4*)(rp + 1024) = odd ? x1 : rcv; }
        }
        }
    }
};
#if WO_FP8
typedef EpiWoT<1> EpiWo;
#else
typedef EpiWoT<2> EpiWo;
#endif
template <bool F8> struct EpiSwiglu {
    static constexpr bool PERM = true, WIDE = false;
    bf16_t* ACT; const float* b_gu;
    __device__ __forceinline__ void operator()(AccRef acc, const Unit& u, int wr, int wc, int fr, int fq) const {
        const int c = u.pn * 128 + wc * 32 + 8 * fq; const float* bg = b_gu + (size_t)u.e * 2048 + c; const float sc = 1.f;
        const f32x4 g0 = *(const f32x4*)(bg), g1 = *(const f32x4*)(bg + 4), u0 = *(const f32x4*)(bg + 1024), u1 = *(const f32x4*)(bg + 1028);
        EPI_ROWS(
            f32x4 ga = acc[ai][0][m][0] * sc + g0, gb = acc[ai][0][m][1] * sc + g1, ua = acc[ai][1][m][0] * sc + u0, ub = acc[ai][1][m][1] * sc + u1, oa, ob;
            _Pragma("unroll") for (int i = 0; i < 4; ++i) {
                const f32x2 x = (f32x2){fminf(ga[i], 7.f), fminf(gb[i], 7.f)}, y = (f32x2){fminf(fmaxf(ua[i], -7.f), 7.f), fminf(fmaxf(ub[i], -7.f), 7.f)};
                const f32x2 r = (y + 1.f) * x * fsigmoid2(x * 1.702f);
                oa[i] = r.x; ob[i] = r.y; }
            if (F8) *(u32x2*)((unsigned char*)ACT + (size_t)row * 1024 + c) = pack8_fp8(oa, ob);
            else *(u32x4*)(ACT + (size_t)row * 1024 + c) = pack8(oa, ob);
        )
    }
};
template <bool F8> struct EpiDown {
    static constexpr bool PERM = true, WIDE = false;
    bf16_t* Z; const float* b_down; const int* ROWSLOT; const float* ROWW; const volatile PG8_LAS int* cntL; const volatile PG8_LAS int* bst;
    __device__ __forceinline__ void operator()(AccRef acc, const Unit& u, int wr, int wc, int fr, int fq) const {
        const int c0 = u.pn * 256 + wc * 32 + 8 * fq; const float* bd = b_down + (size_t)u.e * 1024 + c0; const float sc = 1.f;
#if FUSED_ROWS
        const int eb = u.e * ESTR + ((u.pm - bst[u.e]) << 8) - u.pm * BM;
#endif
        f32x4 bv[2][2];
        _Pragma("unroll") for (int bj = 0; bj < 2; ++bj) _Pragma("unroll") for (int n = 0; n < 2; ++n) bv[bj][n] = *(const f32x4*)(bd + bj * HALF + 4 * n);
        EPI_ROWS(
#if FUSED_ROWS
            const int slot = ROWSLOT[eb + row]; const float w = ROWW[eb + row];
#else
            const int slot = ROWSLOT[row]; const float w = ROWW[row];
#endif
#if Z_FP8
            const float w16 = w * 16.f;
            _Pragma("unroll") for (int bj = 0; bj < 2; ++bj)
                { f32x4 za = (acc[ai][bj][m][0] * sc + bv[bj][0]) * w16, zb = (acc[ai][bj][m][1] * sc + bv[bj][1]) * w16;
                    _Pragma("unroll") for (int i = 0; i < 4; ++i) { za[i] = fminf(fmaxf(za[i], -448.f), 448.f); zb[i] = fminf(fmaxf(zb[i], -448.f), 448.f); }
                    *(u32x2*)((unsigned char*)Z + (size_t)slot * 1024 + c0 + bj * HALF) = pack8_fp8(za, zb); }
#else
            _Pragma("unroll") for (int bj = 0; bj < 2; ++bj)
                *(u32x4*)(Z + (size_t)slot * 1024 + c0 + bj * HALF) = pack8((acc[ai][bj][m][0] * sc + bv[bj][0]) * w, (acc[ai][bj][m][1] * sc + bv[bj][1]) * w);
#endif
        )
    }
};
#undef EPI_ROWS
}

namespace att {
constexpr int KB_OFF = 0, K_OFF = 16384, KSLOT = 12288, V_OFF = K_OFF + 2 * KSLOT, VSLOT = 8192, OST_OFF = V_OFF + 2 * VSLOT, OST_W = 4608, ATT_LDS = OST_OFF + 8 * OST_W + 64;
constexpr int BG_STAGE_OFF = 96 * 1024;
static_assert(ATT_LDS <= BG_STAGE_OFF && BG_STAGE_OFF + 32768 <= RING_BYTES, "attention LDS");
typedef short v4i16_t __attribute__((ext_vector_type(4)));
__device__ __forceinline__ s16x4 vtr(const LAS unsigned char* p) { return __builtin_bit_cast(s16x4, __builtin_amdgcn_ds_read_tr16_b64_v4i16((LAS v4i16_t*)p)); }
__device__ __forceinline__ float xor32(float v) { return __shfl_xor(v, 32); }
__device__ __forceinline__ void glds16(const void* gsrc, unsigned lds_dst) { unsigned keep;
    asm volatile("s_mov_b32 %0, m0\n\ts_mov_b32 m0, %2\n\ts_nop 0\n\tglobal_load_lds_dwordx4 %1, off\n\ts_mov_b32 m0, %0" : "=&s"(keep) : "v"(gsrc), "s"(lds_dst) : "memory"); }

template <int DQ, bool FOX, class CV>
__device__ __forceinline__ void attn_unit(CV& cv, LAS unsigned char* lds, int b, int h, int qb, const bf16* Q, const bf16* K, const bf16* KP, const bf16* V, const float* KBg, bf16* O, float kmax2) {
    constexpr int QP = FOX ? 512 : 768, ND = DQ / 16;
    int tid_ = threadIdx.x; asm volatile("" : "+v"(tid_));
    const int tid = tid_, lane = tid & 63, r32 = lane & 31, hi = lane >> 5; const int wid = __builtin_amdgcn_readfirstlane(tid >> 6);
    const size_t rowbase = (size_t)b * SEQ; const int q0 = qb * 256, NT = q0 / 64 + 4, qw0 = q0 + 32 * wid, my_last = (qw0 + 31) >> 6;
    if (FOX) { const f32x4* src = (const f32x4*)(KBg + (size_t)(b * 8 + h) * SEQ); LAS f32x4* dst = (LAS f32x4*)(lds + KB_OFF);
        for (int i = tid; i < NT * 16; i += 512) dst[i] = src[i]; }
    bf16x8 qr[ND];
    { const bf16* Qw = Q + (rowbase + qw0 + r32) * QP + h * DQ + hi * 8;
#pragma unroll
      for (int d0 = 0; d0 < ND; ++d0) qr[d0] = *(const bf16x8*)(Qw + d0 * 16);
#pragma unroll
      for (int d0 = 0; d0 < ND; ++d0) asm volatile("" : "+v"(qr[d0])); }
    const bf16* ksrc = K + (rowbase + lane) * 512 + h * 64 + wid * 8;
    const bf16* kpsrc = KP + (rowbase + lane) * 32 + (wid & 3) * 8;
    const bf16* vsrc = V + (rowbase + 16 * (wid & 3) + (lane >> 2)) * 512 + h * 64 + (wid >> 2) * 32 + (lane & 3) * 8;
    const unsigned ldsb = (unsigned)(size_t)lds;
#define ATT_ISSUE(t, buf) do { \
        glds16(ksrc + (size_t)(t) * 64 * 512, (unsigned)__builtin_amdgcn_readfirstlane(ldsb + K_OFF + (buf) * KSLOT + wid * 1024)); \
        if (DQ > 64 && wid < 4) glds16(kpsrc + (size_t)(t) * 64 * 32, (unsigned)__builtin_amdgcn_readfirstlane(ldsb + K_OFF + (buf) * KSLOT + (8 + wid) * 1024)); \
        glds16(vsrc + (size_t)(t) * 64 * 512, (unsigned)__builtin_amdgcn_readfirstlane(ldsb + V_OFF + (buf) * VSLOT + wid * 1024)); } while (0)
    float m = 0.f, l = 0.f; f32x16 o0 = {}, o1 = {}, negm = {};
    float bq = 0.f; bool wdone = false;
    volatile LAS int* dflag = (volatile LAS int*)(lds + OST_OFF + 8 * OST_W);
    if (FOX) {
        float qs = 0.f;
#pragma unroll
        for (int d0 = 0; d0 < ND; ++d0)
#pragma unroll
            for (int j = 0; j < 8; ++j) { const float v = bf2f((bf16)qr[d0][j]); qs += v * v; }
        qs += xor32(qs);
        bq = sqrtf(qs) * sqrtf(kmax2) + 1.f;
        if (lane == 0) dflag[wid] = 0x7fffffff;
    }
    ATT_ISSUE(NT - 1, 0);
    if (wid >= 4) __builtin_amdgcn_s_setprio(1);
    for (int it = 0; it < NT; ++it) {
        const int t = NT - 1 - it;
        const bool full = (it == 0) || !(cv.pend && cv.age == 0);
        if (full) VM_WAIT(); else asm volatile("s_waitcnt vmcnt(4)" ::: "memory");
        LDS_WAIT(); __builtin_amdgcn_s_barrier(); asm volatile("" ::: "memory");
        if (FOX && it > 0) { int mxf = 0;
#pragma unroll
            for (int w8 = 0; w8 < 8; ++w8) mxf = max(mxf, dflag[w8]);
            if (mxf < it) break; }
        if (cv.pend) { if (full) cv.consume(lane); else cv.age = 1; }
        if (it + 1 < NT) ATT_ISSUE(t - 1, (it + 1) & 1);
        if (!FOX && !cv.pend) cv.issue(lane);
        __builtin_amdgcn_sched_barrier(0);
        if (t <= my_last && !wdone) {
            const LAS unsigned char* Kb = lds + K_OFF + (it & 1) * KSLOT + hi * 1024 + r32 * 16;
            const LAS unsigned char* vp = lds + V_OFF + (it & 1) * VSLOT + ((lane >> 4) & 1) * 32 + (lane & 3) * 8 + (4 * hi + ((lane & 15) >> 2)) * 64;
            bf16x8 kf[2 * ND]; s16x4 vt[16];
#pragma unroll
            for (int d0 = 0; d0 < ND; ++d0) { kf[2 * d0] = *(const LAS bf16x8*)(Kb + d0 * 2048); kf[2 * d0 + 1] = *(const LAS bf16x8*)(Kb + d0 * 2048 + 512); }
            f32x16 p0, p1;
            if (FOX) {
                const LAS float* kbt = (const LAS float*)(lds + KB_OFF) + t * 64 + 4 * hi;
#pragma unroll
                for (int g = 0; g < 4; ++g) { const f32x4 a = *(const LAS f32x4*)(kbt + 8 * g), c = *(const LAS f32x4*)(kbt + 32 + 8 * g);
                    const f32x2 mm = (f32x2){m, m};
                    const f32x2 a01 = (f32x2){a[0], a[1]} - mm, a23 = (f32x2){a[2], a[3]} - mm, c01 = (f32x2){c[0], c[1]} - mm, c23 = (f32x2){c[2], c[3]} - mm;
                    p0[4 * g] = a01.x; p0[4 * g + 1] = a01.y; p0[4 * g + 2] = a23.x; p0[4 * g + 3] = a23.y; p1[4 * g] = c01.x; p1[4 * g + 1] = c01.y; p1[4 * g + 2] = c23.x; p1[4 * g + 3] = c23.y; }
            }
#pragma unroll
            for (int k = 0; k < 4; ++k) { vt[4 * k] = vtr(vp + k * 1024); vt[4 * k + 1] = vtr(vp + k * 1024 + 512); vt[4 * k + 2] = vtr(vp + 4096 + k * 1024); vt[4 * k + 3] = vtr(vp + 4096 + k * 1024 + 512); }
            __builtin_amdgcn_sched_barrier(0);
            if (!FOX) { p0 = negm; p1 = negm; }
#pragma unroll
            for (int d0 = 0; d0 < ND; ++d0) {
                p0 = __builtin_amdgcn_mfma_f32_32x32x16_bf16(kf[2 * d0], qr[d0], p0, 0, 0, 0); p1 = __builtin_amdgcn_mfma_f32_32x32x16_bf16(kf[2 * d0 + 1], qr[d0], p1, 0, 0, 0); }
            const bool first = (t == my_last);
            if (FOX && first) { const int qabs = qw0 + r32, kv0 = t * 64 + 4 * hi;
#pragma unroll
                for (int r = 0; r < 16; ++r) { const int kv = kv0 + (r & 3) + 8 * (r >> 2); if (kv > qabs) p0[r] = -INFINITY; if (kv + 32 > qabs) p1[r] = -INFINITY; } }
            asm volatile("s_nop 15\n\ts_nop 3" : "+v"(p0), "+v"(p1));
            float mx;
            asm("v_max_f32 %0, %1, %2" : "=v"(mx) : "v"(p0[0]), "v"(p1[0]));
#pragma unroll
            for (int r = 1; r < 16; ++r) asm("v_max3_f32 %0, %1, %2, %3" : "=v"(mx) : "v"(mx), "v"(p0[r]), "v"(p1[r]));
            { const auto sw_ = __builtin_amdgcn_permlane32_swap(__float_as_uint(mx), __float_as_uint(mx), false, false);
              asm("v_max_f32 %0, %1, %2" : "=v"(mx) : "v"(__uint_as_float(sw_[0])), "v"(__uint_as_float(sw_[1]))); }
            if (first || __any(mx > 6.f)) {
                const float dl = first ? mx : fmaxf(mx, 0.f), al = __builtin_amdgcn_exp2f(-dl);
                m += dl; l *= al;
#pragma unroll
                for (int r = 0; r < 16; ++r) { p0[r] -= dl; p1[r] -= dl; o0[r] *= al; o1[r] *= al; negm[r] = -m; }
            }
            float sum = 0.f;
#pragma unroll
            for (int r = 0; r < 16; ++r) { p0[r] = __builtin_amdgcn_exp2f(p0[r]); p1[r] = __builtin_amdgcn_exp2f(p1[r]); sum += p0[r] + p1[r]; }
            l += sum;
            u32x4 pw[4];
#pragma unroll
            for (int k = 0; k < 2; ++k) {
                pw[k] = (u32x4){cvt_pk_bf16(p0[8 * k], p0[8 * k + 1]), cvt_pk_bf16(p0[8 * k + 2], p0[8 * k + 3]), cvt_pk_bf16(p0[8 * k + 4], p0[8 * k + 5]), cvt_pk_bf16(p0[8 * k + 6], p0[8 * k + 7])};
                pw[2 + k] = (u32x4){cvt_pk_bf16(p1[8 * k], p1[8 * k + 1]), cvt_pk_bf16(p1[8 * k + 2], p1[8 * k + 3]), cvt_pk_bf16(p1[8 * k + 4], p1[8 * k + 5]), cvt_pk_bf16(p1[8 * k + 6], p1[8 * k + 7])}; }
#pragma unroll
            for (int k = 0; k < 4; ++k) {
                const s16x4 a0 = vt[4 * k], a1 = vt[4 * k + 1], c0 = vt[4 * k + 2], c1 = vt[4 * k + 3];
                const bf16x8 vf0 = (bf16x8){a0[0], a0[1], a0[2], a0[3], a1[0], a1[1], a1[2], a1[3]}, vf1 = (bf16x8){c0[0], c0[1], c0[2], c0[3], c1[0], c1[1], c1[2], c1[3]};
                const bf16x8 pk = __builtin_bit_cast(bf16x8, pw[k]);
                o0 = __builtin_amdgcn_mfma_f32_32x32x16_bf16(vf0, pk, o0, 0, 0, 0); o1 = __builtin_amdgcn_mfma_f32_32x32x16_bf16(vf1, pk, o1, 0, 0, 0); }
            if (FOX && t > 0) { const float kbn = ((const LAS float*)(lds + KB_OFF))[64 * t - 1];
                if (__all(bq + kbn - m <= -40.f)) { wdone = true; if (lane == 0) dflag[wid] = it; } }
        }
    }
#undef ATT_ISSUE
    __builtin_amdgcn_s_setprio(0);
    l += xor32(l); const float il = 1.f / l;
    LAS bf16* stg = (LAS bf16*)(lds + OST_OFF + wid * OST_W);
#pragma unroll
    for (int g = 0; g < 4; ++g) {
        u32x2 w0, w1; w0.x = cvt_pk_bf16(o0[4 * g] * il, o0[4 * g + 1] * il); w0.y = cvt_pk_bf16(o0[4 * g + 2] * il, o0[4 * g + 3] * il);
        w1.x = cvt_pk_bf16(o1[4 * g] * il, o1[4 * g + 1] * il); w1.y = cvt_pk_bf16(o1[4 * g + 2] * il, o1[4 * g + 3] * il);
        *(LAS u32x2*)(stg + r32 * 72 + 8 * g + 4 * hi) = w0; *(LAS u32x2*)(stg + r32 * 72 + 32 + 8 * g + 4 * hi) = w1; }
    LDS_WAIT();
    bf16* Ow = O + (rowbase + qw0) * 512 + h * 64;
#pragma unroll
    for (int i = 0; i < 4; ++i) { const int row = i * 8 + (lane >> 3), ch = lane & 7; const u32x4 v = *(const LAS u32x4*)(stg + row * 72 + ch * 8); *(u32x4*)(Ow + (size_t)row * 512 + ch * 8) = v; }
    __syncthreads();
}
}

#define XB_TMO      128
#define XB_XCNT(j)  (256  + 64 * (j))
#define XB_XSUB(j)  (1280 + 64 * (j))
#define XB_XGEN(j)  (2304 + 64 * (j))
#define XB_TOP      3328
#define XB_TOPGEN   3392
#define XCD_BAR_WORDS 3456
#define XB_SPIN_CAP (1u << 18)
__device__ __forceinline__ unsigned xb_ld(unsigned* p)              { return __hip_atomic_load(p, __ATOMIC_RELAXED, __HIP_MEMORY_SCOPE_AGENT); }
__device__ __forceinline__ unsigned xb_add(unsigned* p, unsigned v) { return __hip_atomic_fetch_add(p, v, __ATOMIC_RELAXED, __HIP_MEMORY_SCOPE_AGENT); }
__device__ __forceinline__ unsigned xb_xcc_id() { return (unsigned)__builtin_amdgcn_s_getreg((3 << 11) | 20) & 0xFu; }
#define XB_SPIN(cond, bar) do { unsigned _sp = 0; while (cond) { __builtin_amdgcn_s_sleep(1); \
    if ((++_sp & 255u) == 0u) { if (xb_ld(&(bar)[XB_TMO])) break; if (_sp > XB_SPIN_CAP) { atomicAdd(&(bar)[XB_TMO], 1u); break; } } } } while (0)
struct XcdBarrier { unsigned* bar; unsigned x; volatile LAS unsigned* st; };
__device__ __forceinline__ XcdBarrier xcd_barrier_post(unsigned* bar, volatile LAS unsigned* st) {
    XcdBarrier b; b.bar = bar; b.x = xb_xcc_id(); b.st = st;
    if (threadIdx.x == 0) (void)xb_add(&bar[XB_XCNT(b.x)], 1u);
    return b;
}
__device__ __forceinline__ void xcd_barrier_complete(unsigned* bar, unsigned x, unsigned& nloc, unsigned& nx) {
    const unsigned G = gridDim.x * gridDim.y * gridDim.z;
    unsigned sum, cnt, mine, sp = 0u;
    for (;;) {
        sum = 0u; cnt = 0u; mine = 0u;
#pragma unroll
        for (unsigned j = 0; j < 16; ++j) { const unsigned c = xb_ld(&bar[XB_XCNT(j)]); sum += c; cnt += (c > 0u) ? 1u : 0u; mine = (j == x) ? c : mine; }
        if (sum == G) break;
        __builtin_amdgcn_s_sleep(1);
        if ((++sp & 255u) == 0u) { if (xb_ld(&bar[XB_TMO])) break; if (sp > XB_SPIN_CAP) { atomicAdd(&bar[XB_TMO], 1u); break; } }
    }
    nloc = mine > 0u ? mine : 1u; nx = cnt > 0u ? cnt : 1u;
}
__device__ __forceinline__ void xcd_barrier(const XcdBarrier& b) {
    asm volatile("s_waitcnt vmcnt(0)" ::: "memory");
    __syncthreads();
    if (threadIdx.x == 0) {
        unsigned* bar = b.bar;
        __builtin_amdgcn_s_waitcnt(0);
        unsigned nloc = b.st[0], nx = b.st[1];
        if (nloc == 0u) { xcd_barrier_complete(bar, b.x, nloc, nx); b.st[0] = nloc; b.st[1] = nx; }
        const unsigned old = xb_add(&bar[XB_XSUB(b.x)], 1u);
        const unsigned gen = old / nloc;
        if (old + 1u == (gen + 1u) * nloc) {
            __builtin_amdgcn_fence(__ATOMIC_RELEASE, "agent");
            asm volatile("s_waitcnt vmcnt(0)" ::: "memory");
            const unsigned og = xb_add(&bar[XB_TOP], 1u);
            const unsigned tg = og / nx;
            if (og + 1u == (tg + 1u) * nx) xb_add(&bar[XB_TOPGEN], 1u);
            else XB_SPIN(xb_ld(&bar[XB_TOPGEN]) == tg, bar);
            __builtin_amdgcn_fence(__ATOMIC_ACQUIRE, "agent");
            xb_add(&bar[XB_XGEN(b.x)], 1u);
            asm volatile("s_waitcnt vmcnt(0)" ::: "memory");
        } else {
            XB_SPIN(xb_ld(&bar[XB_XGEN(b.x)]) == gen, bar);
            __builtin_amdgcn_fence(__ATOMIC_ACQUIRE, "agent");
            asm volatile("s_waitcnt vmcnt(0)" ::: "memory");
        }
    }
    __syncthreads();
}

struct Frame { LAS unsigned char* lds; volatile LAS unsigned* MISC; int tid, wave, vcu, G; };

constexpr int W_SMALL = 128 * 16 + 24 * 4 + 32 * 4 + 32 * 8 + 32 * 8 + 32 * 16, W_ALL = W_SMALL + 32 * 64 * 16 + 32 * 32 * 16;
struct WItem { const float* src; const float* ksc; bf16* dst; int ldw, ldt, nvalid, fp8; };
__device__ __forceinline__ WItem wt_decode(const P& p, int it) {
    constexpr int I_WIN = 128 * 16, I_WQ = 24 * 4, I_WKV = 32 * 4, I_WF = 32 * 8, I_WM = 32 * 8, I_WO = 32 * 16, I_GU = 32 * 64 * 16;
    WItem w; w.ksc = nullptr; w.nvalid = 32; w.fp8 = 0; int r = it;
    if (r < I_WIN) { const int db = r & 127, kb = r >> 7, n = 32 * db; int src0;
        if (n < 1536) src0 = n; else if (n < 1792) src0 = C_QL + (n - 1536);
        else if (n < 2048) { const int j = n - 1792; if (j < 128) src0 = C_KV + j; else if (j == 128) src0 = C_KPE; else if (j == 160) { src0 = C_FL; w.nvalid = 8; } else { src0 = 0; w.nvalid = 0; } }
        else src0 = C_G + (n - 2048);
        w.src = p.w_in + (size_t)(64 * kb) * IN_COLS + src0; w.ldw = IN_COLS; w.dst = WSP(bf16, WS_WIN) + (size_t)n * 1024 + 64 * kb; w.ldt = 1024;
#if GATE_FP8
        if (n >= 2048) { w.fp8 = 1; w.dst = (bf16*)(WSP(unsigned char, WS_WIN8) + (size_t)(n - 2048) * 1024 + 64 * kb); }
#endif
        return w; }
    r -= I_WIN;
    if (r < I_WQ) { const int db = r % 24, kb = r / 24, n = 32 * db; const int src0 = (n < 512) ? (n >> 6) * 96 + (n & 63) : ((n - 512) >> 5) * 96 + 64;
        w.src = p.w_q_b + (size_t)(64 * kb) * 768 + src0; w.ldw = 768; w.ksc = p.g_q_a + 64 * kb; w.dst = WSP(bf16, WS_WQ) + (size_t)n * 256 + 64 * kb; w.ldt = 256; return w; }
    r -= I_WQ;
    if (r < I_WKV) { const int db = r & 31, kb = r >> 5, n = 32 * db; const int nn = n & 511; const int src0 = (nn >> 6) * 128 + (n >= 512 ? 64 : 0) + (nn & 63);
        w.src = p.w_kv_b + (size_t)((kb < 2) ? 64 * kb : 0) * 1024 + src0; w.ldw = 1024; w.ksc = p.g_kv_a + ((kb < 2) ? 64 * kb : 0); w.nvalid = (kb < 2) ? 32 : 0; w.dst = WSP(bf16, WS_WKV) + (size_t)n * 256 + 64 * kb; w.ldt = 256; return w; }
    r -= I_WKV;
    if (r < I_WF) { const int db = r & 31, kb = r >> 5; w.src = p.w_fox + (size_t)(64 * kb) * 1024 + 32 * db; w.ldw = 1024; w.dst = WSP(bf16, WS_WF) + (size_t)(32 * db) * 512 + 64 * kb; w.ldt = 512; return w; }
    r -= I_WF;
    if (r < I_WM) { const int db = r & 31, kb = r >> 5; w.src = p.w_mla + (size_t)(64 * kb) * 1024 + 32 * db; w.ldw = 1024; w.dst = WSP(bf16, WS_WM) + (size_t)(32 * db) * 512 + 64 * kb; w.ldt = 512; return w; }
    r -= I_WM;
    if (r < I_WO) { const int db = r & 31, kb = r >> 5; w.src = p.w_o + (size_t)(64 * kb) * 1024 + 32 * db; w.ldw = 1024; w.ldt = 1024;
#if WO_FP8
        w.fp8 = 1; w.dst = (bf16*)(WSP(unsigned char, WS_WO) + (size_t)(32 * db) * 1024 + 64 * kb);
#else
        w.dst = WSP(bf16, WS_WO) + (size_t)(32 * db) * 1024 + 64 * kb;
#endif
        return w; }
    r -= I_WO;
    if (r < I_GU) { const int e = r >> 10, rr = r & 1023, db = rr & 63, kb = rr >> 6, n = 32 * db; const int src0 = ((n >> 7) & 1) * 1024 + (n >> 8) * 128 + (n & 127);
        w.src = p.w_gu + (size_t)e * 1024 * 2048 + (size_t)(64 * kb) * 2048 + src0; w.ldw = 2048; w.ldt = 1024;
#if MOE_FP8
        w.fp8 = 1; w.dst = (bf16*)(WSP(unsigned char, WS_WGU) + (size_t)e * 2048 * 1024 + (size_t)n * 1024 + 64 * kb);
#else
        w.dst = WSP(bf16, WS_WGU) + (size_t)e * 2048 * 1024 + (size_t)n * 1024 + 64 * kb;
#endif
        return w; }
    r -= I_GU;
    { const int e = r >> 9, rr = r & 511, db = rr & 31, kb = rr >> 5;
        w.src = p.w_down + (size_t)e * 1024 * 1024 + (size_t)(64 * kb) * 1024 + 32 * db; w.ldw = 1024; w.ldt = 1024;
#if MOE_FP8
        w.fp8 = 1; w.dst = (bf16*)(WSP(unsigned char, WS_WD) + (size_t)e * 1024 * 1024 + (size_t)(32 * db) * 1024 + 64 * kb);
#else
        w.dst = WSP(bf16, WS_WD) + (size_t)e * 1024 * 1024 + (size_t)(32 * db) * 1024 + 64 * kb;
#endif
        return w; }
}
struct BgConv {
    const P* p; LAS unsigned char* scr; unsigned stage; int it, step, stride, age; bool active, pend; WItem w;
    __device__ __forceinline__ void init(const P& p_, LAS unsigned char* scr_, LAS unsigned char* stage_, int it0, int stride_) { p = &p_; scr = scr_; stage = (unsigned)(size_t)stage_; it = it0; stride = stride_; step = 0; age = 0; active = it0 < W_ALL; pend = false; w = wt_decode(p_, active ? it0 : W_SMALL); }
    __device__ __forceinline__ void issue(int lane) {
        if (!active) return;
        const float* g = w.src + (size_t)(8 * step + (lane >> 3)) * w.ldw + 4 * (lane & 7);
#pragma unroll
        for (int j = 0; j < 4; ++j) att::glds16(g + (size_t)(8 * j) * w.ldw, stage + 1024 * j);
        pend = true; age = 0;
    }
    __device__ __forceinline__ void consume(int lane) {
        if (!pend) return;
        pend = false;
        { const LAS unsigned char* sp = (const LAS unsigned char*)(size_t)stage + 16 * lane;
          f32x4 x[4];
#pragma unroll
          for (int j = 0; j < 4; ++j) x[j] = *(const LAS f32x4*)(sp + 1024 * j) * 32.f;
          LDS_WAIT(); asm volatile("" ::: "memory");
          LAS unsigned char* q = scr + (8 * step + (lane >> 3)) * 36 + 4 * (lane & 7);
#pragma unroll
          for (int j = 0; j < 4; ++j) { int b = __builtin_amdgcn_cvt_pk_fp8_f32(x[j][0], x[j][1], 0, false); b = __builtin_amdgcn_cvt_pk_fp8_f32(x[j][2], x[j][3], b, true); *(LAS int*)(q + 8 * 36 * j) = b; } }
        step += 4;
        if (step < 8) return;
        LDS_WAIT(); asm volatile("" ::: "memory");
        const int c = lane & 7, ng = lane >> 3;
        unsigned d[8];
#pragma unroll
        for (int q = 0; q < 8; ++q) d[q] = *(const LAS unsigned*)(scr + (8 * c + q) * 36 + 4 * ng);
        unsigned t[2][4];
#pragma unroll
        for (int h = 0; h < 2; ++h) {
            const unsigned p01l = __builtin_amdgcn_perm(d[4 * h + 1], d[4 * h], 0x05010400u), p01h = __builtin_amdgcn_perm(d[4 * h + 1], d[4 * h], 0x07030602u);
            const unsigned p23l = __builtin_amdgcn_perm(d[4 * h + 3], d[4 * h + 2], 0x05010400u), p23h = __builtin_amdgcn_perm(d[4 * h + 3], d[4 * h + 2], 0x07030602u);
            t[h][0] = __builtin_amdgcn_perm(p23l, p01l, 0x05040100u); t[h][1] = __builtin_amdgcn_perm(p23l, p01l, 0x07060302u);
            t[h][2] = __builtin_amdgcn_perm(p23h, p01h, 0x05040100u); t[h][3] = __builtin_amdgcn_perm(p23h, p01h, 0x07060302u); }
        unsigned char* dst = (unsigned char*)w.dst;
#pragma unroll
        for (int j = 0; j < 4; ++j) *(u32x2*)(dst + (size_t)(4 * ng + j) * w.ldt + 8 * c) = (u32x2){t[0][j], t[1][j]};
        LDS_WAIT(); asm volatile("" ::: "memory");
        step = 0; it += stride; active = it < W_ALL; if (active) w = wt_decode(*p, it);
    }
};
__device__ __forceinline__ void wt_load(const WItem& w, f32x4 (&v)[8], int lane) {
    const int n4 = lane & 7;
#pragma unroll
    for (int i = 0; i < 8; ++i) { const int kk = 8 * i + (lane >> 3); v[i] = (f32x4){0.f, 0.f, 0.f, 0.f};
        if (4 * n4 < w.nvalid) { v[i] = *(const f32x4*)(w.src + (size_t)kk * w.ldw + 4 * n4); if (w.ksc) v[i] = v[i] * w.ksc[kk]; } }
}
__device__ __forceinline__ void wt_store(const WItem& w, const f32x4 (&v)[8], LAS float* scr, int lane) {
    const int n4 = lane & 7;
#pragma unroll
    for (int i = 0; i < 8; ++i) { const int kk = 8 * i + (lane >> 3); LAS float* s = scr + kk * 33 + 4 * n4; s[0] = v[i][0]; s[1] = v[i][1]; s[2] = v[i][2]; s[3] = v[i][3]; }
    LDS_WAIT(); asm volatile("" ::: "memory");
    const int c = lane & 7;
#pragma unroll
    for (int j = 0; j < 4; ++j) { const int n = (lane >> 3) + 8 * j; const LAS float* s = scr + (8 * c) * 33 + n;
        if (w.fp8) { *(u32x2*)((unsigned char*)w.dst + (size_t)n * w.ldt + 8 * c) = pack8_fp8((f32x4){s[0 * 33], s[1 * 33], s[2 * 33], s[3 * 33]} * 32.f, (f32x4){s[4 * 33], s[5 * 33], s[6 * 33], s[7 * 33]} * 32.f); }
        else { u32x4 o; o.x = cvt_pk_bf16(s[0 * 33], s[1 * 33]); o.y = cvt_pk_bf16(s[2 * 33], s[3 * 33]); o.z = cvt_pk_bf16(s[4 * 33], s[5 * 33]); o.w = cvt_pk_bf16(s[6 * 33], s[7 * 33]);
            *(u32x4*)(w.dst + (size_t)n * w.ldt + 8 * c) = o; } }
    LDS_WAIT(); asm volatile("" ::: "memory");
}
__device__ __forceinline__ void wt_convert_range(const P& p, Frame& F, int lo, int hi) {
    LAS float* scr = (LAS float*)(F.lds + F.wave * 16384);
    const int gw = F.vcu * NWAVES + F.wave, NGW = F.G * NWAVES;
    int it = lo + gw; f32x4 va[8], vb[8];
    WItem wa = wt_decode(p, it < hi ? it : lo), wb = wa;
    if (it < hi) wt_load(wa, va, (F.tid & 63));
    while (it < hi) {
        const int nx = it + NGW;
        if (nx < hi) { wb = wt_decode(p, nx); wt_load(wb, vb, (F.tid & 63)); }
        wt_store(wa, va, scr, (F.tid & 63));
        it = nx; if (it >= hi) break;
        const int nx2 = it + NGW;
        if (nx2 < hi) { wa = wt_decode(p, nx2); wt_load(wa, va, (F.tid & 63)); }
        wt_store(wb, vb, scr, (F.tid & 63));
        it = nx2;
    }
}
__device__ __forceinline__ void p0_prologue(const P& p, Frame& F) {
    LAS float* scr = (LAS float*)(F.lds + F.wave * 16384);
    const int gw = F.vcu * NWAVES + F.wave, NGW = F.G * NWAVES;
    constexpr int NITEMS = W_SMALL;
    {
        int it = gw; f32x4 va[8], vb[8];
        WItem wa = wt_decode(p, it < NITEMS ? it : 0), wb = wa;
        if (it < NITEMS) wt_load(wa, va, (F.tid & 63));
        while (it < NITEMS) {
            const int nx = it + NGW;
            if (nx < NITEMS) { wb = wt_decode(p, nx); wt_load(wb, vb, (F.tid & 63)); }
            wt_store(wa, va, scr, (F.tid & 63));
            it = nx; if (it >= NITEMS) break;
            const int nx2 = it + NGW;
            if (nx2 < NITEMS) { wa = wt_decode(p, nx2); wt_load(wa, va, (F.tid & 63)); }
            wt_store(wb, vb, scr, (F.tid & 63));
            it = nx2;
        }
    }
    for (int m0 = gw; m0 < NTOK; m0 += 2 * NGW) {
        f32x4 v[2][4];
#pragma unroll
        for (int q = 0; q < 2; ++q) { const int mrow = (m0 + q * NGW < NTOK) ? m0 + q * NGW : m0; const f32x4* xr = (const f32x4*)(p.x + (size_t)mrow * DM) + (F.tid & 63);
#pragma unroll
            for (int j = 0; j < 4; ++j) v[q][j] = xr[64 * j]; }
#pragma unroll
        for (int q = 0; q < 2; ++q) { const int mrow = m0 + q * NGW; if (mrow >= NTOK) break;
            float s = 0.f;
#pragma unroll
            for (int j = 0; j < 4; ++j) s += (v[q][j].x * v[q][j].x + v[q][j].y * v[q][j].y) + (v[q][j].z * v[q][j].z + v[q][j].w * v[q][j].w);
            const float rs = 1.f / sqrtf(wave_sum(s) * (1.f / DM) + EPS);
            const f32x4* gr = (const f32x4*)p.g_attn + (F.tid & 63); u32x2* o8 = (u32x2*)(WSP(bf16, WS_H) + (size_t)mrow * DM) + (F.tid & 63);
#pragma unroll
            for (int j = 0; j < 4; ++j) { const f32x4 g = gr[64 * j]; const f32x4 hv = (f32x4){v[q][j].x * rs * g.x, v[q][j].y * rs * g.y, v[q][j].z * rs * g.z, v[q][j].w * rs * g.w};
                u32x2 w; w.x = cvt_pk_bf16(hv.x, hv.y); w.y = cvt_pk_bf16(hv.z, hv.w); o8[64 * j] = w;
#if GATE_FP8
                { int b8 = __builtin_amdgcn_cvt_pk_fp8_f32(hv.x, hv.y, 0, false); b8 = __builtin_amdgcn_cvt_pk_fp8_f32(hv.z, hv.w, b8, true); ((unsigned*)(WSP(unsigned char, WS_H8) + (size_t)mrow * DM))[(F.tid & 63) + 64 * j] = (unsigned)b8; }
#endif
            } }
    }
    if (blockIdx.x == 0 && F.tid < 64) WSP(unsigned, WS_MISC)[GM_KMAX + F.tid] = 0u;
    if (blockIdx.x == 0 && F.tid < 32) WSP(int, WS_MISC)[GM_CUR + F.tid] = 0;
    for (int idx = (F.vcu * NWAVES * 64) + F.tid; idx < NTOK * 16; idx += F.G * NWAVES * 64) {
        const int tok = idx >> 4, j = idx & 15;
        const float inv_freq = powf(10000.0f, -(float)j / 16.0f); const float ang = (float)p.pos[tok] * inv_freq;
        float* cs = WSP(float, WS_CS) + (size_t)tok * 32; cs[j] = cosf(ang); cs[16 + j] = sinf(ang);
    }
}
__device__ __forceinline__ void p2a_rows(const P& p, Frame& F) {
    const int gw = F.vcu * NWAVES + F.wave, l = (F.tid & 63); const int bb = gw >> 8, r0 = bb * SEQ + (gw & 255);
    float kmx = 0.f;
    for (int jb = 0; jb < 16; jb += 4) {
        u32x4 wv[4], kv[4];
#pragma unroll
        for (int q = 0; q < 4; ++q) { const int mrow = r0 + 256 * (jb + q); wv[q] = *((const u32x4*)(WSP(const bf16, WS_QL) + (size_t)mrow * 512) + l); kv[q] = *((const u32x4*)(WSP(const bf16, WS_KF) + (size_t)mrow * 512) + l); }
#pragma unroll
        for (int q = 0; q < 4; ++q) { const int mrow = r0 + 256 * (jb + q); const u32x4 w = wv[q];
            { const u32x4 k = kv[q]; const float k8[8] = {bflo(k.x), bfhi(k.x), bflo(k.y), bfhi(k.y), bflo(k.z), bfhi(k.z), bflo(k.w), bfhi(k.w)}; float ks = 0.f;
#pragma unroll
              for (int i = 0; i < 8; ++i) ks += k8[i] * k8[i];
              ks += __shfl_xor(ks, 1); ks += __shfl_xor(ks, 2); ks += __shfl_xor(ks, 4); kmx = fmaxf(kmx, ks); }
            float v[8] = {bflo(w.x), bfhi(w.x), bflo(w.y), bfhi(w.y), bflo(w.z), bfhi(w.z), bflo(w.w), bfhi(w.w)};
            float s = 0.f;
#pragma unroll
            for (int i = 0; i < 8; ++i) s += v[i] * v[i];
            const float sq = wave_sum(l < 32 ? s : 0.f), sk = wave_sum((l >= 32 && l < 48) ? s : 0.f);
            if (l == 0) { float* rs = WSP(float, WS_SSQ) + (size_t)mrow * 2; rs[0] = 1.f / sqrtf(sq * (1.f / 256) + EPS); rs[1] = 1.f / sqrtf(sk * (1.f / 128) + EPS); }
            float pv[8];
#pragma unroll
            for (int i = 0; i < 8; ++i) pv[i] = __shfl_xor(v[i], 2);
            if (l >= 48 && l < 52) {
                const int jq = 8 * (l - 48); const float* cs = WSP(const float, WS_CS) + (size_t)mrow * 32 + (jq & 15); const float sg = (jq < 16) ? -1.f : 1.f;
                float o[8];
#pragma unroll
                for (int i = 0; i < 8; ++i) o[i] = v[i] * cs[i] + sg * pv[i] * cs[16 + i];
                u32x4 ow; ow.x = cvt_pk_bf16(o[0], o[1]); ow.y = cvt_pk_bf16(o[2], o[3]); ow.z = cvt_pk_bf16(o[4], o[5]); ow.w = cvt_pk_bf16(o[6], o[7]);
                *(u32x4*)(WSP(bf16, WS_KPE) + (size_t)mrow * 32 + jq) = ow;
            }
            if (l == 52) {
                float* lf = WSP(float, WS_LOGF) + (size_t)mrow * 8;
#pragma unroll
                for (int i = 0; i < 8; ++i) { const float z = v[i] + p.b_fgate[i]; lf[i] = fminf(z, 0.f) - log1pf(expf(-fabsf(z))); }
            }
        }
    }
    if ((l & 7) == 0) atomicMax(WSP(unsigned, WS_MISC) + GM_KMAX + bb * 8 + (l >> 3), __float_as_uint(kmx));
}
__device__ __forceinline__ void p2_cumsum(const P& p, Frame& F, int bh) {
    const int b = bh >> 3, h = bh & 7, t = F.tid;
    const float* lf = WSP(const float, WS_LOGF) + ((size_t)b * SEQ + 8 * t) * 8 + h;
    float v[8], tot = 0.f;
#pragma unroll
    for (int i = 0; i < 8; ++i) { v[i] = lf[i * 8]; tot += v[i]; }
    float inc = tot;
#pragma unroll
    for (int o = 1; o < 64; o <<= 1) { const float x = __shfl_up(inc, o); if ((F.tid & 63) >= o) inc += x; }
    LAS float* wt = (LAS float*)(F.lds);
    if ((F.tid & 63) == 63) wt[F.wave] = inc;
    __syncthreads();
    float run = inc - tot;
    for (int w = 0; w < F.wave; ++w) run += wt[w];
    float* kb = WSP(float, WS_KB) + (size_t)bh * SEQ + 8 * t;
#pragma unroll
    for (int i = 0; i < 8; ++i) { run += v[i]; kb[i] = -run * LOG2E; }
    __syncthreads();
}
__device__ __forceinline__ void p6_router(const P& p, Frame& F) {
    LAS bf16x8* WRH = (LAS bf16x8*)F.lds; LAS bf16x8* WRL = WRH + 4096;
    for (int f = F.tid; f < 4096; f += NWAVES * 64) { const int ln = f & 63, nb = (f >> 6) & 1, ks = f >> 7; const float* src = p.w_router + (size_t)(32 * ks + 8 * (ln >> 4)) * 32 + 16 * nb + (ln & 15);
        bf16x8 h, lo;
#pragma unroll
        for (int j = 0; j < 8; ++j) { const float w = src[j * 32]; const unsigned hb = f2bf(w); h[j] = (short)hb; lo[j] = (short)f2bf(w - bf2f((bf16)hb)); }
        WRH[f] = h; WRL[f] = lo; }
    volatile LAS unsigned* hist = F.MISC + 32;
    if (F.tid < 32) hist[F.tid] = 0u;
    __syncthreads();
    const int wg = blockIdx.x, lane = (F.tid & 63), tr = lane & 15, kq = lane >> 4;
    const int tok0 = wg * 128 + F.wave * 16;
    const bf16* xr = WSP(const bf16, WS_X1) + (size_t)(tok0 + tr) * DM + 8 * kq;
    const float* gr = p.g_ffn + 8 * kq;
    f32x4 acc0 = {0.f, 0.f, 0.f, 0.f}, acc1 = {0.f, 0.f, 0.f, 0.f}; float ss = 0.f;
#pragma unroll 4
    for (int ks = 0; ks < 32; ++ks) {
        const u32x4 xw = *(const u32x4*)(xr + 32 * ks); const f32x4 x0 = (f32x4){bflo(xw.x), bfhi(xw.x), bflo(xw.y), bfhi(xw.y)}, x1 = (f32x4){bflo(xw.z), bfhi(xw.z), bflo(xw.w), bfhi(xw.w)}, g0 = *(const f32x4*)(gr + 32 * ks), g1 = *(const f32x4*)(gr + 32 * ks + 4);
        ss += (x0[0] * x0[0] + x0[1] * x0[1]) + (x0[2] * x0[2] + x0[3] * x0[3]) + (x1[0] * x1[0] + x1[1] * x1[1]) + (x1[2] * x1[2] + x1[3] * x1[3]);
        const f32x4 a0 = x0 * g0, a1 = x1 * g1;
        bf16x8 ah, al;
#pragma unroll
        for (int j = 0; j < 4; ++j) { const unsigned h0 = f2bf(a0[j]), h1 = f2bf(a1[j]); ah[j] = (short)h0; ah[4 + j] = (short)h1; al[j] = (short)f2bf(a0[j] - bf2f((bf16)h0)); al[4 + j] = (short)f2bf(a1[j] - bf2f((bf16)h1)); }
        const bf16x8 bh0 = WRH[(ks * 2 + 0) * 64 + lane], bh1 = WRH[(ks * 2 + 1) * 64 + lane], bl0 = WRL[(ks * 2 + 0) * 64 + lane], bl1 = WRL[(ks * 2 + 1) * 64 + lane];
        acc0 = __builtin_amdgcn_mfma_f32_16x16x32_bf16(ah, bh0, acc0, 0, 0, 0); acc1 = __builtin_amdgcn_mfma_f32_16x16x32_bf16(ah, bh1, acc1, 0, 0, 0);
        acc0 = __builtin_amdgcn_mfma_f32_16x16x32_bf16(al, bh0, acc0, 0, 0, 0); acc1 = __builtin_amdgcn_mfma_f32_16x16x32_bf16(al, bh1, acc1, 0, 0, 0);
        acc0 = __builtin_amdgcn_mfma_f32_16x16x32_bf16(ah, bl0, acc0, 0, 0, 0); acc1 = __builtin_amdgcn_mfma_f32_16x16x32_bf16(ah, bl1, acc1, 0, 0, 0);
    }
    ss += __shfl_xor(ss, 16); ss += __shfl_xor(ss, 32);
    const float rs = 1.f / sqrtf(ss * (1.f / DM) + EPS);
    LAS float* LG = (LAS float*)(F.lds + ROWTAB_OFF) + F.wave * 544;
#pragma unroll
    for (int r = 0; r < 4; ++r) { LG[(4 * kq + r) * 32 + tr] = acc0[r]; LG[(4 * kq + r) * 32 + 16 + tr] = acc1[r]; }
    if (kq == 0) LG[512 + tr] = rs;
    LDS_WAIT(); asm volatile("" ::: "memory");
    int idx[4] = {0, 0, 0, 0}, rnk[4] = {0, 0, 0, 0}; float wgt[4] = {0.f, 0.f, 0.f, 0.f};
    if (lane < 16) {
        const float rst = LG[512 + lane]; float lg[32];
#pragma unroll
        for (int c = 0; c < 8; ++c) { const f32x4 v = *(const LAS f32x4*)(LG + lane * 32 + 4 * c); const f32x4 b = *(const f32x4*)(p.b_router + 4 * c);
            lg[4 * c] = v[0] * rst + b[0]; lg[4 * c + 1] = v[1] * rst + b[1]; lg[4 * c + 2] = v[2] * rst + b[2]; lg[4 * c + 3] = v[3] * rst + b[3]; }
        float val[4];
#pragma unroll
        for (int k = 0; k < 4; ++k) { float bv = -INFINITY; int bi = 0;
#pragma unroll
            for (int e = 0; e < 32; ++e) { const bool tk = lg[e] > bv; bv = tk ? lg[e] : bv; bi = tk ? e : bi; }
            idx[k] = bi; val[k] = bv;
#pragma unroll
            for (int e = 0; e < 32; ++e) lg[e] = (e == bi) ? -INFINITY : lg[e]; }
        float ex[4], sum = 0.f;
#pragma unroll
        for (int k = 0; k < 4; ++k) { ex[k] = expf(val[k] - val[0]); sum += ex[k]; }
        const float inv = 1.f / sum; const int tok = tok0 + lane;
        *(u32x4*)(WSP(int, WS_TOPI) + tok * 4) = (u32x4){(unsigned)idx[0], (unsigned)idx[1], (unsigned)idx[2], (unsigned)idx[3]};
        *(f32x4*)(WSP(float, WS_TOPW) + tok * 4) = (f32x4){ex[0] * inv, ex[1] * inv, ex[2] * inv, ex[3] * inv};
#pragma unroll
        for (int k = 0; k < 4; ++k) { rnk[k] = (int)__hip_atomic_fetch_add((LAS unsigned*)(F.lds + MISC_OFF) + 32 + idx[k], 1u, __ATOMIC_RELAXED, __HIP_MEMORY_SCOPE_WORKGROUP); wgt[k] = ex[k] * inv; }
    }
#if MOE_FP8
    unsigned char* H2 = WSP(unsigned char, WS_H2) + (size_t)(tok0 + tr) * DM + 8 * kq;
#else
    bf16* H2 = WSP(bf16, WS_H2) + (size_t)(tok0 + tr) * DM + 8 * kq;
#endif
#pragma unroll 4
    for (int ks = 0; ks < 32; ++ks) {
        const u32x4 xw = *(const u32x4*)(xr + 32 * ks); const f32x4 x0 = (f32x4){bflo(xw.x), bfhi(xw.x), bflo(xw.y), bfhi(xw.y)}, x1 = (f32x4){bflo(xw.z), bfhi(xw.z), bflo(xw.w), bfhi(xw.w)}, g0 = *(const f32x4*)(gr + 32 * ks), g1 = *(const f32x4*)(gr + 32 * ks + 4);
#if MOE_FP8
        *(u32x2*)(H2 + 32 * ks) = pack8_fp8(x0 * g0 * rs, x1 * g1 * rs); }
#else
        *(u32x4*)(H2 + 32 * ks) = pack8(x0 * g0 * rs, x1 * g1 * rs); }
#endif
    __syncthreads();
#if FUSED_ROWS
    volatile LAS int* gbase = (volatile LAS int*)(F.MISC + 64);
    if (F.tid < 32) gbase[F.tid] = atomicAdd(WSP(int, WS_MISC) + GM_CUR + F.tid, (int)hist[F.tid]);
    __syncthreads();
    if (lane < 16) { const int tok = tok0 + lane;
#pragma unroll
        for (int k = 0; k < 4; ++k) { const size_t pos = (size_t)idx[k] * ESTR + gbase[idx[k]] + rnk[k];
            WSP(int, WS_EROWTOK)[pos] = tok; WSP(int, WS_EROWSLOT)[pos] = tok * 4 + k; WSP(float, WS_EROWW)[pos] = wgt[k]; } }
#else
    if (F.tid < 32) WSP(int, WS_MISC)[GM_CNT + wg * 32 + F.tid] = (int)hist[F.tid];
#endif
    __syncthreads();
}
__device__ __forceinline__ void p7_rows(const P& p, Frame& F) {
    const int wg = blockIdx.x, tid = F.tid;
    LAS int* part = (LAS int*)F.lds;
    LAS int* tot = part + 512; LAS int* pre = tot + 32; LAS int* pstart = pre + 32; LAS int* base = pstart + 33; LAS unsigned* lcnt = (LAS unsigned*)(base + 32);
    const int* cnt = WSP(const int, WS_MISC) + GM_CNT;
    { const int e = tid & 31, j = tid >> 5; int s = 0;
#pragma unroll
      for (int w = 0; w < 16; ++w) s += cnt[(j * 16 + w) * 32 + e];
      part[j * 32 + e] = s; }
    __syncthreads();
    if (tid < 32) { int t = 0, pr = 0;
        for (int j = 0; j < 16; ++j) { if (j < (wg >> 4)) pr += part[j * 32 + tid]; t += part[j * 32 + tid]; }
        for (int w = (wg & ~15); w < wg; ++w) pr += cnt[w * 32 + tid];
        tot[tid] = t; pre[tid] = pr; lcnt[tid] = 0u; }
    __syncthreads();
    if (tid == 0) { int s = 0; for (int e = 0; e < 32; ++e) { pstart[e] = s; s += ((tot[e] + 255) >> 8) << 8; } pstart[32] = s; }
    __syncthreads();
    if (tid < 32) base[tid] = pstart[tid] + pre[tid];
    __syncthreads();
    { const int a = wg * 512 + tid; const int e = WSP(const int, WS_TOPI)[a]; const float w = WSP(const float, WS_TOPW)[a];
      const int pos = base[e] + (int)__hip_atomic_fetch_add(lcnt + e, 1u, __ATOMIC_RELAXED, __HIP_MEMORY_SCOPE_WORKGROUP);
      WSP(int, WS_ROWTOK)[pos] = a >> 2; WSP(int, WS_ROWSLOT)[pos] = a; WSP(float, WS_ROWW)[pos] = w; }
    if (wg < 32) { const int e = wg; const int s0 = pstart[e] + tot[e], s1 = pstart[e + 1];
        for (int r = s0 + tid; r < s1; r += NWAVES * 64) { WSP(int, WS_ROWTOK)[r] = 0; WSP(int, WS_ROWSLOT)[r] = NTOK * 4; WSP(float, WS_ROWW)[r] = 0.f; } }
    if (wg == 0) {
        if (tid == 0) WSP(int, WS_MISC)[GM_NBLK] = pstart[32] >> 8;
        if (tid < 32) { for (int bk = pstart[tid] >> 8; bk < (pstart[tid + 1] >> 8); ++bk) WSP(int, WS_MISC)[GM_BLKE + bk] = tid; }
    }
    __syncthreads();
}
__device__ __forceinline__ void moe_setup(const P& p, Frame& F, pg8::MoeOrder& S, int shift, int gc_log2, bool gather) {
    LAS int* blke = (LAS int*)(F.lds + BLKE_OFF); LAS int* rowtab = (LAS int*)(F.lds + ROWTAB_OFF);
#if FUSED_ROWS
    volatile LAS int* cntL = (volatile LAS int*)(F.MISC + 32); volatile LAS int* bst = (volatile LAS int*)(F.MISC + 64);
    if (F.tid < 64) {
        const int l = F.tid, c = (l < 32) ? WSP(const int, WS_MISC)[GM_CUR + l] : 0, nb = (c + 255) >> 8;
        int inc = nb;
#pragma unroll
        for (int d = 1; d < 32; d <<= 1) { const int o = __shfl_up(inc, d); if (l >= d) inc += o; }
        if (l < 32) { cntL[l] = c; bst[l] = inc - nb; }
        if (l == 31) bst[32] = inc;
    }
    __syncthreads();
    const int nblk = bst[32];
    for (int i = F.tid; i < MAXBLK; i += NWAVES * 64) { int e = 0;
#pragma unroll
        for (int st = 16; st >= 1; st >>= 1) { if (bst[e + st] <= i) e += st; }
        blke[i] = (i < nblk) ? e : 0; }
    __syncthreads();
    S.init(nblk, F.G, (int)blockIdx.x, shift, gc_log2, (const LAS int*)blke);
    if (gather) {
        for (int i = 0; i < ROWTAB_UNITS; ++i) { const int rb = S.rb_of(i); if (rb >= nblk) break;
            if (F.tid < 256) { const int e = blke[rb], pos = ((rb - bst[e]) << 8) + F.tid; rowtab[i * 256 + F.tid] = (pos < cntL[e]) ? WSP(const int, WS_EROWTOK)[(size_t)e * ESTR + pos] : 0; } }
        if (blockIdx.x < 32) { const int e = (int)blockIdx.x, c0_ = cntL[e], c1_ = ((c0_ + 255) >> 8) << 8;
            for (int q = c0_ + F.tid; q < c1_; q += NWAVES * 64) { WSP(int, WS_EROWSLOT)[(size_t)e * ESTR + q] = NTOK * 4; WSP(float, WS_EROWW)[(size_t)e * ESTR + q] = 0.f; } }
    }
#else
    const int nblk = WSP(const int, WS_MISC)[GM_NBLK];
    for (int i = F.tid; i < MAXBLK; i += NWAVES * 64) blke[i] = (i < nblk) ? WSP(const int, WS_MISC)[GM_BLKE + i] : 0;
    S.init(nblk, F.G, (int)blockIdx.x, shift, gc_log2, (const LAS int*)blke);
    if (gather) {
        for (int i = 0; i < ROWTAB_UNITS; ++i) { const int rb = S.rb_of(i); if (rb >= nblk) break;
            if (F.tid < 256) rowtab[i * 256 + F.tid] = WSP(const int, WS_ROWTOK)[rb * 256 + F.tid]; }
    }
#endif
    __syncthreads();
}
__device__ __forceinline__ void p10_final(const P& p, Frame& F) {
    const int gw = F.vcu * NWAVES + F.wave, NGW = F.G * NWAVES, lane = F.tid & 63;
#if Z_FP8
    typedef float f32x2 __attribute__((ext_vector_type(2)));
    for (int m0 = gw; m0 < NTOK; m0 += 2 * NGW) {
        f32x4 v[2][4]; unsigned z[2][4][4];
#pragma unroll
        for (int q = 0; q < 2; ++q) { const int mrow = (m0 + q * NGW < NTOK) ? m0 + q * NGW : m0;
            const u32x2* xr = (const u32x2*)(WSP(const bf16, WS_X1) + (size_t)mrow * DM) + lane;
#pragma unroll
            for (int j = 0; j < 4; ++j) { const u32x2 xw = xr[64 * j]; v[q][j] = (f32x4){bflo(xw.x), bfhi(xw.x), bflo(xw.y), bfhi(xw.y)};
#pragma unroll
                for (int k = 0; k < 4; ++k) z[q][j][k] = *((const unsigned*)(WSP(const unsigned char, WS_Z) + ((size_t)mrow * 4 + k) * 1024) + lane + 64 * j); } }
#pragma unroll
        for (int q = 0; q < 2; ++q) { const int mrow = m0 + q * NGW; if (mrow >= NTOK) break;
            float s = 0.f;
#pragma unroll
            for (int j = 0; j < 4; ++j) { f32x4 a = {0.f, 0.f, 0.f, 0.f};
#pragma unroll
                for (int k = 0; k < 4; ++k) { const f32x2 lo = __builtin_amdgcn_cvt_pk_f32_fp8((int)z[q][j][k], false), hi = __builtin_amdgcn_cvt_pk_f32_fp8((int)z[q][j][k], true); a.x += lo.x; a.y += lo.y; a.z += hi.x; a.w += hi.y; }
                v[q][j] = v[q][j] + a * 0.0625f;
                s += (v[q][j].x * v[q][j].x + v[q][j].y * v[q][j].y) + (v[q][j].z * v[q][j].z + v[q][j].w * v[q][j].w); }
            const float rs = 1.f / sqrtf(wave_sum(s) * (1.f / DM) + EPS);
            f32x4* xo = (f32x4*)(p.out + (size_t)mrow * DM) + lane; const f32x4* gr = (const f32x4*)p.g_final + lane;
#pragma unroll
            for (int j = 0; j < 4; ++j) { const f32x4 g = gr[64 * j]; xo[64 * j] = (f32x4){v[q][j].x * rs * g.x, v[q][j].y * rs * g.y, v[q][j].z * rs * g.z, v[q][j].w * rs * g.w}; }
        }
    }
#else
    for (int m0 = gw; m0 < NTOK; m0 += 2 * NGW) {
        f32x4 v[2][4]; u32x2 z[2][4][4];
#pragma unroll
        for (int q = 0; q < 2; ++q) { const int mrow = (m0 + q * NGW < NTOK) ? m0 + q * NGW : m0;
            const u32x2* xr = (const u32x2*)(WSP(const bf16, WS_X1) + (size_t)mrow * DM) + lane;
#pragma unroll
            for (int j = 0; j < 4; ++j) { const u32x2 xw = xr[64 * j]; v[q][j] = (f32x4){bflo(xw.x), bfhi(xw.x), bflo(xw.y), bfhi(xw.y)};
#pragma unroll
                for (int k = 0; k < 4; ++k) z[q][j][k] = *((const u32x2*)(WSP(const bf16, WS_Z) + ((size_t)mrow * 4 + k) * 1024) + lane + 64 * j); } }
#pragma unroll
        for (int q = 0; q < 2; ++q) { const int mrow = m0 + q * NGW; if (mrow >= NTOK) break;
            float s = 0.f;
#pragma unroll
            for (int j = 0; j < 4; ++j) {
#pragma unroll
                for (int k = 0; k < 4; ++k) { v[q][j].x += bflo(z[q][j][k].x); v[q][j].y += bfhi(z[q][j][k].x); v[q][j].z += bflo(z[q][j][k].y); v[q][j].w += bfhi(z[q][j][k].y); }
                s += (v[q][j].x * v[q][j].x + v[q][j].y * v[q][j].y) + (v[q][j].z * v[q][j].z + v[q][j].w * v[q][j].w); }
            const float rs = 1.f / sqrtf(wave_sum(s) * (1.f / DM) + EPS);
            f32x4* xo = (f32x4*)(p.out + (size_t)mrow * DM) + lane; const f32x4* gr = (const f32x4*)p.g_final + lane;
#pragma unroll
            for (int j = 0; j < 4; ++j) { const f32x4 g = gr[64 * j]; xo[64 * j] = (f32x4){v[q][j].x * rs * g.x, v[q][j].y * rs * g.y, v[q][j].z * rs * g.z, v[q][j].w * rs * g.w}; }
        }
    }
#endif
}

constexpr int NPHASE = 12;
struct Args { P p; int ph_lo, ph_hi; };
__global__ void __launch_bounds__(NWAVES * 64, 2) mk_fwd(Args args) {
    extern __shared__ __attribute__((aligned(16))) unsigned char lds_raw[];
    const P& p = args.p;
    Frame F;
    F.lds = (LAS unsigned char*)lds_raw; F.MISC = (volatile LAS unsigned*)(F.lds + MISC_OFF);
    F.tid = threadIdx.x; F.wave = __builtin_amdgcn_readfirstlane(F.tid >> 6);
    F.G = gridDim.x; { const int bx = blockIdx.x; F.vcu = (F.G % 8 == 0) ? (bx % 8) * (F.G / 8) + bx / 8 : bx; }
    for (int u = F.tid; u < 256; u += NWAVES * 64) F.MISC[u] = 0u;
    __syncthreads();
    const int lo = args.ph_lo, hi = args.ph_hi;
    const bool one = (hi - lo) > 1;
    XcdBarrier bar; bar.bar = (unsigned*)(p.ws + WS_CTL) + 4096; bar.x = 0; bar.st = nullptr;
    if (one) bar = xcd_barrier_post((unsigned*)(p.ws + WS_CTL) + 4096, F.MISC + 8);
#ifndef PH_MASK
#define PH_MASK 0xfff
#endif
#define IN(k) (((PH_MASK >> (k)) & 1) && lo <= (k) && (k) < hi)
#define SEAM(k) do { if (IN(k) && IN((k) + 1)) xcd_barrier(bar); } while (0)
    using namespace pg8;
    const int bx = (int)blockIdx.x;
    if (IN(0)) { p0_prologue(p, F); } SEAM(0);
    if (IN(1)) {
#if GATE_FP8
        { Gemm g{WSP(const bf16, WS_H), WSP(const bf16, WS_WIN), 1024, 1024}; StaticOrder S; S.init(NTOK, 2048, F.G, bx);
          EpiInproj<false> E{p.ws};
          gemm_phase<EpiInproj<false>, StaticOrder, true, false>(F.lds, g, S, E, nullptr); }
        { Gemm g{WSP(const bf16, WS_H8), WSP(const bf16, WS_WIN8), 1024, 1024}; StaticOrder S; S.init(NTOK, 2048, F.G, bx);
          EpiInproj<true> E{p.ws};
          gemm_phase8<EpiInproj<true>, StaticOrder, true, false>(F.lds, g, S, E, nullptr); }
#else
        Gemm g{WSP(const bf16, WS_H), WSP(const bf16, WS_WIN), 1024, 1024}; StaticOrder S; S.init(NTOK, 4096, F.G, bx);
        EpiInproj<false> E{p.ws};
        gemm_phase<EpiInproj<false>, StaticOrder, true, false>(F.lds, g, S, E, nullptr);
#endif
    } SEAM(1);
    if (IN(2)) { p2a_rows(p, F); } SEAM(2);
    if (IN(3)) {
        if (F.vcu < 64) p2_cumsum(p, F, F.vcu);
        { Gemm g{WSP(const bf16, WS_QL), WSP(const bf16, WS_WQ), 256, 512}; StaticOrder S; S.init(NTOK, 768, F.G, (F.G == 256) ? (((bx & 7) + 6) & 7) * 32 + (bx >> 3) : bx);
          EpiQup E{WSP(bf16, WS_QM), WSP(const float, WS_SSQ), WSP(const float, WS_CS)};
          gemm_phase<EpiQup, StaticOrder, true, false>(F.lds, g, S, E, nullptr); }
        { Gemm g{WSP(const bf16, WS_QL) + 256, WSP(const bf16, WS_WKV), 256, 512}; StaticOrder S; S.init(NTOK, 1024, F.G, bx);
          EpiKvup E{WSP(bf16, WS_KN), WSP(const float, WS_SSQ)};
          gemm_phase<EpiKvup, StaticOrder, true, false>(F.lds, g, S, E, nullptr); }
    } SEAM(3);
    if (IN(4)) {
        BgConv cv; cv.init(p, F.lds + ROWTAB_OFF + F.wave * 2304, F.lds + att::BG_STAGE_OFF + F.wave * 4096, W_SMALL + F.vcu * NWAVES + F.wave, F.G * NWAVES);
        for (int j = F.vcu; j < 2048; j += F.G) {
            const int br = j >> 10, jj = j & 1023, r = jj >> 8, bh = (jj & 255) >> 2, s = jj & 3;
            const int qb = (r == 0) ? s : (r == 1) ? 7 - s : (r == 2) ? 8 + s : 15 - s;
            if (br == 0) att::attn_unit<64, true>(cv, F.lds, bh >> 3, bh & 7, qb, WSP(const bf16, WS_QF), WSP(const bf16, WS_KF), WSP(const bf16, WS_KPE), WSP(const bf16, WS_VF), WSP(const float, WS_KB), WSP(bf16, WS_YF), __uint_as_float(WSP(const unsigned, WS_MISC)[GM_KMAX + bh]));
            else att::attn_unit<96, false>(cv, F.lds, bh >> 3, bh & 7, qb, WSP(const bf16, WS_QM), WSP(const bf16, WS_KN), WSP(const bf16, WS_KPE), WSP(const bf16, WS_VM), WSP(const float, WS_KB), WSP(bf16, WS_YM), 0.f);
        }
        VM_WAIT(); cv.consume(F.tid & 63);
        while (cv.active) { cv.issue(F.tid & 63); VM_WAIT(); cv.consume(F.tid & 63); }
    } SEAM(4);
    if (IN(5)) {
        { Gemm g{WSP(const bf16, WS_YF), WSP(const bf16, WS_WF), 512, 512}; StaticOrder S; S.init(NTOK, 1024, F.G, bx);
          EpiMerge<0> E{WSP(bf16, WS_T0), WSP(bf16, WS_MG), WSP(const bf16, WS_G), p.b_merge};
          gemm_phase<EpiMerge<0>, StaticOrder, true, false>(F.lds, g, S, E, nullptr); }
        { Gemm g{WSP(const bf16, WS_YM), WSP(const bf16, WS_WM), 512, 512}; StaticOrder S; S.init(NTOK, 1024, F.G, bx);
          EpiMerge<1> E{WSP(bf16, WS_T0), WSP(bf16, WS_MG), WSP(const bf16, WS_G), p.b_merge};
          gemm_phase<EpiMerge<1>, StaticOrder, true, false>(F.lds, g, S, E, nullptr); }
    } SEAM(5);
    if (IN(6)) {
        StaticOrder S; S.init(NTOK, 1024, F.G, bx);
        EpiWo E{p.x, WSP(bf16, WS_X1)};
#if WO_FP8
        Gemm g{WSP(const bf16, WS_MG), WSP(const bf16, WS_WO), 1024, 1024, 0x7B7B7B7B};
        gemm_phase8<EpiWo, StaticOrder, true, false>(F.lds, g, S, E, nullptr);
#else
        Gemm g{WSP(const bf16, WS_MG), WSP(const bf16, WS_WO), 1024, 1024};
        gemm_phase<EpiWo, StaticOrder, true, false>(F.lds, g, S, E, nullptr);
#endif
    } SEAM(6);
    if (IN(7)) { p6_router(p, F); } SEAM(7);
#if !FUSED_ROWS
    if (IN(8)) { p7_rows(p, F); } SEAM(8);
#endif
    if (IN(9)) {
        MoeOrder S; moe_setup(p, F, S, 3, 1, true);
        Gemm g{WSP(const bf16, WS_H2), WSP(const bf16, WS_WGU), 1024, 1024};
        EpiSwiglu<MOE_FP8 != 0> E{WSP(bf16, WS_ACT), p.b_gu};
#if MOE_FP8
        gemm_phase8<EpiSwiglu<true>, MoeOrder, false, true>(F.lds, g, S, E, (const LAS int*)(F.lds + ROWTAB_OFF));
#else
        gemm_phase<EpiSwiglu<false>, MoeOrder, false, true>(F.lds, g, S, E, (const LAS int*)(F.lds + ROWTAB_OFF));
#endif
    } SEAM(9);
    if (IN(10)) {
        MoeOrder S; moe_setup(p, F, S, 2, 0, false);
        Gemm g{WSP(const bf16, WS_ACT), WSP(const bf16, WS_WD), 1024, 1024};
#if FUSED_ROWS
        EpiDown<MOE_FP8 != 0> E{WSP(bf16, WS_Z), p.b_down, WSP(const int, WS_EROWSLOT), WSP(const float, WS_EROWW), (const volatile LAS int*)(F.MISC + 32), (const volatile LAS int*)(F.MISC + 64)};
#else
        EpiDown<MOE_FP8 != 0> E{WSP(bf16, WS_Z), p.b_down, WSP(const int, WS_ROWSLOT), WSP(const float, WS_ROWW), nullptr, nullptr};
#endif
#if MOE_FP8
        gemm_phase8<EpiDown<true>, MoeOrder, true, false>(F.lds, g, S, E, nullptr);
#else
        gemm_phase<EpiDown<false>, MoeOrder, true, false>(F.lds, g, S, E, nullptr);
#endif
    } SEAM(10);
    if (IN(11)) { p10_final(p, F); }
#undef IN
#undef SEAM
}

extern "C" void kernel_launch(void* const* d_in, const int* in_sizes, int n_in, void* d_out, int out_size, void* d_ws, size_t ws_size, hipStream_t stream) {
    static int grid = 0;
    if (grid == 0) {
        if (n_in != 21 || out_size != NTOK * DM || ws_size < WS_END) { fprintf(stderr, "kernel_launch: unexpected sizes n_in %d out %d ws %zu\n", n_in, out_size, ws_size); grid = -1; return; }
        int dev = 0, cus = 0, per_cu = 0;
        if (hipGetDevice(&dev) != hipSuccess || hipDeviceGetAttribute(&cus, hipDeviceAttributeMultiprocessorCount, dev) != hipSuccess) { grid = -1; return; }
        if (hipFuncSetAttribute((const void*)mk_fwd, hipFuncAttributeMaxDynamicSharedMemorySize, LDS_BYTES) != hipSuccess) { fprintf(stderr, "kernel_launch: hipFuncSetAttribute failed\n"); grid = -1; return; }
        if (hipOccupancyMaxActiveBlocksPerMultiprocessor(&per_cu, (const void*)mk_fwd, NWAVES * 64, LDS_BYTES) != hipSuccess || per_cu < 1) { fprintf(stderr, "kernel_launch: occupancy query says %d\n", per_cu); }
        (void)hipGetLastError();
        if (cus != 256) { fprintf(stderr, "kernel_launch: built for 256 CUs, found %d\n", cus); grid = -1; return; }
        grid = 256;
    }
    if (grid < 0) return;
    P p{};
    p.x = (const float*)d_in[0]; p.pos = (const int*)d_in[1]; p.g_attn = (const float*)d_in[2]; p.w_in = (const float*)d_in[3]; p.b_fgate = (const float*)d_in[4];
    p.g_q_a = (const float*)d_in[5]; p.w_q_b = (const float*)d_in[6]; p.g_kv_a = (const float*)d_in[7]; p.w_kv_b = (const float*)d_in[8];
    p.w_fox = (const float*)d_in[9]; p.w_mla = (const float*)d_in[10]; p.b_merge = (const float*)d_in[11]; p.w_o = (const float*)d_in[12];
    p.g_ffn = (const float*)d_in[13]; p.w_router = (const float*)d_in[14]; p.b_router = (const float*)d_in[15];
    p.w_gu = (const float*)d_in[16]; p.b_gu = (const float*)d_in[17]; p.w_down = (const float*)d_in[18]; p.b_down = (const float*)d_in[19]; p.g_final = (const float*)d_in[20];
    p.out = (float*)d_out; p.ws = (unsigned char*)d_ws;
    (void)hipMemsetAsync((char*)d_ws + WS_CTL, 0, 64 * 1024, stream);
    Args a{}; a.p = p;
    a.ph_lo = 0; a.ph_hi = NPHASE;
    hipLaunchKernelGGL(mk_fwd, dim3(grid), dim3(NWAVES * 64), LDS_BYTES, stream, a);
}
```

```cpp
#include <hip/hip_runtime.h>
#include <cstdio>
#include <cstdint>

constexpr int DM = 1024, BATCH = 8, SEQ = 4096, NTOK = BATCH * SEQ;
constexpr int NE = 32, TOPK = 4, FF = 1024;
constexpr int IN_COLS = 4008;
constexpr int C_QF = 0, C_KF = 512, C_VF = 1024, C_FL = 1536, C_QL = 1544, C_KV = 1800, C_KPE = 1928, C_G = 1960;
constexpr float EPS = 1e-6f;
constexpr size_t SSQ2 = (size_t)NTOK * 4;
constexpr float LOG2E = 1.4426950408889634f;
constexpr float C2F = 0.125f * LOG2E;
constexpr float C2M = 0.10206207261596577f * LOG2E;

typedef unsigned short bf16;
__device__ __forceinline__ unsigned f2bf(float f) { unsigned u = __builtin_bit_cast(unsigned, f); return (u + 0x7fffu + ((u >> 16) & 1u)) >> 16; }
__device__ __forceinline__ float bf2f(bf16 b) { return __builtin_bit_cast(float, (unsigned)b << 16); }

constexpr size_t MiB = 1u << 20;
constexpr size_t WS_CTL = 0;
constexpr size_t WS_WIN = 2 * MiB, WS_WQ = 10 * MiB, WS_WKV = 10 * MiB + 512 * 1024, WS_WF = 11 * MiB, WS_WM = 12 * MiB, WS_WO = 13 * MiB;
constexpr size_t WS_WGU = 16 * MiB, WS_WD = 144 * MiB;
constexpr size_t WS_SSQ = 208 * MiB, WS_KPE = 209 * MiB, WS_LOGF = 211 * MiB, WS_CS = 212 * MiB, WS_KB = 216 * MiB, WS_TOPI = 217 * MiB, WS_TOPW = 217 * MiB + 512 * 1024;
constexpr size_t WS_ROWTOK = 218 * MiB, WS_ROWSLOT = 219 * MiB, WS_ROWW = 220 * MiB, WS_MISC = 221 * MiB;
constexpr size_t WS_T0 = 224 * MiB, WS_H2 = 224 * MiB, WS_MG = 288 * MiB;
constexpr size_t WS_A = 352 * MiB, WS_H = 352 * MiB, WS_QF = 416 * MiB, WS_KF = 448 * MiB, WS_VF = 480 * MiB, WS_QL = 512 * MiB, WS_QM = 544 * MiB, WS_ACT = 480 * MiB, WS_X1 = 352 * MiB;
constexpr size_t WS_B = 624 * MiB, WS_G = 624 * MiB, WS_KN = 752 * MiB, WS_VM = 784 * MiB, WS_YF = 816 * MiB, WS_YM = 848 * MiB, WS_Z = 624 * MiB;
constexpr size_t WS_H8 = 288 * MiB;
constexpr size_t WS_WIN8 = 2 * MiB + 4 * MiB;
constexpr size_t WS_END = 896 * MiB;

struct P {
    const float* x; const int* pos; const float* g_attn; const float* w_in; const float* b_fgate; const float* g_q_a; const float* w_q_b; const float* g_kv_a; const float* w_kv_b;
    const float* w_fox; const float* w_mla; const float* b_merge; const float* w_o; const float* g_ffn; const float* w_router; const float* b_router;
    const float* w_gu; const float* b_gu; const float* w_down; const float* b_down; const float* g_final;
    float* out; unsigned char* ws;
};
#define WSP(T, off) ((T*)(p.ws + (off)))

__device__ __forceinline__ float wave_sum(float v) {
#pragma unroll
    for (int o = 1; o < 64; o <<= 1) v += __shfl_xor(v, o);
    return v;
}

#ifndef GATE_FP8
#define GATE_FP8 1
#endif
#ifndef Z_FP8
#define G_FP8 1
#define WO_FP8 1
#define FUSED_ROWS 1
#define Z_FP8 1
#endif
#ifndef MOE_FP8
#define MOE_FP8 1
#endif
#define GAS __attribute__((address_space(1)))
#define LAS __attribute__((address_space(3)))
typedef unsigned u32x4 __attribute__((ext_vector_type(4)));
typedef unsigned u32x2 __attribute__((ext_vector_type(2)));
typedef float f32x4 __attribute__((ext_vector_type(4)));
typedef float f32x16 __attribute__((ext_vector_type(16)));
typedef short bf16x8 __attribute__((ext_vector_type(8)));
typedef short s16x4 __attribute__((ext_vector_type(4)));
typedef int v8i32 __attribute__((ext_vector_type(8)));
typedef int v4i32 __attribute__((ext_vector_type(4)));
typedef GAS unsigned gu32;
#define RLX_AGENT __ATOMIC_RELAXED, __HIP_MEMORY_SCOPE_AGENT
#define LDS_WAIT() asm volatile("s_waitcnt lgkmcnt(0)" ::: "memory")
#define VM_WAIT() asm volatile("s_waitcnt vmcnt(0)" ::: "memory")
__device__ __forceinline__ unsigned cvt_pk_bf16(float lo, float hi) { unsigned r; asm volatile("v_cvt_pk_bf16_f32 %0, %1, %2" : "=v"(r) : "v"(lo), "v"(hi)); return r; }
__device__ __forceinline__ u32x4 pack8(f32x4 a, f32x4 b) { u32x4 w; w.x = cvt_pk_bf16(a[0], a[1]); w.y = cvt_pk_bf16(a[2], a[3]); w.z = cvt_pk_bf16(b[0], b[1]); w.w = cvt_pk_bf16(b[2], b[3]); return w; }
__device__ __forceinline__ u32x2 pack8_fp8(f32x4 a, f32x4 b) { int w0 = __builtin_amdgcn_cvt_pk_fp8_f32(a[0], a[1], 0, false); w0 = __builtin_amdgcn_cvt_pk_fp8_f32(a[2], a[3], w0, true);
    int w1 = __builtin_amdgcn_cvt_pk_fp8_f32(b[0], b[1], 0, false); w1 = __builtin_amdgcn_cvt_pk_fp8_f32(b[2], b[3], w1, true); return (u32x2){(unsigned)w0, (unsigned)w1}; }
__device__ __forceinline__ float bflo(unsigned w) { return __builtin_bit_cast(float, w << 16); }
__device__ __forceinline__ float bfhi(unsigned w) { return __builtin_bit_cast(float, w & 0xffff0000u); }
typedef float f32x2 __attribute__((ext_vector_type(2)));
__device__ __forceinline__ f32x2 fsigmoid2(f32x2 z) { const f32x2 t = z * (-LOG2E); f32x2 e; e.x = __builtin_amdgcn_exp2f(t.x); e.y = __builtin_amdgcn_exp2f(t.y); const f32x2 d = e + 1.f; f32x2 r; r.x = __builtin_amdgcn_rcpf(d.x); r.y = __builtin_amdgcn_rcpf(d.y); return r; }
__device__ __forceinline__ unsigned lane_xor1(unsigned v) { return (unsigned)__builtin_amdgcn_mov_dpp((int)v, 0xB1, 0xF, 0xF, true); }
__device__ __forceinline__ float fsigmoid(float z) { return __builtin_amdgcn_rcpf(1.f + __builtin_amdgcn_exp2f(-z * LOG2E)); }

constexpr int RING_BYTES = 131072;
constexpr int MISC_OFF = RING_BYTES;
constexpr int BLKE_OFF = MISC_OFF + 1024;
constexpr int ROWTAB_OFF = BLKE_OFF + 2304;
constexpr int ROWTAB_UNITS = 18;
constexpr int LDS_BYTES = ROWTAB_OFF + ROWTAB_UNITS * 1024;
static_assert(LDS_BYTES <= 160 * 1024, "LDS");
static_assert(WS_VF - WS_KF == WS_KF - WS_QF, "QF/KF/VF equally spaced");
constexpr int NWAVES = 8;
constexpr int MAXBLK = 544;
constexpr int GM_NBLK = 0, GM_BLKE = 64, GM_CNT = 1024, GM_KMAX = 40000;
constexpr int GM_CUR = GM_CNT;
constexpr int ESTR = NTOK + 256;
constexpr size_t WS_EROWTOK = 80 * MiB, WS_EROWSLOT = 85 * MiB, WS_EROWW = 90 * MiB;

namespace pg8 {
#define PG8_LAS __attribute__((address_space(3)))
typedef unsigned short bf16_t;
constexpr int BM = 256, BK = 64, HALF = 128, HTB = HALF * BK * 2, STAGE_BYTES = 8 * HTB, NXCD = 8, WGM = 8;
__host__ __device__ __forceinline__ int lds_byte(int r, int c) { const int st = (r >> 4) * 2 + (c >> 5), rr = r & 15, cc = c & 31, ob = rr * 64 + cc * 2; return st * 1024 + (ob ^ (((ob >> 9) & 1) << 5)); }
__host__ __device__ __forceinline__ void stage_rc(int b, int& R, int& C) { const int st = b / 1024, sb = b % 1024, swz = sb ^ (((sb >> 9) & 1) << 5); R = (st >> 1) * 16 + swz / 64; C = (st & 1) * 32 + (swz % 64) / 2; }
__host__ __device__ __forceinline__ int perm32(int rho) { const int n = rho >> 4, i = rho & 15; return 8 * (i >> 2) + 4 * n + (i & 3); }

struct Unit { int pm, pn, bt, e; };
struct Gemm { const bf16_t* A; const bf16_t* Bt; int K, lda; int ascale = 0x7F7F7F7F; };

struct StaticOrder {
    int nM, nN, nwg, G, c;
    __device__ void init(int M, int N, int G_, int c_) { nM = M / BM; nN = N / BM; nwg = nM * nN; G = G_; c = c_; }
    __device__ bool next(int i, Unit& u) const {
        const long L = (long)i * G + c; if (L >= nwg) return false;
        int wgid = (int)L; { const int q = nwg / NXCD, r = nwg % NXCD, xcd = wgid % NXCD, off = wgid / NXCD; wgid = (xcd < r ? xcd * (q + 1) : r * (q + 1) + (xcd - r) * q) + off; }
        const int nig = WGM * nN, gid = wgid / nig, fm = gid * WGM, gsz = (nM - fm) < WGM ? (nM - fm) : WGM;
        u.pm = fm + ((wgid % nig) % gsz); u.pn = (wgid % nig) / gsz; u.bt = u.pn; u.e = 0; return true;
    }
};
struct LinearOrder {
    int nunits, G, c, shift;
    __device__ bool next(int i, Unit& u) const { const int idx = c + i * G; if (idx >= nunits) return false; u.pm = idx >> shift; u.pn = idx & ((1 << shift) - 1); u.bt = u.pn; u.e = 0; return true; }
};
struct MoeOrder {
    int nblk, s, g8, xr, gr, pn0, cpxs, shift; const PG8_LAS int* blke;
    __device__ void init(int nblk_, int G, int c, int shift_, int gc_log2, const PG8_LAS int* blke_) {
        nblk = nblk_; shift = shift_; blke = blke_; g8 = G >> 3; s = c >> 3; const int x = c & 7; gr = 8 >> gc_log2; xr = x & (gr - 1); const int xc = x / gr; cpxs = shift_ - gc_log2; pn0 = xc << cpxs; }
    __device__ int rb_of(int i) const { const int j = s + i * g8; return (j >> cpxs) * gr + xr; }
    __device__ bool next(int i, Unit& u) const {
        const int j = s + i * g8, rb = (j >> cpxs) * gr + xr; if (rb >= nblk) return false;
        const int pn = pn0 + (j & ((1 << cpxs) - 1)), e = blke[rb];
        u.pm = rb; u.pn = pn; u.e = e; u.bt = (e << shift) + pn; return true;
    }
};

template <class Epi, class Sched, bool ALIGN_EPI, bool GATHER>
__device__ __forceinline__ void gemm_phase(PG8_LAS unsigned char* lds, const Gemm g, const Sched& S, const Epi& E, const PG8_LAS int* rowtab) {
    int tid_ = threadIdx.x; asm volatile("" : "+v"(tid_));
    const int tid = tid_, wid = __builtin_amdgcn_readfirstlane(tid >> 6), lane = tid & 63, wr = wid >> 2, wc = wid & 3, fr = lane & 15, fq = lane >> 4;
    const int K = g.K, nt = K / BK, lda = g.lda;
    unsigned voffA[2], voffB[2]; int RA[2]; unsigned CA2[2];
#pragma unroll
    for (int i = 0; i < 2; ++i) { int R, C; stage_rc(tid * 16 + i * 8192, R, C); const int Rb = Epi::WIDE ? (64 * (R >> 5) + perm32(R & 31)) : Epi::PERM ? ((R & ~31) + perm32(R & 31)) : R;
        voffA[i] = (unsigned)(R * lda + C) * 2u; voffB[i] = (unsigned)(Rb * K + C) * 2u; RA[i] = R; CA2[i] = (unsigned)C * 2u; }
    const size_t kstep = (size_t)(BK * 2);
    const size_t hstepA = (size_t)HALF * lda * 2, tstepA = 2 * hstepA;
    const size_t hstepB = (size_t)(Epi::WIDE ? 32 : HALF) * K * 2, tstepB = (size_t)2 * HALF * K * 2;
    const unsigned ldsw = (unsigned)wid * 1024u;
    const int aoff = lds_byte(wr * 64 + fr, fq * 8), boff = lds_byte(wc * 32 + fr, fq * 8);
    unsigned va[2][2], vn[2][2];
#define PG8_SA(b, h) (((b) * 2 + (h)) * HTB)
#define PG8_SB(b, h) ((4 + (b) * 2 + (h)) * HTB)
#define PG8_STAGE(bufoff, gbase, voff) do { _Pragma("unroll") for (int _i = 0; _i < 2; ++_i) \
        __builtin_amdgcn_global_load_lds((const unsigned*)((const char*)(gbase) + (voff)[_i]), (PG8_LAS unsigned*)(lds + (bufoff) + ldsw + _i * 8192), 16, 0, 0); } while (0)
#define PG8_STAGE_A(bufoff, gbase, h, NXT) do { if constexpr (GATHER) { unsigned o_[2]; o_[0] = (NXT) ? vn[h][0] : va[h][0]; o_[1] = (NXT) ? vn[h][1] : va[h][1]; PG8_STAGE(bufoff, gbase, o_); } \
        else { PG8_STAGE(bufoff, (gbase) + (h) * hstepA, voffA); } } while (0)
#define PG8_LDA(dst, b, h) do { _Pragma("unroll") for (int m = 0; m < 4; ++m) _Pragma("unroll") for (int k = 0; k < 2; ++k) dst[m][k] = *(const PG8_LAS bf16x8*)(lds + PG8_SA(b, h) + aoff + m * 2048 + k * 1024); } while (0)
#define PG8_LDB(dst, b, h) do { _Pragma("unroll") for (int n = 0; n < 2; ++n) _Pragma("unroll") for (int k = 0; k < 2; ++k) dst[n][k] = *(const PG8_LAS bf16x8*)(lds + PG8_SB(b, h) + boff + n * 2048 + k * 1024); } while (0)
#define PG8_MMA(ai, bj, At, Bt) do { __builtin_amdgcn_s_setprio(1); _Pragma("unroll") for (int m = 0; m < 4; ++m) _Pragma("unroll") for (int n = 0; n < 2; ++n) _Pragma("unroll") for (int k = 0; k < 2; ++k) \
        acc[ai][bj][m][n] = __builtin_amdgcn_mfma_f32_16x16x32_bf16(Bt[n][k], At[m][k], acc[ai][bj][m][n], 0, 0, 0); __builtin_amdgcn_s_setprio(0); } while (0)
#define PG8_WAIT_V(n) asm volatile("s_waitcnt vmcnt(" #n ")" ::: "memory")
#define PG8_WAIT_L(n) asm volatile("s_waitcnt lgkmcnt(" #n ")" ::: "memory")
#define PG8_BAR __builtin_amdgcn_s_barrier()
#define PG8_SCHED __builtin_amdgcn_sched_barrier(0)
#define PG8_ROWOFF(dst, ui_) do { _Pragma("unroll") for (int h_ = 0; h_ < 2; ++h_) _Pragma("unroll") for (int i_ = 0; i_ < 2; ++i_) \
        dst[h_][i_] = (unsigned)rowtab[(ui_) * 256 + h_ * 128 + RA[i_]] * (unsigned)(lda * 2) + CA2[i_]; } while (0)
    Unit cur, nxt; int ui = 0;
    if (!S.next(0, cur)) return;
    f32x4 acc[2][2][4][2];
#pragma unroll
    for (int a = 0; a < 2; ++a)
#pragma unroll
        for (int b = 0; b < 2; ++b)
#pragma unroll
            for (int m = 0; m < 4; ++m)
#pragma unroll
                for (int n = 0; n < 2; ++n) acc[a][b][m][n] = (f32x4){0.f, 0.f, 0.f, 0.f};
    bf16x8 At[4][2], B0[2][2], B1[2][2];
    const char* cA = (const char*)g.A + (GATHER ? (size_t)0 : (size_t)cur.pm * tstepA); const char* cB = (const char*)g.Bt + (size_t)cur.bt * tstepB;
    if constexpr (GATHER) { PG8_ROWOFF(va, 0); }
    PG8_STAGE(PG8_SB(0, 0), cB, voffB); PG8_STAGE(PG8_SB(0, 1), cB + hstepB, voffB); PG8_STAGE_A(PG8_SA(0, 0), cA, 0, false); PG8_STAGE_A(PG8_SA(0, 1), cA, 1, false);
    if (wr == 1) PG8_BAR;
    PG8_WAIT_V(2); PG8_BAR;
    PG8_STAGE(PG8_SB(1, 0), cB + kstep, voffB); PG8_STAGE_A(PG8_SA(1, 0), cA + kstep, 0, false); PG8_STAGE(PG8_SB(1, 1), cB + hstepB + kstep, voffB);
    PG8_WAIT_V(6); PG8_BAR;
    for (;;) {
        const bool has_next = S.next(ui + 1, nxt);
        const char* nA = has_next ? (const char*)g.A + (GATHER ? (size_t)0 : (size_t)nxt.pm * tstepA) : cA; const char* nB = has_next ? (const char*)g.Bt + (size_t)nxt.bt * tstepB : cB;
        if constexpr (GATHER) { if (has_next) { PG8_ROWOFF(vn, ui + 1); } else {
#pragma unroll
            for (int h_ = 0; h_ < 2; ++h_)
#pragma unroll
                for (int i_ = 0; i_ < 2; ++i_) vn[h_][i_] = va[h_][i_]; } }
        for (int t = 0; t < nt; t += 2) {
            const bool last = (t == nt - 2);
            const char* a1 = cA + (size_t)(t + 1) * kstep;
            const char* a2 = last ? nA : cA + (size_t)(t + 2) * kstep; const char* b2 = last ? nB : cB + (size_t)(t + 2) * kstep;
            const char* a3 = a2 + kstep; const char* b3 = b2 + kstep;
            PG8_LDB(B0, 0, 0); PG8_LDB(B1, 0, 1); PG8_SCHED; PG8_LDA(At, 0, 0); PG8_STAGE_A(PG8_SA(1, 1), a1, 1, false);
            PG8_WAIT_V(8); PG8_WAIT_L(0); PG8_BAR; PG8_MMA(0, 0, At, B0); PG8_MMA(0, 1, At, B1); PG8_BAR; PG8_SCHED;
            PG8_LDA(At, 0, 1); PG8_STAGE(PG8_SB(0, 0), b2, voffB); PG8_STAGE(PG8_SB(0, 1), b2 + hstepB, voffB); PG8_STAGE_A(PG8_SA(0, 0), a2, 0, last);
            PG8_WAIT_V(8); PG8_WAIT_L(0); PG8_BAR; PG8_MMA(1, 0, At, B0); PG8_MMA(1, 1, At, B1); PG8_BAR; PG8_SCHED;
            PG8_LDB(B0, 1, 0); PG8_LDB(B1, 1, 1); PG8_SCHED; PG8_LDA(At, 1, 0); PG8_STAGE_A(PG8_SA(0, 1), a2, 1, last);
            PG8_WAIT_V(8); PG8_WAIT_L(0); PG8_BAR; PG8_MMA(0, 0, At, B0); PG8_MMA(0, 1, At, B1); PG8_BAR; PG8_SCHED;
            PG8_LDA(At, 1, 1); PG8_STAGE(PG8_SB(1, 0), b3, voffB); PG8_STAGE(PG8_SB(1, 1), b3 + hstepB, voffB); PG8_STAGE_A(PG8_SA(1, 0), a3, 0, last);
            PG8_WAIT_V(8); PG8_WAIT_L(0); PG8_BAR; PG8_MMA(1, 0, At, B0); PG8_MMA(1, 1, At, B1); PG8_BAR; PG8_SCHED;
        }
        if constexpr (ALIGN_EPI) { if (wr == 0) PG8_BAR; }
        E(acc, cur, wr, wc, fr, fq);
        if (!has_next) break;
#pragma unroll
        for (int a = 0; a < 2; ++a)
#pragma unroll
            for (int b = 0; b < 2; ++b)
#pragma unroll
                for (int m = 0; m < 4; ++m)
#pragma unroll
                    for (int n = 0; n < 2; ++n) acc[a][b][m][n] = (f32x4){0.f, 0.f, 0.f, 0.f};
        cur = nxt; cA = nA; cB = nB; ++ui;
        if constexpr (GATHER) {
#pragma unroll
            for (int h_ = 0; h_ < 2; ++h_)
#pragma unroll
                for (int i_ = 0; i_ < 2; ++i_) va[h_][i_] = vn[h_][i_]; }
        if constexpr (ALIGN_EPI) { if (wr == 1) PG8_BAR; }
    }
    PG8_WAIT_V(0);
    if constexpr (!ALIGN_EPI) { if (wr == 0) PG8_BAR; }
    PG8_BAR;
#undef PG8_SA
#undef PG8_SB
#undef PG8_STAGE
#undef PG8_STAGE_A
#undef PG8_LDA
#undef PG8_LDB
#undef PG8_MMA
#undef PG8_WAIT_V
#undef PG8_WAIT_L
#undef PG8_BAR
#undef PG8_SCHED
#undef PG8_ROWOFF
}

template <class Epi, class Sched, bool ALIGN_EPI, bool GATHER>
__device__ __forceinline__ void gemm_phase8(PG8_LAS unsigned char* lds, const Gemm g, const Sched& S, const Epi& E, const PG8_LAS int* rowtab) {
    int tid_ = threadIdx.x; asm volatile("" : "+v"(tid_));
    const int tid = tid_, wid = __builtin_amdgcn_readfirstlane(tid >> 6), lane = tid & 63, wr = wid >> 2, wc = wid & 3, fr = lane & 15, fq = lane >> 4;
    int K_ = g.K; asm volatile("" : "+s"(K_));
    const int K = K_, nt = K / 128, lda = g.lda;
    unsigned voffA[2], voffB[2]; int RA[2]; unsigned CA2[2];
#pragma unroll
    for (int i = 0; i < 2; ++i) { const int u = tid * 16 + i * 8192; const int R = 16 * (u >> 11) + ((u & 1023) >> 6), J = 4 * ((u >> 10) & 1) + (((u & 63) >> 4) ^ ((R >> 2) & 3)); const int Rb = Epi::WIDE ? (64 * (R >> 5) + perm32(R & 31)) : Epi::PERM ? ((R & ~31) + perm32(R & 31)) : R;
        voffA[i] = (unsigned)(R * lda + J * 16); voffB[i] = (unsigned)(Rb * K + J * 16); RA[i] = R; CA2[i] = (unsigned)(J * 16); }
    const size_t kstep = (size_t)128;
    const size_t hstepA = (size_t)HALF * lda, tstepA = 2 * hstepA;
    const size_t hstepB = (size_t)(Epi::WIDE ? 32 : HALF) * K, tstepB = (size_t)2 * HALF * K;
    const unsigned ldsw = (unsigned)wid * 1024u;
    const int aoff0 = wr * 8192 + fr * 64 + 16 * (fq ^ ((fr >> 2) & 3)), boff0 = wc * 4096 + fr * 64 + 16 * (fq ^ ((fr >> 2) & 3));
    unsigned va[2][2], vn[2][2];
#define PG8_SA(b, h) (((b) * 2 + (h)) * HTB)
#define PG8_SB(b, h) ((4 + (b) * 2 + (h)) * HTB)
#define PG8_STAGE(bufoff, gbase, voff) do { _Pragma("unroll") for (int _i = 0; _i < 2; ++_i) \
        __builtin_amdgcn_global_load_lds((const unsigned*)((const char*)(gbase) + (voff)[_i]), (PG8_LAS unsigned*)(lds + (bufoff) + ldsw + _i * 8192), 16, 0, 0); } while (0)
#define PG8_STAGE_A(bufoff, gbase, h, NXT) do { if constexpr (GATHER) { unsigned o_[2]; o_[0] = (NXT) ? vn[h][0] : va[h][0]; o_[1] = (NXT) ? vn[h][1] : va[h][1]; PG8_STAGE(bufoff, gbase, o_); } \
        else { PG8_STAGE(bufoff, (gbase) + (h) * hstepA, voffA); } } while (0)
#define PG8_LDA(dst, b, h) do { _Pragma("unroll") for (int m = 0; m < 4; ++m) { const v4i32 lo_ = *(const PG8_LAS v4i32*)(lds + PG8_SA(b, h) + aoff0 + m * 2048), hi_ = *(const PG8_LAS v4i32*)(lds + PG8_SA(b, h) + aoff0 + m * 2048 + 1024); dst[m] = __builtin_shufflevector(lo_, hi_, 0, 1, 2, 3, 4, 5, 6, 7); } } while (0)
#define PG8_LDB(dst, b, h) do { _Pragma("unroll") for (int n = 0; n < 2; ++n) { const v4i32 lo_ = *(const PG8_LAS v4i32*)(lds + PG8_SB(b, h) + boff0 + n * 2048), hi_ = *(const PG8_LAS v4i32*)(lds + PG8_SB(b, h) + boff0 + n * 2048 + 1024); dst[n] = __builtin_shufflevector(lo_, hi_, 0, 1, 2, 3, 4, 5, 6, 7); } } while (0)
#define PG8_F8(F_) ((v8i32){(int)F_[0][0], (int)F_[0][1], (int)F_[0][2], (int)F_[0][3], (int)F_[1][0], (int)F_[1][1], (int)F_[1][2], (int)F_[1][3]})
#define PG8_MMA(ai, bj, At, Bt) do { __builtin_amdgcn_s_setprio(1); _Pragma("unroll") for (int m = 0; m < 4; ++m) _Pragma("unroll") for (int n = 0; n < 2; ++n) \
        asm volatile("v_mfma_scale_f32_16x16x128_f8f6f4 %0, %1, %2, %0, %3, %4 op_sel_hi:[0,0,0]" : "+v"(acc[ai][bj][m][n]) : "v"(Bt[n]), "v"(At[m]), "v"(sclw_), "v"(scl_));     __builtin_amdgcn_s_setprio(0); } while (0)
#define PG8_WAIT_V(n) asm volatile("s_waitcnt vmcnt(" #n ")" ::: "memory")
#define PG8_WAIT_L(n) asm volatile("s_waitcnt lgkmcnt(" #n ")" ::: "memory")
#define PG8_BAR __builtin_amdgcn_s_barrier()
#define PG8_SCHED __builtin_amdgcn_sched_barrier(0)
#define PG8_ROWOFF(dst, ui_) do { _Pragma("unroll") for (int h_ = 0; h_ < 2; ++h_) _Pragma("unroll") for (int i_ = 0; i_ < 2; ++i_) \
        dst[h_][i_] = (unsigned)rowtab[(ui_) * 256 + h_ * 128 + RA[i_]] * (unsigned)lda + CA2[i_]; } while (0)
    Unit cur, nxt; int ui = 0;
    if (!S.next(0, cur)) return;
    int scl_ = g.ascale, sclw_ = 0x7A7A7A7A; asm volatile("" : "+v"(scl_), "+v"(sclw_));
    float z_ = 0.f; asm volatile("" : "+v"(z_));
    f32x4 acc[2][2][4][2];
#pragma unroll
    for (int a = 0; a < 2; ++a)
#pragma unroll
        for (int b = 0; b < 2; ++b)
#pragma unroll
            for (int m = 0; m < 4; ++m)
#pragma unroll
                for (int n = 0; n < 2; ++n) acc[a][b][m][n] = (f32x4){z_, z_, z_, z_};
    v8i32 At[4], B0[2], B1[2];
    const char* cA = (const char*)g.A + (GATHER ? (size_t)0 : (size_t)cur.pm * tstepA); const char* cB = (const char*)g.Bt + (size_t)cur.bt * tstepB;
    if constexpr (GATHER) { PG8_ROWOFF(va, 0); }
    PG8_STAGE(PG8_SB(0, 0), cB, voffB); PG8_STAGE(PG8_SB(0, 1), cB + hstepB, voffB); PG8_STAGE_A(PG8_SA(0, 0), cA, 0, false); PG8_STAGE_A(PG8_SA(0, 1), cA, 1, false);
    if (wr == 1) PG8_BAR;
    PG8_WAIT_V(2); PG8_BAR;
    PG8_STAGE(PG8_SB(1, 0), cB + kstep, voffB); PG8_STAGE_A(PG8_SA(1, 0), cA + kstep, 0, false); PG8_STAGE(PG8_SB(1, 1), cB + hstepB + kstep, voffB);
    PG8_WAIT_V(6); PG8_BAR;
    for (;;) {
        const bool has_next = S.next(ui + 1, nxt);
        const char* nA = has_next ? (const char*)g.A + (GATHER ? (size_t)0 : (size_t)nxt.pm * tstepA) : cA; const char* nB = has_next ? (const char*)g.Bt + (size_t)nxt.bt * tstepB : cB;
        asm volatile("" : "+s"(nB));
        if constexpr (GATHER) { if (has_next) { PG8_ROWOFF(vn, ui + 1); } else {
#pragma unroll
            for (int h_ = 0; h_ < 2; ++h_)
#pragma unroll
                for (int i_ = 0; i_ < 2; ++i_) vn[h_][i_] = va[h_][i_]; } }
#pragma unroll 1
        for (int t = 0; t < nt; t += 2) {
            const bool last = (t == nt - 2);
            const char* a1 = cA + (size_t)(t + 1) * kstep;
            const char* a2 = last ? nA : cA + (size_t)(t + 2) * kstep; const char* b2 = last ? nB : cB + (size_t)(t + 2) * kstep;
            const char* a3 = a2 + kstep; const char* b3 = b2 + kstep;
            PG8_LDB(B0, 0, 0); PG8_LDB(B1, 0, 1); PG8_SCHED; PG8_LDA(At, 0, 0); PG8_STAGE_A(PG8_SA(1, 1), a1, 1, false);
            PG8_WAIT_V(8); PG8_WAIT_L(0); PG8_BAR; PG8_MMA(0, 0, At, B0); PG8_MMA(0, 1, At, B1); PG8_BAR; PG8_SCHED;
            PG8_LDA(At, 0, 1); PG8_STAGE(PG8_SB(0, 0), b2, voffB); PG8_STAGE(PG8_SB(0, 1), b2 + hstepB, voffB); PG8_STAGE_A(PG8_SA(0, 0), a2, 0, last);
            PG8_WAIT_V(8); PG8_WAIT_L(0); PG8_BAR; PG8_MMA(1, 0, At, B0); PG8_MMA(1, 1, At, B1); PG8_BAR; PG8_SCHED;
            PG8_LDB(B0, 1, 0); PG8_LDB(B1, 1, 1); PG8_SCHED; PG8_LDA(At, 1, 0); PG8_STAGE_A(PG8_SA(0, 1), a2, 1, last);
            PG8_WAIT_V(8); PG8_WAIT_L(0); PG8_BAR; PG8_MMA(0, 0, At, B0); PG8_MMA(0, 1, At, B1); PG8_BAR; PG8_SCHED;
            PG8_LDA(At, 1, 1); PG8_STAGE(PG8_SB(1, 0), b3, voffB); PG8_STAGE(PG8_SB(1, 1), b3 + hstepB, voffB); PG8_STAGE_A(PG8_SA(1, 0), a3, 0, last);
            PG8_WAIT_V(8); PG8_WAIT_L(0); PG8_BAR; PG8_MMA(1, 0, At, B0); PG8_MMA(1, 1, At, B1); PG8_BAR; PG8_SCHED;
        }
        if constexpr (ALIGN_EPI) { if (wr == 0) PG8_BAR; }
        asm volatile("s_nop 15\n\ts_nop 7" ::: "memory");
        E(acc, cur, wr, wc, fr, fq);
        if (!has_next) break;
#pragma unroll
        for (int a = 0; a < 2; ++a)
#pragma unroll
            for (int b = 0; b < 2; ++b)
#pragma unroll
                for (int m = 0; m < 4; ++m)
#pragma unroll
                    for (int n = 0; n < 2; ++n) acc[a][b][m][n] = (f32x4){z_, z_, z_, z_};
        cur = nxt; cA = nA; cB = nB; ++ui;
        if constexpr (GATHER) {
#pragma unroll
            for (int h_ = 0; h_ < 2; ++h_)
#pragma unroll
                for (int i_ = 0; i_ < 2; ++i_) va[h_][i_] = vn[h_][i_]; }
        if constexpr (ALIGN_EPI) { if (wr == 1) PG8_BAR; }
    }
    PG8_WAIT_V(0);
    if constexpr (!ALIGN_EPI) { if (wr == 0) PG8_BAR; }
    PG8_BAR;
#undef PG8_SA
#undef PG8_SB
#undef PG8_STAGE
#undef PG8_STAGE_A
#undef PG8_LDA
#undef PG8_LDB
#undef PG8_MMA
#undef PG8_WAIT_V
#undef PG8_WAIT_L
#undef PG8_BAR
#undef PG8_SCHED
#undef PG8_ROWOFF
#undef PG8_F8
}


typedef const f32x4 (&AccRef)[2][2][4][2];
#define EPI_ROWS(...) _Pragma("unroll") for (int ai = 0; ai < 2; ++ai) _Pragma("unroll") for (int m = 0; m < 4; ++m) { const int row = u.pm * BM + ai * HALF + wr * 64 + m * 16 + fr; __VA_ARGS__ }

template <bool F8> struct EpiInproj {
    static constexpr bool PERM = true, WIDE = !F8;
    unsigned char* ws;
    __device__ __forceinline__ void operator()(AccRef acc, const Unit& u, int wr, int wc, int fr, int fq) const {
        if constexpr (F8) {
            unsigned char* gb = ws + WS_G + (size_t)(u.pn * 256 + wc * 32 + 8 * fq);
            EPI_ROWS(
                unsigned char* rp = gb + (size_t)row * 2048;
                _Pragma("unroll") for (int bj = 0; bj < 2; ++bj) *(u32x2*)(rp + bj * HALF) = pack8_fp8(acc[ai][bj][m][0], acc[ai][bj][m][1]);
            )
            return;
        }
        const int pn = u.pn; const bool odd = fr & 1;
#if G_FP8
        if (pn >= 8) {
            unsigned char* gb = ws + WS_G + (size_t)((pn - 8) * 256 + wc * 64 + 8 * fq + (odd ? 32 : 0));
            EPI_ROWS(
                const u32x2 x0 = pack8_fp8(acc[ai][0][m][0], acc[ai][0][m][1]), x1 = pack8_fp8(acc[ai][1][m][0], acc[ai][1][m][1]);
                const u32x2 snd = odd ? x0 : x1; u32x2 rcv; rcv.x = lane_xor1(snd.x); rcv.y = lane_xor1(snd.y);
                unsigned char* rp = gb + (size_t)(row & ~1) * 2048;
                *(u32x2*)rp = odd ? rcv : x0; *(u32x2*)(rp + 2048) = odd ? x1 : rcv;
            )
            return;
        }
#endif
        const size_t off = pn < 6 ? WS_QF + (size_t)(pn >> 1) * (WS_KF - WS_QF) : pn < 8 ? WS_QL : WS_G;
        const int ld = pn < 8 ? 512 : 2048, col0 = (pn < 6 ? (pn & 1) : pn < 8 ? (pn - 6) : (pn - 8)) * 256 + wc * 64 + 8 * fq + (odd ? 32 : 0);
        const float sc = (pn < 2 ? C2F : 1.f);
        bf16_t* base = (bf16_t*)(ws + off) + col0;
        EPI_ROWS(
            const u32x4 x0 = pack8(acc[ai][0][m][0] * sc, acc[ai][0][m][1] * sc), x1 = pack8(acc[ai][1][m][0] * sc, acc[ai][1][m][1] * sc);
            const u32x4 snd = odd ? x0 : x1; u32x4 rcv; rcv.x = lane_xor1(snd.x); rcv.y = lane_xor1(snd.y); rcv.z = lane_xor1(snd.z); rcv.w = lane_xor1(snd.w);
            bf16_t* rp = base + (size_t)(row & ~1) * ld;
            *(u32x4*)rp = odd ? rcv : x0; *(u32x4*)(rp + ld) = odd ? x1 : rcv;
        )
    }
};
struct EpiQup {
    static constexpr bool PERM = true, WIDE = false;
    bf16_t* QM; const float *SSQ, *CS;
    __device__ __forceinline__ void operator()(AccRef acc, const Unit& u, int wr, int wc, int fr, int fq) const {
        const int pn = u.pn;
        if (pn < 2) {
            EPI_ROWS(
                const float rs = C2M * SSQ[(size_t)row * 2];
                _Pragma("unroll") for (int bj = 0; bj < 2; ++bj) { const int c = pn * 256 + bj * HALF + wc * 32 + 8 * fq, h = c >> 6, d = c & 63;
                    *(u32x4*)(QM + (size_t)row * 768 + h * 96 + d) = pack8(acc[ai][bj][m][0] * rs, acc[ai][bj][m][1] * rs); }
            )
        } else {
            const float sgn = (fq < 2) ? -1.f : 1.f;
            EPI_ROWS(
                const float rs = C2M * SSQ[(size_t)row * 2];
                const float* cs = CS + (size_t)row * 32 + ((8 * fq) & 15);
                f32x4 c0 = *(const f32x4*)(cs) * rs, c1 = *(const f32x4*)(cs + 4) * rs, s0 = *(const f32x4*)(cs + 16) * (rs * sgn), s1 = *(const f32x4*)(cs + 20) * (rs * sgn);
                _Pragma("unroll") for (int bj = 0; bj < 2; ++bj) { const int h = 4 * bj + wc; f32x4 o0, o1;
                    _Pragma("unroll") for (int i = 0; i < 4; ++i) {
                        const float v0 = acc[ai][bj][m][0][i], v1 = acc[ai][bj][m][1][i]; const float p0 = __shfl_xor(v0, 32), p1 = __shfl_xor(v1, 32);
                        o0[i] = v0 * c0[i] + p0 * s0[i]; o1[i] = v1 * c1[i] + p1 * s1[i]; }
                    *(u32x4*)(QM + (size_t)row * 768 + h * 96 + 64 + 8 * fq) = pack8(o0, o1); }
            )
        }
    }
};
struct EpiKvup {
    static constexpr bool PERM = true, WIDE = false;
    bf16_t* KN; const float* SSQ;
    __device__ __forceinline__ void operator()(AccRef acc, const Unit& u, int wr, int wc, int fr, int fq) const {
        bf16_t* base = KN + (size_t)(u.pn >> 1) * ((WS_VM - WS_KN) / 2) + (u.pn & 1) * 256 + wc * 32 + 8 * fq;
        EPI_ROWS(
            const float rs = SSQ[(size_t)row * 2 + 1];
            _Pragma("unroll") for (int bj = 0; bj < 2; ++bj) *(u32x4*)(base + (size_t)row * 512 + bj * HALF) = pack8(acc[ai][bj][m][0] * rs, acc[ai][bj][m][1] * rs);
        )
    }
};
template <int STEP> struct EpiMerge {
    static constexpr bool PERM = true, WIDE = true;
    bf16_t *T0, *MG; const bf16_t* G; const float* b_merge;
    __device__ __forceinline__ void operator()(AccRef acc, const Unit& u, int wr, int wc, int fr, int fq) const {
        const int c0 = u.pn * 256 + wc * 64 + 8 * fq; const bool odd = fr & 1;
        f32x4 bm[2][2];
        _Pragma("unroll") for (int bj = 0; bj < 2; ++bj) { bm[bj][0] = *(const f32x4*)(b_merge + STEP * 1024 + c0 + bj * 32); bm[bj][1] = *(const f32x4*)(b_merge + STEP * 1024 + c0 + bj * 32 + 4); }
        _Pragma("unroll") for (int ai = 0; ai < 2; ++ai) {
            u32x4 tv[4][2];
#if G_FP8
            u32x2 gv[4][2];
#else
            u32x4 gv[4][2];
#endif
            _Pragma("unroll") for (int m = 0; m < 4; ++m) _Pragma("unroll") for (int bj = 0; bj < 2; ++bj) { const size_t row = (size_t)(u.pm * BM + ai * HALF + wr * 64 + m * 16 + fr);
#if G_FP8
                gv[m][bj] = *(const u32x2*)((const unsigned char*)G + row * 2048 + STEP * 1024 + c0 + bj * 32);
#else
                gv[m][bj] = *(const u32x4*)(G + row * 2048 + STEP * 1024 + c0 + bj * 32);
#endif
                if (STEP == 1) tv[m][bj] = *(const u32x4*)(T0 + row * 1024 + c0 + bj * 32); }
            _Pragma("unroll") for (int m = 0; m < 4; ++m) { const size_t row = (size_t)(u.pm * BM + ai * HALF + wr * 64 + m * 16 + fr); u32x4 xo[2];
              _Pragma("unroll") for (int bj = 0; bj < 2; ++bj) {
                const f32x4 bm0 = bm[bj][0], bm1 = bm[bj][1];
                f32x4 a = acc[ai][bj][m][0], b = acc[ai][bj][m][1];
#if G_FP8
                { const u32x2 g = gv[m][bj];
                  const f32x2 g01 = __builtin_amdgcn_cvt_pk_f32_fp8((int)g.x, false), g23 = __builtin_amdgcn_cvt_pk_f32_fp8((int)g.x, true), g45 = __builtin_amdgcn_cvt_pk_f32_fp8((int)g.y, false), g67 = __builtin_amdgcn_cvt_pk_f32_fp8((int)g.y, true);
                  const f32x2 s01 = fsigmoid2(g01 + (f32x2){bm0[0], bm0[1]}), s23 = fsigmoid2(g23 + (f32x2){bm0[2], bm0[3]}), s45 = fsigmoid2(g45 + (f32x2){bm1[0], bm1[1]}), s67 = fsigmoid2(g67 + (f32x2){bm1[2], bm1[3]});
                  const f32x2 a01 = (f32x2){a[0], a[1]} * s01, a23 = (f32x2){a[2], a[3]} * s23, b01 = (f32x2){b[0], b[1]} * s45, b23 = (f32x2){b[2], b[3]} * s67;
                  a = (f32x4){a01.x, a01.y, a23.x, a23.y}; b = (f32x4){b01.x, b01.y, b23.x, b23.y}; }
#else
                const u32x4 g = gv[m][bj];
                a[0] *= fsigmoid(bflo(g.x) + bm0[0]); a[1] *= fsigmoid(bfhi(g.x) + bm0[1]); a[2] *= fsigmoid(bflo(g.y) + bm0[2]); a[3] *= fsigmoid(bfhi(g.y) + bm0[3]);
                b[0] *= fsigmoid(bflo(g.z) + bm1[0]); b[1] *= fsigmoid(bfhi(g.z) + bm1[1]); b[2] *= fsigmoid(bflo(g.w) + bm1[2]); b[3] *= fsigmoid(bfhi(g.w) + bm1[3]);
#endif
                if (STEP == 1) { const u32x4 t = tv[m][bj];
                    a[0] += bflo(t.x); a[1] += bfhi(t.x); a[2] += bflo(t.y); a[3] += bfhi(t.y); b[0] += bflo(t.z); b[1] += bfhi(t.z); b[2] += bflo(t.w); b[3] += bfhi(t.w);
#if WO_FP8
                    { _Pragma("unroll") for (int i = 0; i < 4; ++i) { a[i] = fminf(fmaxf(a[i] * 16.f, -448.f), 448.f); b[i] = fminf(fmaxf(b[i] * 16.f, -448.f), 448.f); }
                      const u32x2 q8 = pack8_fp8(a, b); xo[bj] = (u32x4){q8.x, q8.y, 0u, 0u}; } }
#else
                    xo[bj] = pack8(a, b); }
#endif
                else xo[bj] = pack8(a, b); }
#if WO_FP8
              if (STEP == 1) { const u32x2 s2 = odd ? (u32x2){xo[0].x, xo[0].y} : (u32x2){xo[1].x, xo[1].y}; u32x2 r2; r2.x = lane_xor1(s2.x); r2.y = lane_xor1(s2.y);
                unsigned char* rp = (unsigned char*)MG + (row & ~(size_t)1) * 1024 + c0 + (odd ? 32 : 0);
                *(u32x2*)rp = odd ? r2 : (u32x2){xo[0].x, xo[0].y}; *(u32x2*)(rp + 1024) = odd ? (u32x2){xo[1].x, xo[1].y} : r2; } else
#endif
              { const u32x4 snd = odd ? xo[0] : xo[1]; u32x4 rcv; rcv.x = lane_xor1(snd.x); rcv.y = lane_xor1(snd.y); rcv.z = lane_xor1(snd.z); rcv.w = lane_xor1(snd.w);
                bf16_t* rp = (STEP == 1 ? MG : T0) + (row & ~(size_t)1) * 1024 + c0 + (odd ? 32 : 0);
                *(u32x4*)rp = odd ? rcv : xo[0]; *(u32x4*)(rp + 1024) = odd ? xo[1] : rcv; } }
        }
    }
};
template <int MB> struct EpiWoT {
    static constexpr bool PERM = true, WIDE = (MB == 2);
    const float* x; bf16_t* X1;
    __device__ __forceinline__ void operator()(AccRef acc, const Unit& u, int wr, int wc, int fr, int fq) const {
        if constexpr (MB == 1) {
            const int c0 = u.pn * 256 + wc * 32 + 8 * fq;
            EPI_ROWS(
                const float* xl = x + (size_t)row * 1024 + c0; asm volatile("" : "+v"(xl));
                _Pragma("unroll") for (int bj = 0; bj < 2; ++bj) { const f32x4 xa = *(const f32x4*)(xl + bj * HALF), xb = *(const f32x4*)(xl + bj * HALF + 4);
                    *(u32x4*)(X1 + (size_t)row * 1024 + c0 + bj * HALF) = pack8(xa + acc[ai][bj][m][0], xb + acc[ai][bj][m][1]); }
            )
        } else {
        const int c0 = u.pn * 256 + wc * 64 + 8 * fq; const bool odd = fr & 1;
        _Pragma("unroll") for (int ai = 0; ai < 2; ++ai) _Pragma("unroll") for (int mh = 0; mh < 2; ++mh) {
            f32x4 xv[2][2][2];
            _Pragma("unroll") for (int mm = 0; mm < 2; ++mm) _Pragma("unroll") for (int bj = 0; bj < 2; ++bj) { const size_t off = (size_t)(u.pm * BM + ai * HALF + wr * 64 + (2 * mh + mm) * 16 + fr) * 1024 + c0 + bj * 32;
                xv[mm][bj][0] = *(const f32x4*)(x + off); xv[mm][bj][1] = *(const f32x4*)(x + off + 4); }
            _Pragma("unroll") for (int mm = 0; mm < 2; ++mm) { const int m = 2 * mh + mm; const size_t row = (size_t)(u.pm * BM + ai * HALF + wr * 64 + m * 16 + fr);
                const u32x4 x0 = pack8(xv[mm][0][0] + acc[ai][0][m][0], xv[mm][0][1] + acc[ai][0][m][1]), x1 = pack8(xv[mm][1][0] + acc[ai][1][m][0], xv[mm][1][1] + acc[ai][1][m][1]);
                const u32x4 snd = odd ? x0 : x1; u32x4 rcv; rcv.x = lane_xor1(snd.x); rcv.y = lane_xor1(snd.y); rcv.z = lane_xor1(snd.z); rcv.w = lane_xor1(snd.w);
                bf16_t* rp = X1 + (row & ~(size_t)1) * 1024 + c0 + (odd ? 32 : 0);
                *(u32x4*)rp = odd ? rcv : x0; *(u32x4*)(rp + 1024) = odd ? x1 : rcv; }
        }
        }
    }
};
#if WO_FP8
typedef EpiWoT<1> EpiWo;
#else
typedef EpiWoT<2> EpiWo;
#endif
template <bool F8> struct EpiSwiglu {
    static constexpr bool PERM = true, WIDE = false;
    bf16_t* ACT; const float* b_gu;
    __device__ __forceinline__ void operator()(AccRef acc, const Unit& u, int wr, int wc, int fr, int fq) const {
        const int c = u.pn * 128 + wc * 32 + 8 * fq; const float* bg = b_gu + (size_t)u.e * 2048 + c; const float sc = 1.f;
        const f32x4 g0 = *(const f32x4*)(bg), g1 = *(const f32x4*)(bg + 4), u0 = *(const f32x4*)(bg + 1024), u1 = *(const f32x4*)(bg + 1028);
        EPI_ROWS(
            f32x4 ga = acc[ai][0][m][0] * sc + g0, gb = acc[ai][0][m][1] * sc + g1, ua = acc[ai][1][m][0] * sc + u0, ub = acc[ai][1][m][1] * sc + u1, oa, ob;
            _Pragma("unroll") for (int i = 0; i < 4; ++i) {
                const f32x2 x = (f32x2){fminf(ga[i], 7.f), fminf(gb[i], 7.f)}, y = (f32x2){fminf(fmaxf(ua[i], -7.f), 7.f), fminf(fmaxf(ub[i], -7.f), 7.f)};
                const f32x2 r = (y + 1.f) * x * fsigmoid2(x * 1.702f);
                oa[i] = r.x; ob[i] = r.y; }
            if (F8) *(u32x2*)((unsigned char*)ACT + (size_t)row * 1024 + c) = pack8_fp8(oa, ob);
            else *(u32x4*)(ACT + (size_t)row * 1024 + c) = pack8(oa, ob);
        )
    }
};
template <bool F8> struct EpiDown {
    static constexpr bool PERM = true, WIDE = false;
    bf16_t* Z; const float* b_down; const int* ROWSLOT; const float* ROWW; const volatile PG8_LAS int* cntL; const volatile PG8_LAS int* bst;
    __device__ __forceinline__ void operator()(AccRef acc, const Unit& u, int wr, int wc, int fr, int fq) const {
        const int c0 = u.pn * 256 + wc * 32 + 8 * fq; const float* bd = b_down + (size_t)u.e * 1024 + c0; const float sc = 1.f;
#if FUSED_ROWS
        const int eb = u.e * ESTR + ((u.pm - bst[u.e]) << 8) - u.pm * BM;
#endif
        f32x4 bv[2][2];
        _Pragma("unroll") for (int bj = 0; bj < 2; ++bj) _Pragma("unroll") for (int n = 0; n < 2; ++n) bv[bj][n] = *(const f32x4*)(bd + bj * HALF + 4 * n);
        EPI_ROWS(
#if FUSED_ROWS
            const int slot = ROWSLOT[eb + row]; const float w = ROWW[eb + row];
#else
            const int slot = ROWSLOT[row]; const float w = ROWW[row];
#endif
#if Z_FP8
            const float w16 = w * 16.f;
            _Pragma("unroll") for (int bj = 0; bj < 2; ++bj)
                { f32x4 za = (acc[ai][bj][m][0] * sc + bv[bj][0]) * w16, zb = (acc[ai][bj][m][1] * sc + bv[bj][1]) * w16;
                    _Pragma("unroll") for (int i = 0; i < 4; ++i) { za[i] = fminf(fmaxf(za[i], -448.f), 448.f); zb[i] = fminf(fmaxf(zb[i], -448.f), 448.f); }
                    *(u32x2*)((unsigned char*)Z + (size_t)slot * 1024 + c0 + bj * HALF) = pack8_fp8(za, zb); }
#else
            _Pragma("unroll") for (int bj = 0; bj < 2; ++bj)
                *(u32x4*)(Z + (size_t)slot * 1024 + c0 + bj * HALF) = pack8((acc[ai][bj][m][0] * sc + bv[bj][0]) * w, (acc[ai][bj][m][1] * sc + bv[bj][1]) * w);
#endif
        )
    }
};
#undef EPI_ROWS
}

namespace att {
constexpr int KB_OFF = 0, K_OFF = 16384, KSLOT = 12288, V_OFF = K_OFF + 2 * KSLOT, VSLOT = 8192, OST_OFF = V_OFF + 2 * VSLOT, OST_W = 4608, ATT_LDS = OST_OFF + 8 * OST_W + 64;
constexpr int BG_STAGE_OFF = 96 * 1024;
static_assert(ATT_LDS <= BG_STAGE_OFF && BG_STAGE_OFF + 32768 <= RING_BYTES, "attention LDS");
typedef short v4i16_t __attribute__((ext_vector_type(4)));
__device__ __forceinline__ s16x4 vtr(const LAS unsigned char* p) { return __builtin_bit_cast(s16x4, __builtin_amdgcn_ds_read_tr16_b64_v4i16((LAS v4i16_t*)p)); }
__device__ __forceinline__ float xor32(float v) { return __shfl_xor(v, 32); }
__device__ __forceinline__ void glds16(const void* gsrc, unsigned lds_dst) { unsigned keep;
    asm volatile("s_mov_b32 %0, m0\n\ts_mov_b32 m0, %2\n\ts_nop 0\n\tglobal_load_lds_dwordx4 %1, off\n\ts_mov_b32 m0, %0" : "=&s"(keep) : "v"(gsrc), "s"(lds_dst) : "memory"); }

template <int DQ, bool FOX, class CV>
__device__ __forceinline__ void attn_unit(CV& cv, LAS unsigned char* lds, int b, int h, int qb, const bf16* Q, const bf16* K, const bf16* KP, const bf16* V, const float* KBg, bf16* O, float kmax2) {
    constexpr int QP = FOX ? 512 : 768, ND = DQ / 16;
    int tid_ = threadIdx.x; asm volatile("" : "+v"(tid_));
    const int tid = tid_, lane = tid & 63, r32 = lane & 31, hi = lane >> 5; const int wid = __builtin_amdgcn_readfirstlane(tid >> 6);
    const size_t rowbase = (size_t)b * SEQ; const int q0 = qb * 256, NT = q0 / 64 + 4, qw0 = q0 + 32 * wid, my_last = (qw0 + 31) >> 6;
    if (FOX) { const f32x4* src = (const f32x4*)(KBg + (size_t)(b * 8 + h) * SEQ); LAS f32x4* dst = (LAS f32x4*)(lds + KB_OFF);
        for (int i = tid; i < NT * 16; i += 512) dst[i] = src[i]; }
    bf16x8 qr[ND];
    { const bf16* Qw = Q + (rowbase + qw0 + r32) * QP + h * DQ + hi * 8;
#pragma unroll
      for (int d0 = 0; d0 < ND; ++d0) qr[d0] = *(const bf16x8*)(Qw + d0 * 16);
#pragma unroll
      for (int d0 = 0; d0 < ND; ++d0) asm volatile("" : "+v"(qr[d0])); }
    const bf16* ksrc = K + (rowbase + lane) * 512 + h * 64 + wid * 8;
    const bf16* kpsrc = KP + (rowbase + lane) * 32 + (wid & 3) * 8;
    const bf16* vsrc = V + (rowbase + 16 * (wid & 3) + (lane >> 2)) * 512 + h * 64 + (wid >> 2) * 32 + (lane & 3) * 8;
    const unsigned ldsb = (unsigned)(size_t)lds;
#define ATT_ISSUE(t, buf) do { \
        glds16(ksrc + (size_t)(t) * 64 * 512, (unsigned)__builtin_amdgcn_readfirstlane(ldsb + K_OFF + (buf) * KSLOT + wid * 1024)); \
        if (DQ > 64 && wid < 4) glds16(kpsrc + (size_t)(t) * 64 * 32, (unsigned)__builtin_amdgcn_readfirstlane(ldsb + K_OFF + (buf) * KSLOT + (8 + wid) * 1024)); \
        glds16(vsrc + (size_t)(t) * 64 * 512, (unsigned)__builtin_amdgcn_readfirstlane(ldsb + V_OFF + (buf) * VSLOT + wid * 1024)); } while (0)
    float m = 0.f, l = 0.f; f32x16 o0 = {}, o1 = {}, negm = {};
    float bq = 0.f; bool wdone = false;
    volatile LAS int* dflag = (volatile LAS int*)(lds + OST_OFF + 8 * OST_W);
    if (FOX) {
        float qs = 0.f;
#pragma unroll
        for (int d0 = 0; d0 < ND; ++d0)
#pragma unroll
            for (int j = 0; j < 8; ++j) { const float v = bf2f((bf16)qr[d0][j]); qs += v * v; }
        qs += xor32(qs);
        bq = sqrtf(qs) * sqrtf(kmax2) + 1.f;
        if (lane == 0) dflag[wid] = 0x7fffffff;
    }
    ATT_ISSUE(NT - 1, 0);
    if (wid >= 4) __builtin_amdgcn_s_setprio(1);
    for (int it = 0; it < NT; ++it) {
        const int t = NT - 1 - it;
        const bool full = (it == 0) || !(cv.pend && cv.age == 0);
        if (full) VM_WAIT(); else asm volatile("s_waitcnt vmcnt(4)" ::: "memory");
        LDS_WAIT(); __builtin_amdgcn_s_barrier(); asm volatile("" ::: "memory");
        if (FOX && it > 0) { typedef int i32x4_ __attribute__((ext_vector_type(4)));
            const i32x4_ f0 = *(const LAS i32x4_*)(lds + OST_OFF + 8 * OST_W), f1 = *(const LAS i32x4_*)(lds + OST_OFF + 8 * OST_W + 16);
            const int mxf = max(max(max(f0.x, f0.y), max(f0.z, f0.w)), max(max(f1.x, f1.y), max(f1.z, f1.w)));
            if (mxf < it) break; }
        if (cv.pend) { if (full) cv.consume(lane); else cv.age = 1; }
        if (it + 1 < NT) ATT_ISSUE(t - 1, (it + 1) & 1);
        if (!FOX && !cv.pend) cv.issue(lane);
        __builtin_amdgcn_sched_barrier(0);
        if (t <= my_last && !wdone) {
            const LAS unsigned char* Kb = lds + K_OFF + (it & 1) * KSLOT + hi * 1024 + r32 * 16;
            const LAS unsigned char* vp = lds + V_OFF + (it & 1) * VSLOT + ((lane >> 4) & 1) * 32 + (lane & 3) * 8 + (4 * hi + ((lane & 15) >> 2)) * 64;
            bf16x8 kf[2 * ND]; s16x4 vt[16];
#pragma unroll
            for (int d0 = 0; d0 < ND; ++d0) { kf[2 * d0] = *(const LAS bf16x8*)(Kb + d0 * 2048); kf[2 * d0 + 1] = *(const LAS bf16x8*)(Kb + d0 * 2048 + 512); }
            f32x16 p0, p1;
            if (FOX) {
                const LAS float* kbt = (const LAS float*)(lds + KB_OFF) + t * 64 + 4 * hi;
#pragma unroll
                for (int g = 0; g < 4; ++g) { const f32x4 a = *(const LAS f32x4*)(kbt + 8 * g), c = *(const LAS f32x4*)(kbt + 32 + 8 * g);
                    const f32x2 mm = (f32x2){m, m};
                    const f32x2 a01 = (f32x2){a[0], a[1]} - mm, a23 = (f32x2){a[2], a[3]} - mm, c01 = (f32x2){c[0], c[1]} - mm, c23 = (f32x2){c[2], c[3]} - mm;
                    p0[4 * g] = a01.x; p0[4 * g + 1] = a01.y; p0[4 * g + 2] = a23.x; p0[4 * g + 3] = a23.y; p1[4 * g] = c01.x; p1[4 * g + 1] = c01.y; p1[4 * g + 2] = c23.x; p1[4 * g + 3] = c23.y; }
            }
#pragma unroll
            for (int k = 0; k < 4; ++k) { vt[4 * k] = vtr(vp + k * 1024); vt[4 * k + 1] = vtr(vp + k * 1024 + 512); vt[4 * k + 2] = vtr(vp + 4096 + k * 1024); vt[4 * k + 3] = vtr(vp + 4096 + k * 1024 + 512); }
            __builtin_amdgcn_sched_barrier(0);
            if (!FOX) { p0 = negm; p1 = negm; }
#pragma unroll
            for (int d0 = 0; d0 < ND; ++d0) {
                p0 = __builtin_amdgcn_mfma_f32_32x32x16_bf16(kf[2 * d0], qr[d0], p0, 0, 0, 0); p1 = __builtin_amdgcn_mfma_f32_32x32x16_bf16(kf[2 * d0 + 1], qr[d0], p1, 0, 0, 0); }
            const bool first = (t == my_last);
            if (FOX && first) { const int qabs = qw0 + r32, kv0 = t * 64 + 4 * hi;
#pragma unroll
                for (int r = 0; r < 16; ++r) { const int kv = kv0 + (r & 3) + 8 * (r >> 2); if (kv > qabs) p0[r] = -INFINITY; if (kv + 32 > qabs) p1[r] = -INFINITY; } }
            asm volatile("s_nop 15\n\ts_nop 3" : "+v"(p0), "+v"(p1));
            float mx;
            asm("v_max_f32 %0, %1, %2" : "=v"(mx) : "v"(p0[0]), "v"(p1[0]));
#pragma unroll
            for (int r = 1; r < 16; ++r) asm("v_max3_f32 %0, %1, %2, %3" : "=v"(mx) : "v"(mx), "v"(p0[r]), "v"(p1[r]));
            { const auto sw_ = __builtin_amdgcn_permlane32_swap(__float_as_uint(mx), __float_as_uint(mx), false, false);
              asm("v_max_f32 %0, %1, %2" : "=v"(mx) : "v"(__uint_as_float(sw_[0])), "v"(__uint_as_float(sw_[1]))); }
            if (first || __any(mx > 6.f)) {
                const float dl = first ? mx : fmaxf(mx, 0.f), al = __builtin_amdgcn_exp2f(-dl);
                m += dl; l *= al;
#pragma unroll
                for (int r = 0; r < 16; ++r) { p0[r] -= dl; p1[r] -= dl; o0[r] *= al; o1[r] *= al; negm[r] = -m; }
            }
            float sum = 0.f;
#pragma unroll
            for (int r = 0; r < 16; ++r) { p0[r] = __builtin_amdgcn_exp2f(p0[r]); p1[r] = __builtin_amdgcn_exp2f(p1[r]); sum += p0[r] + p1[r]; }
            l += sum;
            u32x4 pw[4];
#pragma unroll
            for (int k = 0; k < 2; ++k) {
                pw[k] = (u32x4){cvt_pk_bf16(p0[8 * k], p0[8 * k + 1]), cvt_pk_bf16(p0[8 * k + 2], p0[8 * k + 3]), cvt_pk_bf16(p0[8 * k + 4], p0[8 * k + 5]), cvt_pk_bf16(p0[8 * k + 6], p0[8 * k + 7])};
                pw[2 + k] = (u32x4){cvt_pk_bf16(p1[8 * k], p1[8 * k + 1]), cvt_pk_bf16(p1[8 * k + 2], p1[8 * k + 3]), cvt_pk_bf16(p1[8 * k + 4], p1[8 * k + 5]), cvt_pk_bf16(p1[8 * k + 6], p1[8 * k + 7])}; }
#pragma unroll
            for (int k = 0; k < 4; ++k) {
                const s16x4 a0 = vt[4 * k], a1 = vt[4 * k + 1], c0 = vt[4 * k + 2], c1 = vt[4 * k + 3];
                const bf16x8 vf0 = (bf16x8){a0[0], a0[1], a0[2], a0[3], a1[0], a1[1], a1[2], a1[3]}, vf1 = (bf16x8){c0[0], c0[1], c0[2], c0[3], c1[0], c1[1], c1[2], c1[3]};
                const bf16x8 pk = __builtin_bit_cast(bf16x8, pw[k]);
                o0 = __builtin_amdgcn_mfma_f32_32x32x16_bf16(vf0, pk, o0, 0, 0, 0); o1 = __builtin_amdgcn_mfma_f32_32x32x16_bf16(vf1, pk, o1, 0, 0, 0); }
            if (FOX && t > 0) { const float kbn = ((const LAS float*)(lds + KB_OFF))[64 * t - 1];
                if (__all(bq + kbn - m <= -40.f)) { wdone = true; if (lane == 0) dflag[wid] = it; } }
        }
    }
#undef ATT_ISSUE
    __builtin_amdgcn_s_setprio(0);
    l += xor32(l); const float il = 1.f / l;
    LAS bf16* stg = (LAS bf16*)(lds + OST_OFF + wid * OST_W);
#pragma unroll
    for (int g = 0; g < 4; ++g) {
        u32x2 w0, w1; w0.x = cvt_pk_bf16(o0[4 * g] * il, o0[4 * g + 1] * il); w0.y = cvt_pk_bf16(o0[4 * g + 2] * il, o0[4 * g + 3] * il);
        w1.x = cvt_pk_bf16(o1[4 * g] * il, o1[4 * g + 1] * il); w1.y = cvt_pk_bf16(o1[4 * g + 2] * il, o1[4 * g + 3] * il);
        *(LAS u32x2*)(stg + r32 * 72 + 8 * g + 4 * hi) = w0; *(LAS u32x2*)(stg + r32 * 72 + 32 + 8 * g + 4 * hi) = w1; }
    LDS_WAIT();
    bf16* Ow = O + (rowbase + qw0) * 512 + h * 64;
#pragma unroll
    for (int i = 0; i < 4; ++i) { const int row = i * 8 + (lane >> 3), ch = lane & 7; const u32x4 v = *(const LAS u32x4*)(stg + row * 72 + ch * 8); *(u32x4*)(Ow + (size_t)row * 512 + ch * 8) = v; }
    __syncthreads();
}
}

#define XB_TMO      128
#define XB_XCNT(j)  (256  + 64 * (j))
#define XB_XSUB(j)  (1280 + 64 * (j))
#define XB_XGEN(j)  (2304 + 64 * (j))
#define XB_TOP      3328
#define XB_TOPGEN   3392
#define XCD_BAR_WORDS 3456
#define XB_SPIN_CAP (1u << 18)
__device__ __forceinline__ unsigned xb_ld(unsigned* p)              { return __hip_atomic_load(p, __ATOMIC_RELAXED, __HIP_MEMORY_SCOPE_AGENT); }
__device__ __forceinline__ unsigned xb_add(unsigned* p, unsigned v) { return __hip_atomic_fetch_add(p, v, __ATOMIC_RELAXED, __HIP_MEMORY_SCOPE_AGENT); }
__device__ __forceinline__ unsigned xb_xcc_id() { return (unsigned)__builtin_amdgcn_s_getreg((3 << 11) | 20) & 0xFu; }
#define XB_SPIN(cond, bar) do { unsigned _sp = 0; while (cond) { __builtin_amdgcn_s_sleep(1); \
    if ((++_sp & 255u) == 0u) { if (xb_ld(&(bar)[XB_TMO])) break; if (_sp > XB_SPIN_CAP) { atomicAdd(&(bar)[XB_TMO], 1u); break; } } } } while (0)
struct XcdBarrier { unsigned* bar; unsigned x; volatile LAS unsigned* st; };
__device__ __forceinline__ XcdBarrier xcd_barrier_post(unsigned* bar, volatile LAS unsigned* st) {
    XcdBarrier b; b.bar = bar; b.x = xb_xcc_id(); b.st = st;
    if (threadIdx.x == 0) (void)xb_add(&bar[XB_XCNT(b.x)], 1u);
    return b;
}
__device__ __forceinline__ void xcd_barrier_complete(unsigned* bar, unsigned x, unsigned& nloc, unsigned& nx) {
    const unsigned G = gridDim.x * gridDim.y * gridDim.z;
    unsigned sum, cnt, mine, sp = 0u;
    for (;;) {
        sum = 0u; cnt = 0u; mine = 0u;
#pragma unroll
        for (unsigned j = 0; j < 16; ++j) { const unsigned c = xb_ld(&bar[XB_XCNT(j)]); sum += c; cnt += (c > 0u) ? 1u : 0u; mine = (j == x) ? c : mine; }
        if (sum == G) break;
        __builtin_amdgcn_s_sleep(1);
        if ((++sp & 255u) == 0u) { if (xb_ld(&bar[XB_TMO])) break; if (sp > XB_SPIN_CAP) { atomicAdd(&bar[XB_TMO], 1u); break; } }
    }
    nloc = mine > 0u ? mine : 1u; nx = cnt > 0u ? cnt : 1u;
}
__device__ __forceinline__ void xcd_barrier(const XcdBarrier& b) {
    asm volatile("s_waitcnt vmcnt(0)" ::: "memory");
    __syncthreads();
    if (threadIdx.x == 0) {
        unsigned* bar = b.bar;
        __builtin_amdgcn_s_waitcnt(0);
        unsigned nloc = b.st[0], nx = b.st[1];
        if (nloc == 0u) { xcd_barrier_complete(bar, b.x, nloc, nx); b.st[0] = nloc; b.st[1] = nx; }
        const unsigned old = xb_add(&bar[XB_XSUB(b.x)], 1u);
        const unsigned gen = old / nloc;
        if (old + 1u == (gen + 1u) * nloc) {
            __builtin_amdgcn_fence(__ATOMIC_RELEASE, "agent");
            asm volatile("s_waitcnt vmcnt(0)" ::: "memory");
            const unsigned og = xb_add(&bar[XB_TOP], 1u);
            const unsigned tg = og / nx;
            if (og + 1u == (tg + 1u) * nx) xb_add(&bar[XB_TOPGEN], 1u);
            else XB_SPIN(xb_ld(&bar[XB_TOPGEN]) == tg, bar);
            __builtin_amdgcn_fence(__ATOMIC_ACQUIRE, "agent");
            xb_add(&bar[XB_XGEN(b.x)], 1u);
            asm volatile("s_waitcnt vmcnt(0)" ::: "memory");
        } else {
            XB_SPIN(xb_ld(&bar[XB_XGEN(b.x)]) == gen, bar);
            __builtin_amdgcn_fence(__ATOMIC_ACQUIRE, "agent");
            asm volatile("s_waitcnt vmcnt(0)" ::: "memory");
        }
    }
    __syncthreads();
}

struct Frame { LAS unsigned char* lds; volatile LAS unsigned* MISC; int tid, wave, vcu, G; };

constexpr int W_SMALL = 128 * 16 + 24 * 4 + 32 * 4 + 32 * 8 + 32 * 8 + 32 * 16, W_ALL = W_SMALL + 32 * 64 * 16 + 32 * 32 * 16;
struct WItem { const float* src; const float* ksc; bf16* dst; int ldw, ldt, nvalid, fp8; };
__device__ __forceinline__ WItem wt_decode(const P& p, int it) {
    constexpr int I_WIN = 128 * 16, I_WQ = 24 * 4, I_WKV = 32 * 4, I_WF = 32 * 8, I_WM = 32 * 8, I_WO = 32 * 16, I_GU = 32 * 64 * 16;
    WItem w; w.ksc = nullptr; w.nvalid = 32; w.fp8 = 0; int r = it;
    if (r < I_WIN) { const int db = r & 127, kb = r >> 7, n = 32 * db; int src0;
        if (n < 1536) src0 = n; else if (n < 1792) src0 = C_QL + (n - 1536);
        else if (n < 2048) { const int j = n - 1792; if (j < 128) src0 = C_KV + j; else if (j == 128) src0 = C_KPE; else if (j == 160) { src0 = C_FL; w.nvalid = 8; } else { src0 = 0; w.nvalid = 0; } }
        else src0 = C_G + (n - 2048);
        w.src = p.w_in + (size_t)(64 * kb) * IN_COLS + src0; w.ldw = IN_COLS; w.dst = WSP(bf16, WS_WIN) + (size_t)n * 1024 + 64 * kb; w.ldt = 1024;
#if GATE_FP8
        if (n >= 2048) { w.fp8 = 1; w.dst = (bf16*)(WSP(unsigned char, WS_WIN8) + (size_t)(n - 2048) * 1024 + 64 * kb); }
#endif
        return w; }
    r -= I_WIN;
    if (r < I_WQ) { const int db = r % 24, kb = r / 24, n = 32 * db; const int src0 = (n < 512) ? (n >> 6) * 96 + (n & 63) : ((n - 512) >> 5) * 96 + 64;
        w.src = p.w_q_b + (size_t)(64 * kb) * 768 + src0; w.ldw = 768; w.ksc = p.g_q_a + 64 * kb; w.dst = WSP(bf16, WS_WQ) + (size_t)n * 256 + 64 * kb; w.ldt = 256; return w; }
    r -= I_WQ;
    if (r < I_WKV) { const int db = r & 31, kb = r >> 5, n = 32 * db; const int nn = n & 511; const int src0 = (nn >> 6) * 128 + (n >= 512 ? 64 : 0) + (nn & 63);
        w.src = p.w_kv_b + (size_t)((kb < 2) ? 64 * kb : 0) * 1024 + src0; w.ldw = 1024; w.ksc = p.g_kv_a + ((kb < 2) ? 64 * kb : 0); w.nvalid = (kb < 2) ? 32 : 0; w.dst = WSP(bf16, WS_WKV) + (size_t)n * 256 + 64 * kb; w.ldt = 256; return w; }
    r -= I_WKV;
    if (r < I_WF) { const int db = r & 31, kb = r >> 5; w.src = p.w_fox + (size_t)(64 * kb) * 1024 + 32 * db; w.ldw = 1024; w.dst = WSP(bf16, WS_WF) + (size_t)(32 * db) * 512 + 64 * kb; w.ldt = 512; return w; }
    r -= I_WF;
    if (r < I_WM) { const int db = r & 31, kb = r >> 5; w.src = p.w_mla + (size_t)(64 * kb) * 1024 + 32 * db; w.ldw = 1024; w.dst = WSP(bf16, WS_WM) + (size_t)(32 * db) * 512 + 64 * kb; w.ldt = 512; return w; }
    r -= I_WM;
    if (r < I_WO) { const int db = r & 31, kb = r >> 5; w.src = p.w_o + (size_t)(64 * kb) * 1024 + 32 * db; w.ldw = 1024; w.ldt = 1024;
#if WO_FP8
        w.fp8 = 1; w.dst = (bf16*)(WSP(unsigned char, WS_WO) + (size_t)(32 * db) * 1024 + 64 * kb);
#else
        w.dst = WSP(bf16, WS_WO) + (size_t)(32 * db) * 1024 + 64 * kb;
#endif
        return w; }
    r -= I_WO;
    if (r < I_GU) { const int e = r >> 10, rr = r & 1023, db = rr & 63, kb = rr >> 6, n = 32 * db; const int src0 = ((n >> 7) & 1) * 1024 + (n >> 8) * 128 + (n & 127);
        w.src = p.w_gu + (size_t)e * 1024 * 2048 + (size_t)(64 * kb) * 2048 + src0; w.ldw = 2048; w.ldt = 1024;
#if MOE_FP8
        w.fp8 = 1; w.dst = (bf16*)(WSP(unsigned char, WS_WGU) + (size_t)e * 2048 * 1024 + (size_t)n * 1024 + 64 * kb);
#else
        w.dst = WSP(bf16, WS_WGU) + (size_t)e * 2048 * 1024 + (size_t)n * 1024 + 64 * kb;
#endif
        return w; }
    r -= I_GU;
    { const int e = r >> 9, rr = r & 511, db = rr & 31, kb = rr >> 5;
        w.src = p.w_down + (size_t)e * 1024 * 1024 + (size_t)(64 * kb) * 1024 + 32 * db; w.ldw = 1024; w.ldt = 1024;
#if MOE_FP8
        w.fp8 = 1; w.dst = (bf16*)(WSP(unsigned char, WS_WD) + (size_t)e * 1024 * 1024 + (size_t)(32 * db) * 1024 + 64 * kb);
#else
        w.dst = WSP(bf16, WS_WD) + (size_t)e * 1024 * 1024 + (size_t)(32 * db) * 1024 + 64 * kb;
#endif
        return w; }
}
struct BgConv {
    const P* p; LAS unsigned char* scr; unsigned stage; int it, step, stride, age; bool active, pend; WItem w;
    __device__ __forceinline__ void init(const P& p_, LAS unsigned char* scr_, LAS unsigned char* stage_, int it0, int stride_) { p = &p_; scr = scr_; stage = (unsigned)(size_t)stage_; it = it0; stride = stride_; step = 0; age = 0; active = it0 < W_ALL; pend = false; w = wt_decode(p_, active ? it0 : W_SMALL); }
    __device__ __forceinline__ void issue(int lane) {
        if (!active) return;
        const float* g = w.src + (size_t)(8 * step + (lane >> 3)) * w.ldw + 4 * (lane & 7);
#pragma unroll
        for (int j = 0; j < 4; ++j) att::glds16(g + (size_t)(8 * j) * w.ldw, stage + 1024 * j);
        pend = true; age = 0;
    }
    __device__ __forceinline__ void consume(int lane) {
        if (!pend) return;
        pend = false;
        { const LAS unsigned char* sp = (const LAS unsigned char*)(size_t)stage + 16 * lane;
          f32x4 x[4];
#pragma unroll
          for (int j = 0; j < 4; ++j) x[j] = *(const LAS f32x4*)(sp + 1024 * j) * 32.f;
          LDS_WAIT(); asm volatile("" ::: "memory");
          LAS unsigned char* q = scr + (8 * step + (lane >> 3)) * 36 + 4 * (lane & 7);
#pragma unroll
          for (int j = 0; j < 4; ++j) { int b = __builtin_amdgcn_cvt_pk_fp8_f32(x[j][0], x[j][1], 0, false); b = __builtin_amdgcn_cvt_pk_fp8_f32(x[j][2], x[j][3], b, true); *(LAS int*)(q + 8 * 36 * j) = b; } }
        step += 4;
        if (step < 8) return;
        LDS_WAIT(); asm volatile("" ::: "memory");
        const int c = lane & 7, ng = lane >> 3;
        unsigned d[8];
#pragma unroll
        for (int q = 0; q < 8; ++q) d[q] = *(const LAS unsigned*)(scr + (8 * c + q) * 36 + 4 * ng);
        unsigned t[2][4];
#pragma unroll
        for (int h = 0; h < 2; ++h) {
            const unsigned p01l = __builtin_amdgcn_perm(d[4 * h + 1], d[4 * h], 0x05010400u), p01h = __builtin_amdgcn_perm(d[4 * h + 1], d[4 * h], 0x07030602u);
            const unsigned p23l = __builtin_amdgcn_perm(d[4 * h + 3], d[4 * h + 2], 0x05010400u), p23h = __builtin_amdgcn_perm(d[4 * h + 3], d[4 * h + 2], 0x07030602u);
            t[h][0] = __builtin_amdgcn_perm(p23l, p01l, 0x05040100u); t[h][1] = __builtin_amdgcn_perm(p23l, p01l, 0x07060302u);
            t[h][2] = __builtin_amdgcn_perm(p23h, p01h, 0x05040100u); t[h][3] = __builtin_amdgcn_perm(p23h, p01h, 0x07060302u); }
        unsigned char* dst = (unsigned char*)w.dst;
#pragma unroll
        for (int j = 0; j < 4; ++j) *(u32x2*)(dst + (size_t)(4 * ng + j) * w.ldt + 8 * c) = (u32x2){t[0][j], t[1][j]};
        LDS_WAIT(); asm volatile("" ::: "memory");
        step = 0; it += stride; active = it < W_ALL; if (active) w = wt_decode(*p, it);
    }
};
__device__ __forceinline__ void wt_load(const WItem& w, f32x4 (&v)[8], int lane) {
    const int n4 = lane & 7;
#pragma unroll
    for (int i = 0; i < 8; ++i) { const int kk = 8 * i + (lane >> 3); v[i] = (f32x4){0.f, 0.f, 0.f, 0.f};
        if (4 * n4 < w.nvalid) { v[i] = *(const f32x4*)(w.src + (size_t)kk * w.ldw + 4 * n4); if (w.ksc) v[i] = v[i] * w.ksc[kk]; } }
}
__device__ __forceinline__ void wt_store(const WItem& w, const f32x4 (&v)[8], LAS float* scr, int lane) {
    const int n4 = lane & 7;
#pragma unroll
    for (int i = 0; i < 8; ++i) { const int kk = 8 * i + (lane >> 3); LAS float* s = scr + kk * 33 + 4 * n4; s[0] = v[i][0]; s[1] = v[i][1]; s[2] = v[i][2]; s[3] = v[i][3]; }
    LDS_WAIT(); asm volatile("" ::: "memory");
    const int c = lane & 7;
#pragma unroll
    for (int j = 0; j < 4; ++j) { const int n = (lane >> 3) + 8 * j; const LAS float* s = scr + (8 * c) * 33 + n;
        if (w.fp8) { *(u32x2*)((unsigned char*)w.dst + (size_t)n * w.ldt + 8 * c) = pack8_fp8((f32x4){s[0 * 33], s[1 * 33], s[2 * 33], s[3 * 33]} * 32.f, (f32x4){s[4 * 33], s[5 * 33], s[6 * 33], s[7 * 33]} * 32.f); }
        else { u32x4 o; o.x = cvt_pk_bf16(s[0 * 33], s[1 * 33]); o.y = cvt_pk_bf16(s[2 * 33], s[3 * 33]); o.z = cvt_pk_bf16(s[4 * 33], s[5 * 33]); o.w = cvt_pk_bf16(s[6 * 33], s[7 * 33]);
            *(u32x4*)(w.dst + (size_t)n * w.ldt + 8 * c) = o; } }
    LDS_WAIT(); asm volatile("" ::: "memory");
}
__device__ __forceinline__ void wt_convert_range(const P& p, Frame& F, int lo, int hi) {
    LAS float* scr = (LAS float*)(F.lds + F.wave * 16384);
    const int gw = F.vcu * NWAVES + F.wave, NGW = F.G * NWAVES;
    int it = lo + gw; f32x4 va[8], vb[8];
    WItem wa = wt_decode(p, it < hi ? it : lo), wb = wa;
    if (it < hi) wt_load(wa, va, (F.tid & 63));
    while (it < hi) {
        const int nx = it + NGW;
        if (nx < hi) { wb = wt_decode(p, nx); wt_load(wb, vb, (F.tid & 63)); }
        wt_store(wa, va, scr, (F.tid & 63));
        it = nx; if (it >= hi) break;
        const int nx2 = it + NGW;
        if (nx2 < hi) { wa = wt_decode(p, nx2); wt_load(wa, va, (F.tid & 63)); }
        wt_store(wb, vb, scr, (F.tid & 63));
        it = nx2;
    }
}
__device__ __forceinline__ void p0_prologue(const P& p, Frame& F) {
    LAS float* scr = (LAS float*)(F.lds + F.wave * 16384);
    const int gw = F.vcu * NWAVES + F.wave, NGW = F.G * NWAVES;
    constexpr int NITEMS = W_SMALL;
    {
        int it = gw; f32x4 va[8], vb[8];
        WItem wa = wt_decode(p, it < NITEMS ? it : 0), wb = wa;
        if (it < NITEMS) wt_load(wa, va, (F.tid & 63));
        while (it < NITEMS) {
            const int nx = it + NGW;
            if (nx < NITEMS) { wb = wt_decode(p, nx); wt_load(wb, vb, (F.tid & 63)); }
            wt_store(wa, va, scr, (F.tid & 63));
            it = nx; if (it >= NITEMS) break;
            const int nx2 = it + NGW;
            if (nx2 < NITEMS) { wa = wt_decode(p, nx2); wt_load(wa, va, (F.tid & 63)); }
            wt_store(wb, vb, scr, (F.tid & 63));
            it = nx2;
        }
    }
    for (int m0 = gw; m0 < NTOK; m0 += 2 * NGW) {
        f32x4 v[2][4];
#pragma unroll
        for (int q = 0; q < 2; ++q) { const int mrow = (m0 + q * NGW < NTOK) ? m0 + q * NGW : m0; const f32x4* xr = (const f32x4*)(p.x + (size_t)mrow * DM) + (F.tid & 63);
#pragma unroll
            for (int j = 0; j < 4; ++j) v[q][j] = xr[64 * j]; }
#pragma unroll
        for (int q = 0; q < 2; ++q) { const int mrow = m0 + q * NGW; if (mrow >= NTOK) break;
            float s = 0.f;
#pragma unroll
            for (int j = 0; j < 4; ++j) s += (v[q][j].x * v[q][j].x + v[q][j].y * v[q][j].y) + (v[q][j].z * v[q][j].z + v[q][j].w * v[q][j].w);
            const float rs = 1.f / sqrtf(wave_sum(s) * (1.f / DM) + EPS);
            const f32x4* gr = (const f32x4*)p.g_attn + (F.tid & 63); u32x2* o8 = (u32x2*)(WSP(bf16, WS_H) + (size_t)mrow * DM) + (F.tid & 63);
#pragma unroll
            for (int j = 0; j < 4; ++j) { const f32x4 g = gr[64 * j]; const f32x4 hv = (f32x4){v[q][j].x * rs * g.x, v[q][j].y * rs * g.y, v[q][j].z * rs * g.z, v[q][j].w * rs * g.w};
                u32x2 w; w.x = cvt_pk_bf16(hv.x, hv.y); w.y = cvt_pk_bf16(hv.z, hv.w); o8[64 * j] = w;
#if GATE_FP8
                { int b8 = __builtin_amdgcn_cvt_pk_fp8_f32(hv.x, hv.y, 0, false); b8 = __builtin_amdgcn_cvt_pk_fp8_f32(hv.z, hv.w, b8, true); ((unsigned*)(WSP(unsigned char, WS_H8) + (size_t)mrow * DM))[(F.tid & 63) + 64 * j] = (unsigned)b8; }
#endif
            } }
    }
    if (blockIdx.x == 0 && F.tid < 64) WSP(unsigned, WS_MISC)[GM_KMAX + F.tid] = 0u;
    if (blockIdx.x == 0 && F.tid < 32) WSP(int, WS_MISC)[GM_CUR + F.tid] = 0;
    for (int idx = (F.vcu * NWAVES * 64) + F.tid; idx < NTOK * 16; idx += F.G * NWAVES * 64) {
        const int tok = idx >> 4, j = idx & 15;
        const float inv_freq = powf(10000.0f, -(float)j / 16.0f); const float ang = (float)p.pos[tok] * inv_freq;
        float* cs = WSP(float, WS_CS) + (size_t)tok * 32; cs[j] = cosf(ang); cs[16 + j] = sinf(ang);
    }
}
__device__ __forceinline__ void p2a_rows(const P& p, Frame& F) {
    const int gw = F.vcu * NWAVES + F.wave, l = (F.tid & 63); const int bb = gw >> 8, r0 = bb * SEQ + (gw & 255);
    float kmx = 0.f;
    for (int jb = 0; jb < 16; jb += 4) {
        u32x4 wv[4], kv[4];
#pragma unroll
        for (int q = 0; q < 4; ++q) { const int mrow = r0 + 256 * (jb + q); wv[q] = *((const u32x4*)(WSP(const bf16, WS_QL) + (size_t)mrow * 512) + l); kv[q] = *((const u32x4*)(WSP(const bf16, WS_KF) + (size_t)mrow * 512) + l); }
#pragma unroll
        for (int q = 0; q < 4; ++q) { const int mrow = r0 + 256 * (jb + q); const u32x4 w = wv[q];
            { const u32x4 k = kv[q]; const float k8[8] = {bflo(k.x), bfhi(k.x), bflo(k.y), bfhi(k.y), bflo(k.z), bfhi(k.z), bflo(k.w), bfhi(k.w)}; float ks = 0.f;
#pragma unroll
              for (int i = 0; i < 8; ++i) ks += k8[i] * k8[i];
              ks += __shfl_xor(ks, 1); ks += __shfl_xor(ks, 2); ks += __shfl_xor(ks, 4); kmx = fmaxf(kmx, ks); }
            float v[8] = {bflo(w.x), bfhi(w.x), bflo(w.y), bfhi(w.y), bflo(w.z), bfhi(w.z), bflo(w.w), bfhi(w.w)};
            float s = 0.f;
#pragma unroll
            for (int i = 0; i < 8; ++i) s += v[i] * v[i];
            const float sq = wave_sum(l < 32 ? s : 0.f), sk = wave_sum((l >= 32 && l < 48) ? s : 0.f);
            if (l == 0) { float* rs = WSP(float, WS_SSQ) + (size_t)mrow * 2; rs[0] = 1.f / sqrtf(sq * (1.f / 256) + EPS); rs[1] = 1.f / sqrtf(sk * (1.f / 128) + EPS); }
            float pv[8];
#pragma unroll
            for (int i = 0; i < 8; ++i) pv[i] = __shfl_xor(v[i], 2);
            if (l >= 48 && l < 52) {
                const int jq = 8 * (l - 48); const float* cs = WSP(const float, WS_CS) + (size_t)mrow * 32 + (jq & 15); const float sg = (jq < 16) ? -1.f : 1.f;
                float o[8];
#pragma unroll
                for (int i = 0; i < 8; ++i) o[i] = v[i] * cs[i] + sg * pv[i] * cs[16 + i];
                u32x4 ow; ow.x = cvt_pk_bf16(o[0], o[1]); ow.y = cvt_pk_bf16(o[2], o[3]); ow.z = cvt_pk_bf16(o[4], o[5]); ow.w = cvt_pk_bf16(o[6], o[7]);
                *(u32x4*)(WSP(bf16, WS_KPE) + (size_t)mrow * 32 + jq) = ow;
            }
            if (l == 52) {
                float* lf = WSP(float, WS_LOGF) + (size_t)mrow * 8;
#pragma unroll
                for (int i = 0; i < 8; ++i) { const float z = v[i] + p.b_fgate[i]; lf[i] = fminf(z, 0.f) - log1pf(expf(-fabsf(z))); }
            }
        }
    }
    if ((l & 7) == 0) atomicMax(WSP(unsigned, WS_MISC) + GM_KMAX + bb * 8 + (l >> 3), __float_as_uint(kmx));
}
__device__ __forceinline__ void p2_cumsum(const P& p, Frame& F, int bh) {
    const int b = bh >> 3, h = bh & 7, t = F.tid;
    const float* lf = WSP(const float, WS_LOGF) + ((size_t)b * SEQ + 8 * t) * 8 + h;
    float v[8], tot = 0.f;
#pragma unroll
    for (int i = 0; i < 8; ++i) { v[i] = lf[i * 8]; tot += v[i]; }
    float inc = tot;
#pragma unroll
    for (int o = 1; o < 64; o <<= 1) { const float x = __shfl_up(inc, o); if ((F.tid & 63) >= o) inc += x; }
    LAS float* wt = (LAS float*)(F.lds);
    if ((F.tid & 63) == 63) wt[F.wave] = inc;
    __syncthreads();
    float run = inc - tot;
    for (int w = 0; w < F.wave; ++w) run += wt[w];
    float* kb = WSP(float, WS_KB) + (size_t)bh * SEQ + 8 * t;
#pragma unroll
    for (int i = 0; i < 8; ++i) { run += v[i]; kb[i] = -run * LOG2E; }
    __syncthreads();
}
__device__ __forceinline__ void p6_router(const P& p, Frame& F) {
    LAS bf16x8* WRH = (LAS bf16x8*)F.lds; LAS bf16x8* WRL = WRH + 4096;
    for (int f = F.tid; f < 4096; f += NWAVES * 64) { const int ln = f & 63, nb = (f >> 6) & 1, ks = f >> 7; const float* src = p.w_router + (size_t)(32 * ks + 8 * (ln >> 4)) * 32 + 16 * nb + (ln & 15);
        bf16x8 h, lo;
#pragma unroll
        for (int j = 0; j < 8; ++j) { const float w = src[j * 32]; const unsigned hb = f2bf(w); h[j] = (short)hb; lo[j] = (short)f2bf(w - bf2f((bf16)hb)); }
        WRH[f] = h; WRL[f] = lo; }
    volatile LAS unsigned* hist = F.MISC + 32;
    if (F.tid < 32) hist[F.tid] = 0u;
    __syncthreads();
    const int wg = blockIdx.x, lane = (F.tid & 63), tr = lane & 15, kq = lane >> 4;
    const int tok0 = wg * 128 + F.wave * 16;
    const bf16* xr = WSP(const bf16, WS_X1) + (size_t)(tok0 + tr) * DM + 8 * kq;
    const float* gr = p.g_ffn + 8 * kq;
    f32x4 acc0 = {0.f, 0.f, 0.f, 0.f}, acc1 = {0.f, 0.f, 0.f, 0.f}; float ss = 0.f;
#pragma unroll 4
    for (int ks = 0; ks < 32; ++ks) {
        const u32x4 xw = *(const u32x4*)(xr + 32 * ks); const f32x4 x0 = (f32x4){bflo(xw.x), bfhi(xw.x), bflo(xw.y), bfhi(xw.y)}, x1 = (f32x4){bflo(xw.z), bfhi(xw.z), bflo(xw.w), bfhi(xw.w)}, g0 = *(const f32x4*)(gr + 32 * ks), g1 = *(const f32x4*)(gr + 32 * ks + 4);
        ss += (x0[0] * x0[0] + x0[1] * x0[1]) + (x0[2] * x0[2] + x0[3] * x0[3]) + (x1[0] * x1[0] + x1[1] * x1[1]) + (x1[2] * x1[2] + x1[3] * x1[3]);
        const f32x4 a0 = x0 * g0, a1 = x1 * g1;
        bf16x8 ah, al;
#pragma unroll
        for (int j = 0; j < 4; ++j) { const unsigned h0 = f2bf(a0[j]), h1 = f2bf(a1[j]); ah[j] = (short)h0; ah[4 + j] = (short)h1; al[j] = (short)f2bf(a0[j] - bf2f((bf16)h0)); al[4 + j] = (short)f2bf(a1[j] - bf2f((bf16)h1)); }
        const bf16x8 bh0 = WRH[(ks * 2 + 0) * 64 + lane], bh1 = WRH[(ks * 2 + 1) * 64 + lane], bl0 = WRL[(ks * 2 + 0) * 64 + lane], bl1 = WRL[(ks * 2 + 1) * 64 + lane];
        acc0 = __builtin_amdgcn_mfma_f32_16x16x32_bf16(ah, bh0, acc0, 0, 0, 0); acc1 = __builtin_amdgcn_mfma_f32_16x16x32_bf16(ah, bh1, acc1, 0, 0, 0);
        acc0 = __builtin_amdgcn_mfma_f32_16x16x32_bf16(al, bh0, acc0, 0, 0, 0); acc1 = __builtin_amdgcn_mfma_f32_16x16x32_bf16(al, bh1, acc1, 0, 0, 0);
        acc0 = __builtin_amdgcn_mfma_f32_16x16x32_bf16(ah, bl0, acc0, 0, 0, 0); acc1 = __builtin_amdgcn_mfma_f32_16x16x32_bf16(ah, bl1, acc1, 0, 0, 0);
    }
    ss += __shfl_xor(ss, 16); ss += __shfl_xor(ss, 32);
    const float rs = 1.f / sqrtf(ss * (1.f / DM) + EPS);
    LAS float* LG = (LAS float*)(F.lds + ROWTAB_OFF) + F.wave * 544;
#pragma unroll
    for (int r = 0; r < 4; ++r) { LG[(4 * kq + r) * 32 + tr] = acc0[r]; LG[(4 * kq + r) * 32 + 16 + tr] = acc1[r]; }
    if (kq == 0) LG[512 + tr] = rs;
    LDS_WAIT(); asm volatile("" ::: "memory");
    int idx[4] = {0, 0, 0, 0}, rnk[4] = {0, 0, 0, 0}; float wgt[4] = {0.f, 0.f, 0.f, 0.f};
    if (lane < 16) {
        const float rst = LG[512 + lane]; float lg[32];
#pragma unroll
        for (int c = 0; c < 8; ++c) { const f32x4 v = *(const LAS f32x4*)(LG + lane * 32 + 4 * c); const f32x4 b = *(const f32x4*)(p.b_router + 4 * c);
            lg[4 * c] = v[0] * rst + b[0]; lg[4 * c + 1] = v[1] * rst + b[1]; lg[4 * c + 2] = v[2] * rst + b[2]; lg[4 * c + 3] = v[3] * rst + b[3]; }
        float val[4];
#pragma unroll
        for (int k = 0; k < 4; ++k) { float bv = -INFINITY; int bi = 0;
#pragma unroll
            for (int e = 0; e < 32; ++e) { const bool tk = lg[e] > bv; bv = tk ? lg[e] : bv; bi = tk ? e : bi; }
            idx[k] = bi; val[k] = bv;
#pragma unroll
            for (int e = 0; e < 32; ++e) lg[e] = (e == bi) ? -INFINITY : lg[e]; }
        float ex[4], sum = 0.f;
#pragma unroll
        for (int k = 0; k < 4; ++k) { ex[k] = expf(val[k] - val[0]); sum += ex[k]; }
        const float inv = 1.f / sum; const int tok = tok0 + lane;
        *(u32x4*)(WSP(int, WS_TOPI) + tok * 4) = (u32x4){(unsigned)idx[0], (unsigned)idx[1], (unsigned)idx[2], (unsigned)idx[3]};
        *(f32x4*)(WSP(float, WS_TOPW) + tok * 4) = (f32x4){ex[0] * inv, ex[1] * inv, ex[2] * inv, ex[3] * inv};
#pragma unroll
        for (int k = 0; k < 4; ++k) { rnk[k] = (int)__hip_atomic_fetch_add((LAS unsigned*)(F.lds + MISC_OFF) + 32 + idx[k], 1u, __ATOMIC_RELAXED, __HIP_MEMORY_SCOPE_WORKGROUP); wgt[k] = ex[k] * inv; }
    }
#if MOE_FP8
    unsigned char* H2 = WSP(unsigned char, WS_H2) + (size_t)(tok0 + tr) * DM + 8 * kq;
#else
    bf16* H2 = WSP(bf16, WS_H2) + (size_t)(tok0 + tr) * DM + 8 * kq;
#endif
#pragma unroll 4
    for (int ks = 0; ks < 32; ++ks) {
        const u32x4 xw = *(const u32x4*)(xr + 32 * ks); const f32x4 x0 = (f32x4){bflo(xw.x), bfhi(xw.x), bflo(xw.y), bfhi(xw.y)}, x1 = (f32x4){bflo(xw.z), bfhi(xw.z), bflo(xw.w), bfhi(xw.w)}, g0 = *(const f32x4*)(gr + 32 * ks), g1 = *(const f32x4*)(gr + 32 * ks + 4);
#if MOE_FP8
        *(u32x2*)(H2 + 32 * ks) = pack8_fp8(x0 * g0 * rs, x1 * g1 * rs); }
#else
        *(u32x4*)(H2 + 32 * ks) = pack8(x0 * g0 * rs, x1 * g1 * rs); }
#endif
    __syncthreads();
#if FUSED_ROWS
    volatile LAS int* gbase = (volatile LAS int*)(F.MISC + 64);
    if (F.tid < 32) gbase[F.tid] = atomicAdd(WSP(int, WS_MISC) + GM_CUR + F.tid, (int)hist[F.tid]);
    __syncthreads();
    if (lane < 16) { const int tok = tok0 + lane;
#pragma unroll
        for (int k = 0; k < 4; ++k) { const size_t pos = (size_t)idx[k] * ESTR + gbase[idx[k]] + rnk[k];
            WSP(int, WS_EROWTOK)[pos] = tok; WSP(int, WS_EROWSLOT)[pos] = tok * 4 + k; WSP(float, WS_EROWW)[pos] = wgt[k]; } }
#else
    if (F.tid < 32) WSP(int, WS_MISC)[GM_CNT + wg * 32 + F.tid] = (int)hist[F.tid];
#endif
    __syncthreads();
}
__device__ __forceinline__ void p7_rows(const P& p, Frame& F) {
    const int wg = blockIdx.x, tid = F.tid;
    LAS int* part = (LAS int*)F.lds;
    LAS int* tot = part + 512; LAS int* pre = tot + 32; LAS int* pstart = pre + 32; LAS int* base = pstart + 33; LAS unsigned* lcnt = (LAS unsigned*)(base + 32);
    const int* cnt = WSP(const int, WS_MISC) + GM_CNT;
    { const int e = tid & 31, j = tid >> 5; int s = 0;
#pragma unroll
      for (int w = 0; w < 16; ++w) s += cnt[(j * 16 + w) * 32 + e];
      part[j * 32 + e] = s; }
    __syncthreads();
    if (tid < 32) { int t = 0, pr = 0;
        for (int j = 0; j < 16; ++j) { if (j < (wg >> 4)) pr += part[j * 32 + tid]; t += part[j * 32 + tid]; }
        for (int w = (wg & ~15); w < wg; ++w) pr += cnt[w * 32 + tid];
        tot[tid] = t; pre[tid] = pr; lcnt[tid] = 0u; }
    __syncthreads();
    if (tid == 0) { int s = 0; for (int e = 0; e < 32; ++e) { pstart[e] = s; s += ((tot[e] + 255) >> 8) << 8; } pstart[32] = s; }
    __syncthreads();
    if (tid < 32) base[tid] = pstart[tid] + pre[tid];
    __syncthreads();
    { const int a = wg * 512 + tid; const int e = WSP(const int, WS_TOPI)[a]; const float w = WSP(const float, WS_TOPW)[a];
      const int pos = base[e] + (int)__hip_atomic_fetch_add(lcnt + e, 1u, __ATOMIC_RELAXED, __HIP_MEMORY_SCOPE_WORKGROUP);
      WSP(int, WS_ROWTOK)[pos] = a >> 2; WSP(int, WS_ROWSLOT)[pos] = a; WSP(float, WS_ROWW)[pos] = w; }
    if (wg < 32) { const int e = wg; const int s0 = pstart[e] + tot[e], s1 = pstart[e + 1];
        for (int r = s0 + tid; r < s1; r += NWAVES * 64) { WSP(int, WS_ROWTOK)[r] = 0; WSP(int, WS_ROWSLOT)[r] = NTOK * 4; WSP(float, WS_ROWW)[r] = 0.f; } }
    if (wg == 0) {
        if (tid == 0) WSP(int, WS_MISC)[GM_NBLK] = pstart[32] >> 8;
        if (tid < 32) { for (int bk = pstart[tid] >> 8; bk < (pstart[tid + 1] >> 8); ++bk) WSP(int, WS_MISC)[GM_BLKE + bk] = tid; }
    }
    __syncthreads();
}
__device__ __forceinline__ void moe_setup(const P& p, Frame& F, pg8::MoeOrder& S, int shift, int gc_log2, bool gather) {
    LAS int* blke = (LAS int*)(F.lds + BLKE_OFF); LAS int* rowtab = (LAS int*)(F.lds + ROWTAB_OFF);
#if FUSED_ROWS
    volatile LAS int* cntL = (volatile LAS int*)(F.MISC + 32); volatile LAS int* bst = (volatile LAS int*)(F.MISC + 64);
    if (F.tid < 64) {
        const int l = F.tid, c = (l < 32) ? WSP(const int, WS_MISC)[GM_CUR + l] : 0, nb = (c + 255) >> 8;
        int inc = nb;
#pragma unroll
        for (int d = 1; d < 32; d <<= 1) { const int o = __shfl_up(inc, d); if (l >= d) inc += o; }
        if (l < 32) { cntL[l] = c; bst[l] = inc - nb; }
        if (l == 31) bst[32] = inc;
    }
    __syncthreads();
    const int nblk = bst[32];
    for (int i = F.tid; i < MAXBLK; i += NWAVES * 64) { int e = 0;
#pragma unroll
        for (int st = 16; st >= 1; st >>= 1) { if (bst[e + st] <= i) e += st; }
        blke[i] = (i < nblk) ? e : 0; }
    __syncthreads();
    S.init(nblk, F.G, (int)blockIdx.x, shift, gc_log2, (const LAS int*)blke);
    if (gather) {
        for (int i = 0; i < ROWTAB_UNITS; ++i) { const int rb = S.rb_of(i); if (rb >= nblk) break;
            if (F.tid < 256) { const int e = blke[rb], pos = ((rb - bst[e]) << 8) + F.tid; rowtab[i * 256 + F.tid] = (pos < cntL[e]) ? WSP(const int, WS_EROWTOK)[(size_t)e * ESTR + pos] : 0; } }
        if (blockIdx.x < 32) { const int e = (int)blockIdx.x, c0_ = cntL[e], c1_ = ((c0_ + 255) >> 8) << 8;
            for (int q = c0_ + F.tid; q < c1_; q += NWAVES * 64) { WSP(int, WS_EROWSLOT)[(size_t)e * ESTR + q] = NTOK * 4; WSP(float, WS_EROWW)[(size_t)e * ESTR + q] = 0.f; } }
    }
#else
    const int nblk = WSP(const int, WS_MISC)[GM_NBLK];
    for (int i = F.tid; i < MAXBLK; i += NWAVES * 64) blke[i] = (i < nblk) ? WSP(const int, WS_MISC)[GM_BLKE + i] : 0;
    S.init(nblk, F.G, (int)blockIdx.x, shift, gc_log2, (const LAS int*)blke);
    if (gather) {
        for (int i = 0; i < ROWTAB_UNITS; ++i) { const int rb = S.rb_of(i); if (rb >= nblk) break;
            if (F.tid < 256) rowtab[i * 256 + F.tid] = WSP(const int, WS_ROWTOK)[rb * 256 + F.tid]; }
    }
#endif
    __syncthreads();
}
__device__ __forceinline__ void p10_final(const P& p, Frame& F) {
    const int gw = F.vcu * NWAVES + F.wave, NGW = F.G * NWAVES, lane = F.tid & 63;
#if Z_FP8
    typedef float f32x2 __attribute__((ext_vector_type(2)));
    for (int m0 = gw; m0 < NTOK; m0 += 2 * NGW) {
        f32x4 v[2][4]; unsigned z[2][4][4];
#pragma unroll
        for (int q = 0; q < 2; ++q) { const int mrow = (m0 + q * NGW < NTOK) ? m0 + q * NGW : m0;
            const u32x2* xr = (const u32x2*)(WSP(const bf16, WS_X1) + (size_t)mrow * DM) + lane;
#pragma unroll
            for (int j = 0; j < 4; ++j) { const u32x2 xw = xr[64 * j]; v[q][j] = (f32x4){bflo(xw.x), bfhi(xw.x), bflo(xw.y), bfhi(xw.y)};
#pragma unroll
                for (int k = 0; k < 4; ++k) z[q][j][k] = *((const unsigned*)(WSP(const unsigned char, WS_Z) + ((size_t)mrow * 4 + k) * 1024) + lane + 64 * j); } }
#pragma unroll
        for (int q = 0; q < 2; ++q) { const int mrow = m0 + q * NGW; if (mrow >= NTOK) break;
            float s = 0.f;
#pragma unroll
            for (int j = 0; j < 4; ++j) { f32x4 a = {0.f, 0.f, 0.f, 0.f};
#pragma unroll
                for (int k = 0; k < 4; ++k) { const f32x2 lo = __builtin_amdgcn_cvt_pk_f32_fp8((int)z[q][j][k], false), hi = __builtin_amdgcn_cvt_pk_f32_fp8((int)z[q][j][k], true); a.x += lo.x; a.y += lo.y; a.z += hi.x; a.w += hi.y; }
                v[q][j] = v[q][j] + a * 0.0625f;
                s += (v[q][j].x * v[q][j].x + v[q][j].y * v[q][j].y) + (v[q][j].z * v[q][j].z + v[q][j].w * v[q][j].w); }
            const float rs = 1.f / sqrtf(wave_sum(s) * (1.f / DM) + EPS);
            f32x4* xo = (f32x4*)(p.out + (size_t)mrow * DM) + lane; const f32x4* gr = (const f32x4*)p.g_final + lane;
#pragma unroll
            for (int j = 0; j < 4; ++j) { const f32x4 g = gr[64 * j]; xo[64 * j] = (f32x4){v[q][j].x * rs * g.x, v[q][j].y * rs * g.y, v[q][j].z * rs * g.z, v[q][j].w * rs * g.w}; }
        }
    }
#else
    for (int m0 = gw; m0 < NTOK; m0 += 2 * NGW) {
        f32x4 v[2][4]; u32x2 z[2][4][4];
#pragma unroll
        for (int q = 0; q < 2; ++q) { const int mrow = (m0 + q * NGW < NTOK) ? m0 + q * NGW : m0;
            const u32x2* xr = (const u32x2*)(WSP(const bf16, WS_X1) + (size_t)mrow * DM) + lane;
#pragma unroll
            for (int j = 0; j < 4; ++j) { const u32x2 xw = xr[64 * j]; v[q][j] = (f32x4){bflo(xw.x), bfhi(xw.x), bflo(xw.y), bfhi(xw.y)};
#pragma unroll
                for (int k = 0; k < 4; ++k) z[q][j][k] = *((const u32x2*)(WSP(const bf16, WS_Z) + ((size_t)mrow * 4 + k) * 1024) + lane + 64 * j); } }
#pragma unroll
        for (int q = 0; q < 2; ++q) { const int mrow = m0 + q * NGW; if (mrow >= NTOK) break;
            float s = 0.f;
#pragma unroll
            for (int j = 0; j < 4; ++j) {
#pragma unroll
                for (int k = 0; k < 4; ++k) { v[q][j].x += bflo(z[q][j][k].x); v[q][j].y += bfhi(z[q][j][k].x); v[q][j].z += bflo(z[q][j][k].y); v[q][j].w += bfhi(z[q][j][k].y); }
                s += (v[q][j].x * v[q][j].x + v[q][j].y * v[q][j].y) + (v[q][j].z * v[q][j].z + v[q][j].w * v[q][j].w); }
            const float rs = 1.f / sqrtf(wave_sum(s) * (1.f / DM) + EPS);
            f32x4* xo = (f32x4*)(p.out + (size_t)mrow * DM) + lane; const f32x4* gr = (const f32x4*)p.g_final + lane;
#pragma unroll
            for (int j = 0; j < 4; ++j) { const f32x4 g = gr[64 * j]; xo[64 * j] = (f32x4){v[q][j].x * rs * g.x, v[q][j].y * rs * g.y, v[q][j].z * rs * g.z, v[q][j].w * rs * g.w}; }
        }
    }
#endif
}

constexpr int NPHASE = 12;
struct Args { P p; int ph_lo, ph_hi; };
__global__ void __launch_bounds__(NWAVES * 64, 2) mk_fwd(Args args) {
    extern __shared__ __attribute__((aligned(16))) unsigned char lds_raw[];
    const P& p = args.p;
    Frame F;
    F.lds = (LAS unsigned char*)lds_raw; F.MISC = (volatile LAS unsigned*)(F.lds + MISC_OFF);
    F.tid = threadIdx.x; F.wave = __builtin_amdgcn_readfirstlane(F.tid >> 6);
    F.G = gridDim.x; { const int bx = blockIdx.x; F.vcu = (F.G % 8 == 0) ? (bx % 8) * (F.G / 8) + bx / 8 : bx; }
    for (int u = F.tid; u < 256; u += NWAVES * 64) F.MISC[u] = 0u;
    __syncthreads();
    const int lo = args.ph_lo, hi = args.ph_hi;
    const bool one = (hi - lo) > 1;
    XcdBarrier bar; bar.bar = (unsigned*)(p.ws + WS_CTL) + 4096; bar.x = 0; bar.st = nullptr;
    if (one) bar = xcd_barrier_post((unsigned*)(p.ws + WS_CTL) + 4096, F.MISC + 8);
#ifndef PH_MASK
#define PH_MASK 0xfff
#endif
#define IN(k) (((PH_MASK >> (k)) & 1) && lo <= (k) && (k) < hi)
#define SEAM(k) do { if (IN(k) && IN((k) + 1)) xcd_barrier(bar); } while (0)
    using namespace pg8;
    const int bx = (int)blockIdx.x;
    if (IN(0)) { p0_prologue(p, F); } SEAM(0);
    if (IN(1)) {
#if GATE_FP8
        { Gemm g{WSP(const bf16, WS_H), WSP(const bf16, WS_WIN), 1024, 1024}; StaticOrder S; S.init(NTOK, 2048, F.G, bx);
          EpiInproj<false> E{p.ws};
          gemm_phase<EpiInproj<false>, StaticOrder, true, false>(F.lds, g, S, E, nullptr); }
        { Gemm g{WSP(const bf16, WS_H8), WSP(const bf16, WS_WIN8), 1024, 1024}; StaticOrder S; S.init(NTOK, 2048, F.G, bx);
          EpiInproj<true> E{p.ws};
          gemm_phase8<EpiInproj<true>, StaticOrder, true, false>(F.lds, g, S, E, nullptr); }
#else
        Gemm g{WSP(const bf16, WS_H), WSP(const bf16, WS_WIN), 1024, 1024}; StaticOrder S; S.init(NTOK, 4096, F.G, bx);
        EpiInproj<false> E{p.ws};
        gemm_phase<EpiInproj<false>, StaticOrder, true, false>(F.lds, g, S, E, nullptr);
#endif
    } SEAM(1);
    if (IN(2)) { p2a_rows(p, F); } SEAM(2);
    if (IN(3)) {
        if (F.vcu < 64) p2_cumsum(p, F, F.vcu);
        { Gemm g{WSP(const bf16, WS_QL), WSP(const bf16, WS_WQ), 256, 512}; StaticOrder S; S.init(NTOK, 768, F.G, (F.G == 256) ? (((bx & 7) + 6) & 7) * 32 + (bx >> 3) : bx);
          EpiQup E{WSP(bf16, WS_QM), WSP(const float, WS_SSQ), WSP(const float, WS_CS)};
          gemm_phase<EpiQup, StaticOrder, true, false>(F.lds, g, S, E, nullptr); }
        { Gemm g{WSP(const bf16, WS_QL) + 256, WSP(const bf16, WS_WKV), 256, 512}; StaticOrder S; S.init(NTOK, 1024, F.G, bx);
          EpiKvup E{WSP(bf16, WS_KN), WSP(const float, WS_SSQ)};
          gemm_phase<EpiKvup, StaticOrder, true, false>(F.lds, g, S, E, nullptr); }
    } SEAM(3);
    if (IN(4)) {
        BgConv cv; cv.init(p, F.lds + ROWTAB_OFF + F.wave * 2304, F.lds + att::BG_STAGE_OFF + F.wave * 4096, W_SMALL + F.vcu * NWAVES + F.wave, F.G * NWAVES);
        for (int j = F.vcu; j < 2048; j += F.G) {
            const int br = j >> 10, jj = j & 1023, r = jj >> 8, bh = (jj & 255) >> 2, s = jj & 3;
            const int qb = (r == 0) ? s : (r == 1) ? 7 - s : (r == 2) ? 8 + s : 15 - s;
            if (br == 0) att::attn_unit<64, true>(cv, F.lds, bh >> 3, bh & 7, qb, WSP(const bf16, WS_QF), WSP(const bf16, WS_KF), WSP(const bf16, WS_KPE), WSP(const bf16, WS_VF), WSP(const float, WS_KB), WSP(bf16, WS_YF), __uint_as_float(WSP(const unsigned, WS_MISC)[GM_KMAX + bh]));
            else att::attn_unit<96, false>(cv, F.lds, bh >> 3, bh & 7, qb, WSP(const bf16, WS_QM), WSP(const bf16, WS_KN), WSP(const bf16, WS_KPE), WSP(const bf16, WS_VM), WSP(const float, WS_KB), WSP(bf16, WS_YM), 0.f);
        }
        VM_WAIT(); cv.consume(F.tid & 63);
        while (cv.active) { cv.issue(F.tid & 63); VM_WAIT(); cv.consume(F.tid & 63); }
    } SEAM(4);
    if (IN(5)) {
        { Gemm g{WSP(const bf16, WS_YF), WSP(const bf16, WS_WF), 512, 512}; StaticOrder S; S.init(NTOK, 1024, F.G, bx);
          EpiMerge<0> E{WSP(bf16, WS_T0), WSP(bf16, WS_MG), WSP(const bf16, WS_G), p.b_merge};
          gemm_phase<EpiMerge<0>, StaticOrder, true, false>(F.lds, g, S, E, nullptr); }
        { Gemm g{WSP(const bf16, WS_YM), WSP(const bf16, WS_WM), 512, 512}; StaticOrder S; S.init(NTOK, 1024, F.G, bx);
          EpiMerge<1> E{WSP(bf16, WS_T0), WSP(bf16, WS_MG), WSP(const bf16, WS_G), p.b_merge};
          gemm_phase<EpiMerge<1>, StaticOrder, true, false>(F.lds, g, S, E, nullptr); }
    } SEAM(5);
    if (IN(6)) {
        StaticOrder S; S.init(NTOK, 1024, F.G, bx);
        EpiWo E{p.x, WSP(bf16, WS_X1)};
#if WO_FP8
        Gemm g{WSP(const bf16, WS_MG), WSP(const bf16, WS_WO), 1024, 1024, 0x7B7B7B7B};
        gemm_phase8<EpiWo, StaticOrder, true, false>(F.lds, g, S, E, nullptr);
#else
        Gemm g{WSP(const bf16, WS_MG), WSP(const bf16, WS_WO), 1024, 1024};
        gemm_phase<EpiWo, StaticOrder, true, false>(F.lds, g, S, E, nullptr);
#endif
    } SEAM(6);
    if (IN(7)) { p6_router(p, F); } SEAM(7);
#if !FUSED_ROWS
    if (IN(8)) { p7_rows(p, F); } SEAM(8);
#endif
    if (IN(9)) {
        MoeOrder S; moe_setup(p, F, S, 3, 1, true);
        Gemm g{WSP(const bf16, WS_H2), WSP(const bf16, WS_WGU), 1024, 1024};
        EpiSwiglu<MOE_FP8 != 0> E{WSP(bf16, WS_ACT), p.b_gu};
#if MOE_FP8
        gemm_phase8<EpiSwiglu<true>, MoeOrder, false, true>(F.lds, g, S, E, (const LAS int*)(F.lds + ROWTAB_OFF));
#else
        gemm_phase<EpiSwiglu<false>, MoeOrder, false, true>(F.lds, g, S, E, (const LAS int*)(F.lds + ROWTAB_OFF));
#endif
    } SEAM(9);
    if (IN(10)) {
        MoeOrder S; moe_setup(p, F, S, 2, 0, false);
        Gemm g{WSP(const bf16, WS_ACT), WSP(const bf16, WS_WD), 1024, 1024};
#if FUSED_ROWS
        EpiDown<MOE_FP8 != 0> E{WSP(bf16, WS_Z), p.b_down, WSP(const int, WS_EROWSLOT), WSP(const float, WS_EROWW), (const volatile LAS int*)(F.MISC + 32), (const volatile LAS int*)(F.MISC + 64)};
#else
        EpiDown<MOE_FP8 != 0> E{WSP(bf16, WS_Z), p.b_down, WSP(const int, WS_ROWSLOT), WSP(const float, WS_ROWW), nullptr, nullptr};
#endif
#if MOE_FP8
        gemm_phase8<EpiDown<true>, MoeOrder, true, false>(F.lds, g, S, E, nullptr);
#else
        gemm_phase<EpiDown<false>, MoeOrder, true, false>(F.lds, g, S, E, nullptr);
#endif
    } SEAM(10);
    if (IN(11)) { p10_final(p, F); }
#undef IN
#undef SEAM
}

extern "C" void kernel_launch(void* const* d_in, const int* in_sizes, int n_in, void* d_out, int out_size, void* d_ws, size_t ws_size, hipStream_t stream) {
    static int grid = 0;
    if (grid == 0) {
        if (n_in != 21 || out_size != NTOK * DM || ws_size < WS_END) { fprintf(stderr, "kernel_launch: unexpected sizes n_in %d out %d ws %zu\n", n_in, out_size, ws_size); grid = -1; return; }
        int dev = 0, cus = 0, per_cu = 0;
        if (hipGetDevice(&dev) != hipSuccess || hipDeviceGetAttribute(&cus, hipDeviceAttributeMultiprocessorCount, dev) != hipSuccess) { grid = -1; return; }
        if (hipFuncSetAttribute((const void*)mk_fwd, hipFuncAttributeMaxDynamicSharedMemorySize, LDS_BYTES) != hipSuccess) { fprintf(stderr, "kernel_launch: hipFuncSetAttribute failed\n"); grid = -1; return; }
        if (hipOccupancyMaxActiveBlocksPerMultiprocessor(&per_cu, (const void*)mk_fwd, NWAVES * 64, LDS_BYTES) != hipSuccess || per_cu < 1) { fprintf(stderr, "kernel_launch: occupancy query says %d\n", per_cu); }
        (void)hipGetLastError();
        if (cus != 256) { fprintf(stderr, "kernel_launch: built for 256 CUs, found %d\n", cus); grid = -1; return; }
        grid = 256;
    }
    if (grid < 0) return;
    P p{};
    p.x = (const float*)d_in[0]; p.pos = (const int*)d_in[1]; p.g_attn = (const float*)d_in[2]; p.w_in = (const float*)d_in[3]; p.b_fgate = (const float*)d_in[4];
    p.g_q_a = (const float*)d_in[5]; p.w_q_b = (const float*)d_in[6]; p.g_kv_a = (const float*)d_in[7]; p.w_kv_b = (const float*)d_in[8];
    p.w_fox = (const float*)d_in[9]; p.w_mla = (const float*)d_in[10]; p.b_merge = (const float*)d_in[11]; p.w_o = (const float*)d_in[12];
    p.g_ffn = (const float*)d_in[13]; p.w_router = (const float*)d_in[14]; p.b_router = (const float*)d_in[15];
    p.w_gu = (const float*)d_in[16]; p.b_gu = (const float*)d_in[17]; p.w_down = (const float*)d_in[18]; p.b_down = (const float*)d_in[19]; p.g_final = (const float*)d_in[20];
    p.out = (float*)d_out; p.ws = (unsigned char*)d_ws;
    (void)hipMemsetAsync((char*)d_ws + WS_CTL, 0, 64 * 1024, stream);
    Args a{}; a.p = p;
    a.ph_lo = 0; a.ph_hi = NPHASE;
    hipLaunchKernelGGL(mk_fwd, dim3(grid), dim3(NWAVES * 64), LDS_BYTES, stream, a);
}
```

```cpp
#include <hip/hip_runtime.h>
#include <cstdio>
#include <cstdint>

constexpr int DM = 1024, BATCH = 8, SEQ = 4096, NTOK = BATCH * SEQ;
constexpr int NE = 32, TOPK = 4, FF = 1024;
constexpr int IN_COLS = 4008;
constexpr int C_QF = 0, C_KF = 512, C_VF = 1024, C_FL = 1536, C_QL = 1544, C_KV = 1800, C_KPE = 1928, C_G = 1960;
constexpr float EPS = 1e-6f;
constexpr size_t SSQ2 = (size_t)NTOK * 4;
constexpr float LOG2E = 1.4426950408889634f;
constexpr float C2F = 0.125f * LOG2E;
constexpr float C2M = 0.10206207261596577f * LOG2E;

typedef unsigned short bf16;
__device__ __forceinline__ unsigned f2bf(float f) { unsigned u = __builtin_bit_cast(unsigned, f); return (u + 0x7fffu + ((u >> 16) & 1u)) >> 16; }
__device__ __forceinline__ float bf2f(bf16 b) { return __builtin_bit_cast(float, (unsigned)b << 16); }

constexpr size_t MiB = 1u << 20;
constexpr size_t WS_CTL = 0;
constexpr size_t WS_WIN = 2 * MiB, WS_WQ = 10 * MiB, WS_WKV = 10 * MiB + 512 * 1024, WS_WF = 11 * MiB, WS_WM = 12 * MiB, WS_WO = 13 * MiB;
constexpr size_t WS_WGU = 16 * MiB, WS_WD = 144 * MiB;
constexpr size_t WS_SSQ = 208 * MiB, WS_KPE = 209 * MiB, WS_LOGF = 211 * MiB, WS_CS = 212 * MiB, WS_KB = 216 * MiB, WS_TOPI = 217 * MiB, WS_TOPW = 217 * MiB + 512 * 1024;
constexpr size_t WS_ROWTOK = 218 * MiB, WS_ROWSLOT = 219 * MiB, WS_ROWW = 220 * MiB, WS_MISC = 221 * MiB;
constexpr size_t WS_T0 = 224 * MiB, WS_H2 = 224 * MiB, WS_MG = 288 * MiB;
constexpr size_t WS_A = 352 * MiB, WS_H = 352 * MiB, WS_QF = 416 * MiB, WS_KF = 448 * MiB, WS_VF = 480 * MiB, WS_QL = 512 * MiB, WS_QM = 544 * MiB, WS_ACT = 480 * MiB, WS_X1 = 352 * MiB;
constexpr size_t WS_B = 624 * MiB, WS_G = 624 * MiB, WS_KN = 752 * MiB, WS_VM = 784 * MiB, WS_YF = 816 * MiB, WS_YM = 848 * MiB, WS_Z = 624 * MiB;
constexpr size_t WS_H8 = 288 * MiB;
constexpr size_t WS_WIN8 = 2 * MiB + 4 * MiB;
constexpr size_t WS_END = 896 * MiB;

struct P {
    const float* x; const int* pos; const float* g_attn; const float* w_in; const float* b_fgate; const float* g_q_a; const float* w_q_b; const float* g_kv_a; const float* w_kv_b;
    const float* w_fox; const float* w_mla; const float* b_merge; const float* w_o; const float* g_ffn; const float* w_router; const float* b_router;
    const float* w_gu; const float* b_gu; const float* w_down; const float* b_down; const float* g_final;
    float* out; unsigned char* ws;
};
#define WSP(T, off) ((T*)(p.ws + (off)))

__device__ __forceinline__ float wave_sum(float v) {
#pragma unroll
    for (int o = 1; o < 64; o <<= 1) v += __shfl_xor(v, o);
    return v;
}

#ifndef GATE_FP8
#define GATE_FP8 1
#endif
#ifndef Z_FP8
#define G_FP8 1
#define WO_FP8 1
#define FUSED_ROWS 1
#define Z_FP8 1
#endif
#ifndef MOE_FP8
#define MOE_FP8 1
#endif
#define GAS __attribute__((address_space(1)))
#define LAS __attribute__((address_space(3)))
typedef unsigned u32x4 __attribute__((ext_vector_type(4)));
typedef unsigned u32x2 __attribute__((ext_vector_type(2)));
typedef float f32x4 __attribute__((ext_vector_type(4)));
typedef float f32x16 __attribute__((ext_vector_type(16)));
typedef short bf16x8 __attribute__((ext_vector_type(8)));
typedef short s16x4 __attribute__((ext_vector_type(4)));
typedef int v8i32 __attribute__((ext_vector_type(8)));
typedef int v4i32 __attribute__((ext_vector_type(4)));
typedef GAS unsigned gu32;
#define RLX_AGENT __ATOMIC_RELAXED, __HIP_MEMORY_SCOPE_AGENT
#define LDS_WAIT() asm volatile("s_waitcnt lgkmcnt(0)" ::: "memory")
#define VM_WAIT() asm volatile("s_waitcnt vmcnt(0)" ::: "memory")
__device__ __forceinline__ unsigned cvt_pk_bf16(float lo, float hi) { unsigned r; asm volatile("v_cvt_pk_bf16_f32 %0, %1, %2" : "=v"(r) : "v"(lo), "v"(hi)); return r; }
__device__ __forceinline__ u32x4 pack8(f32x4 a, f32x4 b) { u32x4 w; w.x = cvt_pk_bf16(a[0], a[1]); w.y = cvt_pk_bf16(a[2], a[3]); w.z = cvt_pk_bf16(b[0], b[1]); w.w = cvt_pk_bf16(b[2], b[3]); return w; }
__device__ __forceinline__ u32x2 pack8_fp8(f32x4 a, f32x4 b) { int w0 = __builtin_amdgcn_cvt_pk_fp8_f32(a[0], a[1], 0, false); w0 = __builtin_amdgcn_cvt_pk_fp8_f32(a[2], a[3], w0, true);
    int w1 = __builtin_amdgcn_cvt_pk_fp8_f32(b[0], b[1], 0, false); w1 = __builtin_amdgcn_cvt_pk_fp8_f32(b[2], b[3], w1, true); return (u32x2){(unsigned)w0, (unsigned)w1}; }
__device__ __forceinline__ float bflo(unsigned w) { return __builtin_bit_cast(float, w << 16); }
__device__ __forceinline__ float bfhi(unsigned w) { return __builtin_bit_cast(float, w & 0xffff0000u); }
typedef float f32x2 __attribute__((ext_vector_type(2)));
__device__ __forceinline__ f32x2 fsigmoid2(f32x2 z) { const f32x2 t = z * (-LOG2E); f32x2 e; e.x = __builtin_amdgcn_exp2f(t.x); e.y = __builtin_amdgcn_exp2f(t.y); const f32x2 d = e + 1.f; f32x2 r; r.x = __builtin_amdgcn_rcpf(d.x); r.y = __builtin_amdgcn_rcpf(d.y); return r; }
__device__ __forceinline__ unsigned lane_xor1(unsigned v) { return (unsigned)__builtin_amdgcn_mov_dpp((int)v, 0xB1, 0xF, 0xF, true); }
__device__ __forceinline__ float fsigmoid(float z) { return __builtin_amdgcn_rcpf(1.f + __builtin_amdgcn_exp2f(-z * LOG2E)); }

constexpr int RING_BYTES = 131072;
constexpr int MISC_OFF = RING_BYTES;
constexpr int BLKE_OFF = MISC_OFF + 1024;
constexpr int ROWTAB_OFF = BLKE_OFF + 2304;
constexpr int ROWTAB_UNITS = 18;
constexpr int LDS_BYTES = ROWTAB_OFF + ROWTAB_UNITS * 1024;
static_assert(LDS_BYTES <= 160 * 1024, "LDS");
static_assert(WS_VF - WS_KF == WS_KF - WS_QF, "QF/KF/VF equally spaced");
constexpr int NWAVES = 8;
constexpr int MAXBLK = 544;
constexpr int GM_NBLK = 0, GM_BLKE = 64, GM_CNT = 1024, GM_KMAX = 40000;
constexpr int GM_CUR = GM_CNT;
constexpr int ESTR = NTOK + 256;
constexpr size_t WS_EROWTOK = 80 * MiB, WS_EROWSLOT = 85 * MiB, WS_EROWW = 90 * MiB;

namespace pg8 {
#define PG8_LAS __attribute__((address_space(3)))
typedef unsigned short bf16_t;
constexpr int BM = 256, BK = 64, HALF = 128, HTB = HALF * BK * 2, STAGE_BYTES = 8 * HTB, NXCD = 8, WGM = 8;
__host__ __device__ __forceinline__ int lds_byte(int r, int c) { const int st = (r >> 4) * 2 + (c >> 5), rr = r & 15, cc = c & 31, ob = rr * 64 + cc * 2; return st * 1024 + (ob ^ (((ob >> 9) & 1) << 5)); }
__host__ __device__ __forceinline__ void stage_rc(int b, int& R, int& C) { const int st = b / 1024, sb = b % 1024, swz = sb ^ (((sb >> 9) & 1) << 5); R = (st >> 1) * 16 + swz / 64; C = (st & 1) * 32 + (swz % 64) / 2; }
__host__ __device__ __forceinline__ int perm32(int rho) { const int n = rho >> 4, i = rho & 15; return 8 * (i >> 2) + 4 * n + (i & 3); }

struct Unit { int pm, pn, bt, e; };
struct Gemm { const bf16_t* A; const bf16_t* Bt; int K, lda; int ascale = 0x7F7F7F7F; };

struct StaticOrder {
    int nM, nN, nwg, G, c;
    __device__ void init(int M, int N, int G_, int c_) { nM = M / BM; nN = N / BM; nwg = nM * nN; G = G_; c = c_; }
    __device__ bool next(int i, Unit& u) const {
        const long L = (long)i * G + c; if (L >= nwg) return false;
        int wgid = (int)L; { const int q = nwg / NXCD, r = nwg % NXCD, xcd = wgid % NXCD, off = wgid / NXCD; wgid = (xcd < r ? xcd * (q + 1) : r * (q + 1) + (xcd - r) * q) + off; }
        const int nig = WGM * nN, gid = wgid / nig, fm = gid * WGM, gsz = (nM - fm) < WGM ? (nM - fm) : WGM;
        u.pm = fm + ((wgid % nig) % gsz); u.pn = (wgid % nig) / gsz; u.bt = u.pn; u.e = 0; return true;
    }
};
struct LinearOrder {
    int nunits, G, c, shift;
    __device__ bool next(int i, Unit& u) const { const int idx = c + i * G; if (idx >= nunits) return false; u.pm = idx >> shift; u.pn = idx & ((1 << shift) - 1); u.bt = u.pn; u.e = 0; return true; }
};
struct MoeOrder {
    int nblk, s, g8, xr, gr, pn0, cpxs, shift; const PG8_LAS int* blke;
    __device__ void init(int nblk_, int G, int c, int shift_, int gc_log2, const PG8_LAS int* blke_) {
        nblk = nblk_; shift = shift_; blke = blke_; g8 = G >> 3; s = c >> 3; const int x = c & 7; gr = 8 >> gc_log2; xr = x & (gr - 1); const int xc = x / gr; cpxs = shift_ - gc_log2; pn0 = xc << cpxs; }
    __device__ int rb_of(int i) const { const int j = s + i * g8; return (j >> cpxs) * gr + xr; }
    __device__ bool next(int i, Unit& u) const {
        const int j = s + i * g8, rb = (j >> cpxs) * gr + xr; if (rb >= nblk) return false;
        const int pn = pn0 + (j & ((1 << cpxs) - 1)), e = blke[rb];
        u.pm = rb; u.pn = pn; u.e = e; u.bt = (e << shift) + pn; return true;
    }
};

template <class Epi, class Sched, bool ALIGN_EPI, bool GATHER>
__device__ __forceinline__ void gemm_phase(PG8_LAS unsigned char* lds, const Gemm g, const Sched& S, const Epi& E, const PG8_LAS int* rowtab) {
    int tid_ = threadIdx.x; asm volatile("" : "+v"(tid_));
    const int tid = tid_, wid = __builtin_amdgcn_readfirstlane(tid >> 6), lane = tid & 63, wr = wid >> 2, wc = wid & 3, fr = lane & 15, fq = lane >> 4;
    const int K = g.K, nt = K / BK, lda = g.lda;
    unsigned voffA[2], voffB[2]; int RA[2]; unsigned CA2[2];
#pragma unroll
    for (int i = 0; i < 2; ++i) { int R, C; stage_rc(tid * 16 + i * 8192, R, C); const int Rb = Epi::WIDE ? (64 * (R >> 5) + perm32(R & 31)) : Epi::PERM ? ((R & ~31) + perm32(R & 31)) : R;
        voffA[i] = (unsigned)(R * lda + C) * 2u; voffB[i] = (unsigned)(Rb * K + C) * 2u; RA[i] = R; CA2[i] = (unsigned)C * 2u; }
    const size_t kstep = (size_t)(BK * 2);
    const size_t hstepA = (size_t)HALF * lda * 2, tstepA = 2 * hstepA;
    const size_t hstepB = (size_t)(Epi::WIDE ? 32 : HALF) * K * 2, tstepB = (size_t)2 * HALF * K * 2;
    const unsigned ldsw = (unsigned)wid * 1024u;
    const int aoff = lds_byte(wr * 64 + fr, fq * 8), boff = lds_byte(wc * 32 + fr, fq * 8);
    unsigned va[2][2], vn[2][2];
#define PG8_SA(b, h) (((b) * 2 + (h)) * HTB)
#define PG8_SB(b, h) ((4 + (b) * 2 + (h)) * HTB)
#define PG8_STAGE(bufoff, gbase, voff) do { _Pragma("unroll") for (int _i = 0; _i < 2; ++_i) \
        __builtin_amdgcn_global_load_lds((const unsigned*)((const char*)(gbase) + (voff)[_i]), (PG8_LAS unsigned*)(lds + (bufoff) + ldsw + _i * 8192), 16, 0, 0); } while (0)
#define PG8_STAGE_A(bufoff, gbase, h, NXT) do { if constexpr (GATHER) { unsigned o_[2]; o_[0] = (NXT) ? vn[h][0] : va[h][0]; o_[1] = (NXT) ? vn[h][1] : va[h][1]; PG8_STAGE(bufoff, gbase, o_); } \
        else { PG8_STAGE(bufoff, (gbase) + (h) * hstepA, voffA); } } while (0)
#define PG8_LDA(dst, b, h) do { _Pragma("unroll") for (int m = 0; m < 4; ++m) _Pragma("unroll") for (int k = 0; k < 2; ++k) dst[m][k] = *(const PG8_LAS bf16x8*)(lds + PG8_SA(b, h) + aoff + m * 2048 + k * 1024); } while (0)
#define PG8_LDB(dst, b, h) do { _Pragma("unroll") for (int n = 0; n < 2; ++n) _Pragma("unroll") for (int k = 0; k < 2; ++k) dst[n][k] = *(const PG8_LAS bf16x8*)(lds + PG8_SB(b, h) + boff + n * 2048 + k * 1024); } while (0)
#define PG8_MMA(ai, bj, At, Bt) do { __builtin_amdgcn_s_setprio(1); _Pragma("unroll") for (int m = 0; m < 4; ++m) _Pragma("unroll") for (int n = 0; n < 2; ++n) _Pragma("unroll") for (int k = 0; k < 2; ++k) \
        acc[ai][bj][m][n] = __builtin_amdgcn_mfma_f32_16x16x32_bf16(Bt[n][k], At[m][k], acc[ai][bj][m][n], 0, 0, 0); __builtin_amdgcn_s_setprio(0); } while (0)
#define PG8_WAIT_V(n) asm volatile("s_waitcnt vmcnt(" #n ")" ::: "memory")
#define PG8_WAIT_L(n) asm volatile("s_waitcnt lgkmcnt(" #n ")" ::: "memory")
#define PG8_BAR __builtin_amdgcn_s_barrier()
#define PG8_SCHED __builtin_amdgcn_sched_barrier(0)
#define PG8_ROWOFF(dst, ui_) do { _Pragma("unroll") for (int h_ = 0; h_ < 2; ++h_) _Pragma("unroll") for (int i_ = 0; i_ < 2; ++i_) \
        dst[h_][i_] = (unsigned)rowtab[(ui_) * 256 + h_ * 128 + RA[i_]] * (unsigned)(lda * 2) + CA2[i_]; } while (0)
    Unit cur, nxt; int ui = 0;
    if (!S.next(0, cur)) return;
    f32x4 acc[2][2][4][2];
#pragma unroll
    for (int a = 0; a < 2; ++a)
#pragma unroll
        for (int b = 0; b < 2; ++b)
#pragma unroll
            for (int m = 0; m < 4; ++m)
#pragma unroll
                for (int n = 0; n < 2; ++n) acc[a][b][m][n] = (f32x4){0.f, 0.f, 0.f, 0.f};
    bf16x8 At[4][2], B0[2][2], B1[2][2];
    const char* cA = (const char*)g.A + (GATHER ? (size_t)0 : (size_t)cur.pm * tstepA); const char* cB = (const char*)g.Bt + (size_t)cur.bt * tstepB;
    if constexpr (GATHER) { PG8_ROWOFF(va, 0); }
    PG8_STAGE(PG8_SB(0, 0), cB, voffB); PG8_STAGE(PG8_SB(0, 1), cB + hstepB, voffB); PG8_STAGE_A(PG8_SA(0, 0), cA, 0, false); PG8_STAGE_A(PG8_SA(0, 1), cA, 1, false);
    if (wr == 1) PG8_BAR;
    PG8_WAIT_V(2); PG8_BAR;
    PG8_STAGE(PG8_SB(1, 0), cB + kstep, voffB); PG8_STAGE_A(PG8_SA(1, 0), cA + kstep, 0, false); PG8_STAGE(PG8_SB(1, 1), cB + hstepB + kstep, voffB);
    PG8_WAIT_V(6); PG8_BAR;
    for (;;) {
        const bool has_next = S.next(ui + 1, nxt);
        const char* nA = has_next ? (const char*)g.A + (GATHER ? (size_t)0 : (size_t)nxt.pm * tstepA) : cA; const char* nB = has_next ? (const char*)g.Bt + (size_t)nxt.bt * tstepB : cB;
        if constexpr (GATHER) { if (has_next) { PG8_ROWOFF(vn, ui + 1); } else {
#pragma unroll
            for (int h_ = 0; h_ < 2; ++h_)
#pragma unroll
                for (int i_ = 0; i_ < 2; ++i_) vn[h_][i_] = va[h_][i_]; } }
        for (int t = 0; t < nt; t += 2) {
            const bool last = (t == nt - 2);
            const char* a1 = cA + (size_t)(t + 1) * kstep;
            const char* a2 = last ? nA : cA + (size_t)(t + 2) * kstep; const char* b2 = last ? nB : cB + (size_t)(t + 2) * kstep;
            const char* a3 = a2 + kstep; const char* b3 = b2 + kstep;
            PG8_LDB(B0, 0, 0); PG8_LDB(B1, 0, 1); PG8_SCHED; PG8_LDA(At, 0, 0); PG8_STAGE_A(PG8_SA(1, 1), a1, 1, false);
            PG8_WAIT_V(8); PG8_WAIT_L(0); PG8_BAR; PG8_MMA(0, 0, At, B0); PG8_MMA(0, 1, At, B1); PG8_BAR; PG8_SCHED;
            PG8_LDA(At, 0, 1); PG8_STAGE(PG8_SB(0, 0), b2, voffB); PG8_STAGE(PG8_SB(0, 1), b2 + hstepB, voffB); PG8_STAGE_A(PG8_SA(0, 0), a2, 0, last);
            PG8_WAIT_V(8); PG8_WAIT_L(0); PG8_BAR; PG8_MMA(1, 0, At, B0); PG8_MMA(1, 1, At, B1); PG8_BAR; PG8_SCHED;
            PG8_LDB(B0, 1, 0); PG8_LDB(B1, 1, 1); PG8_SCHED; PG8_LDA(At, 1, 0); PG8_STAGE_A(PG8_SA(0, 1), a2, 1, last);
            PG8_WAIT_V(8); PG8_WAIT_L(0); PG8_BAR; PG8_MMA(0, 0, At, B0); PG8_MMA(0, 1, At, B1); PG8_BAR; PG8_SCHED;
            PG8_LDA(At, 1, 1); PG8_STAGE(PG8_SB(1, 0), b3, voffB); PG8_STAGE(PG8_SB(1, 1), b3 + hstepB, voffB); PG8_STAGE_A(PG8_SA(1, 0), a3, 0, last);
            PG8_WAIT_V(8); PG8_WAIT_L(0); PG8_BAR; PG8_MMA(1, 0, At, B0); PG8_MMA(1, 1, At, B1); PG8_BAR; PG8_SCHED;
        }
        if constexpr (ALIGN_EPI) { if (wr == 0) PG8_BAR; }
        E(acc, cur, wr, wc, fr, fq);
        if (!has_next) break;
#pragma unroll
        for (int a = 0; a < 2; ++a)
#pragma unroll
            for (int b = 0; b < 2; ++b)
#pragma unroll
                for (int m = 0; m < 4; ++m)
#pragma unroll
                    for (int n = 0; n < 2; ++n) acc[a][b][m][n] = (f32x4){0.f, 0.f, 0.f, 0.f};
        cur = nxt; cA = nA; cB = nB; ++ui;
        if constexpr (GATHER) {
#pragma unroll
            for (int h_ = 0; h_ < 2; ++h_)
#pragma unroll
                for (int i_ = 0; i_ < 2; ++i_) va[h_][i_] = vn[h_][i_]; }
        if constexpr (ALIGN_EPI) { if (wr == 1) PG8_BAR; }
    }
    PG8_WAIT_V(0);
    if constexpr (!ALIGN_EPI) { if (wr == 0) PG8_BAR; }
    PG8_BAR;
#undef PG8_SA
#undef PG8_SB
#undef PG8_STAGE
#undef PG8_STAGE_A
#undef PG8_LDA
#undef PG8_LDB
#undef PG8_MMA
#undef PG8_WAIT_V
#undef PG8_WAIT_L
#undef PG8_BAR
#undef PG8_SCHED
#undef PG8_ROWOFF
}

template <class Epi, class Sched, bool ALIGN_EPI, bool GATHER>
__device__ __forceinline__ void gemm_phase8(PG8_LAS unsigned char* lds, const Gemm g, const Sched& S, const Epi& E, const PG8_LAS int* rowtab) {
    int tid_ = threadIdx.x; asm volatile("" : "+v"(tid_));
    const int tid = tid_, wid = __builtin_amdgcn_readfirstlane(tid >> 6), lane = tid & 63, wr = wid >> 2, wc = wid & 3, fr = lane & 15, fq = lane >> 4;
    int K_ = g.K; asm volatile("" : "+s"(K_));
    const int K = K_, nt = K / 128, lda = g.lda;
    unsigned voffA[2], voffB[2]; int RA[2]; unsigned CA2[2];
#pragma unroll
    for (int i = 0; i < 2; ++i) { const int u = tid * 16 + i * 8192; const int R = 16 * (u >> 11) + ((u & 1023) >> 6), J = 4 * ((u >> 10) & 1) + (((u & 63) >> 4) ^ ((R >> 2) & 3)); const int Rb = Epi::WIDE ? (64 * (R >> 5) + perm32(R & 31)) : Epi::PERM ? ((R & ~31) + perm32(R & 31)) : R;
        voffA[i] = (unsigned)(R * lda + J * 16); voffB[i] = (unsigned)(Rb * K + J * 16); RA[i] = R; CA2[i] = (unsigned)(J * 16); }
    const size_t kstep = (size_t)128;
    const size_t hstepA = (size_t)HALF * lda, tstepA = 2 * hstepA;
    const size_t hstepB = (size_t)(Epi::WIDE ? 32 : HALF) * K, tstepB = (size_t)2 * HALF * K;
    const unsigned ldsw = (unsigned)wid * 1024u;
    const int aoff0 = wr * 8192 + fr * 64 + 16 * (fq ^ ((fr >> 2) & 3)), boff0 = wc * 4096 + fr * 64 + 16 * (fq ^ ((fr >> 2) & 3));
    unsigned va[2][2], vn[2][2];
#define PG8_SA(b, h) (((b) * 2 + (h)) * HTB)
#define PG8_SB(b, h) ((4 + (b) * 2 + (h)) * HTB)
#define PG8_STAGE(bufoff, gbase, voff) do { _Pragma("unroll") for (int _i = 0; _i < 2; ++_i) \
        __builtin_amdgcn_global_load_lds((const unsigned*)((const char*)(gbase) + (voff)[_i]), (PG8_LAS unsigned*)(lds + (bufoff) + ldsw + _i * 8192), 16, 0, 0); } while (0)
#define PG8_STAGE_A(bufoff, gbase, h, NXT) do { if constexpr (GATHER) { unsigned o_[2]; o_[0] = (NXT) ? vn[h][0] : va[h][0]; o_[1] = (NXT) ? vn[h][1] : va[h][1]; PG8_STAGE(bufoff, gbase, o_); } \
        else { PG8_STAGE(bufoff, (gbase) + (h) * hstepA, voffA); } } while (0)
#define PG8_LDA(dst, b, h) do { _Pragma("unroll") for (int m = 0; m < 4; ++m) { const v4i32 lo_ = *(const PG8_LAS v4i32*)(lds + PG8_SA(b, h) + aoff0 + m * 2048), hi_ = *(const PG8_LAS v4i32*)(lds + PG8_SA(b, h) + aoff0 + m * 2048 + 1024); dst[m] = __builtin_shufflevector(lo_, hi_, 0, 1, 2, 3, 4, 5, 6, 7); } } while (0)
#define PG8_LDB(dst, b, h) do { _Pragma("unroll") for (int n = 0; n < 2; ++n) { const v4i32 lo_ = *(const PG8_LAS v4i32*)(lds + PG8_SB(b, h) + boff0 + n * 2048), hi_ = *(const PG8_LAS v4i32*)(lds + PG8_SB(b, h) + boff0 + n * 2048 + 1024); dst[n] = __builtin_shufflevector(lo_, hi_, 0, 1, 2, 3, 4, 5, 6, 7); } } while (0)
#define PG8_F8(F_) ((v8i32){(int)F_[0][0], (int)F_[0][1], (int)F_[0][2], (int)F_[0][3], (int)F_[1][0], (int)F_[1][1], (int)F_[1][2], (int)F_[1][3]})
#define PG8_MMA(ai, bj, At, Bt) do { __builtin_amdgcn_s_setprio(1); _Pragma("unroll") for (int m = 0; m < 4; ++m) _Pragma("unroll") for (int n = 0; n < 2; ++n) \
        asm volatile("v_mfma_scale_f32_16x16x128_f8f6f4 %0, %1, %2, %0, %3, %4 op_sel_hi:[0,0,0]" : "+v"(acc[ai][bj][m][n]) : "v"(Bt[n]), "v"(At[m]), "v"(sclw_), "v"(scl_));     __builtin_amdgcn_s_setprio(0); } while (0)
#define PG8_WAIT_V(n) asm volatile("s_waitcnt vmcnt(" #n ")" ::: "memory")
#define PG8_WAIT_L(n) asm volatile("s_waitcnt lgkmcnt(" #n ")" ::: "memory")
#define PG8_BAR __builtin_amdgcn_s_barrier()
#define PG8_SCHED __builtin_amdgcn_sched_barrier(0)
#define PG8_ROWOFF(dst, ui_) do { _Pragma("unroll") for (int h_ = 0; h_ < 2; ++h_) _Pragma("unroll") for (int i_ = 0; i_ < 2; ++i_) \
        dst[h_][i_] = (unsigned)rowtab[(ui_) * 256 + h_ * 128 + RA[i_]] * (unsigned)lda + CA2[i_]; } while (0)
    Unit cur, nxt; int ui = 0;
    if (!S.next(0, cur)) return;
    int scl_ = g.ascale, sclw_ = 0x7A7A7A7A; asm volatile("" : "+v"(scl_), "+v"(sclw_));
    float z_ = 0.f; asm volatile("" : "+v"(z_));
    f32x4 acc[2][2][4][2];
#pragma unroll
    for (int a = 0; a < 2; ++a)
#pragma unroll
        for (int b = 0; b < 2; ++b)
#pragma unroll
            for (int m = 0; m < 4; ++m)
#pragma unroll
                for (int n = 0; n < 2; ++n) acc[a][b][m][n] = (f32x4){z_, z_, z_, z_};
    v8i32 At[4], B0[2], B1[2];
    const char* cA = (const char*)g.A + (GATHER ? (size_t)0 : (size_t)cur.pm * tstepA); const char* cB = (const char*)g.Bt + (size_t)cur.bt * tstepB;
    if constexpr (GATHER) { PG8_ROWOFF(va, 0); }
    PG8_STAGE(PG8_SB(0, 0), cB, voffB); PG8_STAGE(PG8_SB(0, 1), cB + hstepB, voffB); PG8_STAGE_A(PG8_SA(0, 0), cA, 0, false); PG8_STAGE_A(PG8_SA(0, 1), cA, 1, false);
    if (wr == 1) PG8_BAR;
    PG8_WAIT_V(2); PG8_BAR;
    PG8_STAGE(PG8_SB(1, 0), cB + kstep, voffB); PG8_STAGE_A(PG8_SA(1, 0), cA + kstep, 0, false); PG8_STAGE(PG8_SB(1, 1), cB + hstepB + kstep, voffB);
    PG8_WAIT_V(6); PG8_BAR;
    for (;;) {
        const bool has_next = S.next(ui + 1, nxt);
        const char* nA = has_next ? (const char*)g.A + (GATHER ? (size_t)0 : (size_t)nxt.pm * tstepA) : cA; const char* nB = has_next ? (const char*)g.Bt + (size_t)nxt.bt * tstepB : cB;
        asm volatile("" : "+s"(nB));
        if constexpr (GATHER) { if (has_next) { PG8_ROWOFF(vn, ui + 1); } else {
#pragma unroll
            for (int h_ = 0; h_ < 2; ++h_)
#pragma unroll
                for (int i_ = 0; i_ < 2; ++i_) vn[h_][i_] = va[h_][i_]; } }
#pragma unroll 1
        for (int t = 0; t < nt; t += 2) {
            const bool last = (t == nt - 2);
            const char* a1 = cA + (size_t)(t + 1) * kstep;
            const char* a2 = last ? nA : cA + (size_t)(t + 2) * kstep; const char* b2 = last ? nB : cB + (size_t)(t + 2) * kstep;
            const char* a3 = a2 + kstep; const char* b3 = b2 + kstep;
            PG8_LDB(B0, 0, 0); PG8_LDB(B1, 0, 1); PG8_SCHED; PG8_LDA(At, 0, 0); PG8_STAGE_A(PG8_SA(1, 1), a1, 1, false);
            PG8_WAIT_V(8); PG8_WAIT_L(0); PG8_BAR; PG8_MMA(0, 0, At, B0); PG8_MMA(0, 1, At, B1); PG8_BAR; PG8_SCHED;
            PG8_LDA(At, 0, 1); PG8_STAGE(PG8_SB(0, 0), b2, voffB); PG8_STAGE(PG8_SB(0, 1), b2 + hstepB, voffB); PG8_STAGE_A(PG8_SA(0, 0), a2, 0, last);
            PG8_WAIT_V(8); PG8_WAIT_L(0); PG8_BAR; PG8_MMA(1, 0, At, B0); PG8_MMA(1, 1, At, B1); PG8_BAR; PG8_SCHED;
            PG8_LDB(B0, 1, 0); PG8_LDB(B1, 1, 1); PG8_SCHED; PG8_LDA(At, 1, 0); PG8_STAGE_A(PG8_SA(0, 1), a2, 1, last);
            PG8_WAIT_V(8); PG8_WAIT_L(0); PG8_BAR; PG8_MMA(0, 0, At, B0); PG8_MMA(0, 1, At, B1); PG8_BAR; PG8_SCHED;
            PG8_LDA(At, 1, 1); PG8_STAGE(PG8_SB(1, 0), b3, voffB); PG8_STAGE(PG8_SB(1, 1), b3 + hstepB, voffB); PG8_STAGE_A(PG8_SA(1, 0), a3, 0, last);
            PG8_WAIT_V(8); PG8_WAIT_L(0); PG8_BAR; PG8_MMA(1, 0, At, B0); PG8_MMA(1, 1, At, B1); PG8_BAR; PG8_SCHED;
        }
        if constexpr (ALIGN_EPI) { if (wr == 0) PG8_BAR; }
        asm volatile("s_nop 15\n\ts_nop 7" ::: "memory");
        E(acc, cur, wr, wc, fr, fq);
        if (!has_next) break;
#pragma unroll
        for (int a = 0; a < 2; ++a)
#pragma unroll
            for (int b = 0; b < 2; ++b)
#pragma unroll
                for (int m = 0; m < 4; ++m)
#pragma unroll
                    for (int n = 0; n < 2; ++n) acc[a][b][m][n] = (f32x4){z_, z_, z_, z_};
        cur = nxt; cA = nA; cB = nB; ++ui;
        if constexpr (GATHER) {
#pragma unroll
            for (int h_ = 0; h_ < 2; ++h_)
#pragma unroll
                for (int i_ = 0; i_ < 2; ++i_) va[h_][i_] = vn[h_][i_]; }
        if constexpr (ALIGN_EPI) { if (wr == 1) PG8_BAR; }
    }
    PG8_WAIT_V(0);
    if constexpr (!ALIGN_EPI) { if (wr == 0) PG8_BAR; }
    PG8_BAR;
#undef PG8_SA
#undef PG8_SB
#undef PG8_STAGE
#undef PG8_STAGE_A
#undef PG8_LDA
#undef PG8_LDB
#undef PG8_MMA
#undef PG8_WAIT_V
#undef PG8_WAIT_L
#undef PG8_BAR
#undef PG8_SCHED
#undef PG8_ROWOFF
#undef PG8_F8
}


typedef const f32x4 (&AccRef)[2][2][4][2];
#define EPI_ROWS(...) _Pragma("unroll") for (int ai = 0; ai < 2; ++ai) _Pragma("unroll") for (int m = 0; m < 4; ++m) { const int row = u.pm * BM + ai * HALF + wr * 64 + m * 16 + fr; __VA_ARGS__ }

template <bool F8> struct EpiInproj {
    static constexpr bool PERM = true, WIDE = !F8;
    unsigned char* ws;
    __device__ __forceinline__ void operator()(AccRef acc, const Unit& u, int wr, int wc, int fr, int fq) const {
        if constexpr (F8) {
            unsigned char* gb = ws + WS_G + (size_t)(u.pn * 256 + wc * 32 + 8 * fq);
            EPI_ROWS(
                unsigned char* rp = gb + (size_t)row * 2048;
                _Pragma("unroll") for (int bj = 0; bj < 2; ++bj) *(u32x2*)(rp + bj * HALF) = pack8_fp8(acc[ai][bj][m][0], acc[ai][bj][m][1]);
            )
            return;
        }
        const int pn = u.pn; const bool odd = fr & 1;
#if G_FP8
        if (pn >= 8) {
            unsigned char* gb = ws + WS_G + (size_t)((pn - 8) * 256 + wc * 64 + 8 * fq + (odd ? 32 : 0));
            EPI_ROWS(
                const u32x2 x0 = pack8_fp8(acc[ai][0][m][0], acc[ai][0][m][1]), x1 = pack8_fp8(acc[ai][1][m][0], acc[ai][1][m][1]);
                const u32x2 snd = odd ? x0 : x1; u32x2 rcv; rcv.x = lane_xor1(snd.x); rcv.y = lane_xor1(snd.y);
                unsigned char* rp = gb + (size_t)(row & ~1) * 2048;
                *(u32x2*)rp = odd ? rcv : x0; *(u32x2*)(rp + 2048) = odd ? x1 : rcv;
            )
            return;
        }
#endif
        const size_t off = pn < 6 ? WS_QF + (size_t)(pn >> 1) * (WS_KF - WS_QF) : pn < 8 ? WS_QL : WS_G;
        const int ld = pn < 8 ? 512 : 2048, col0 = (pn < 6 ? (pn & 1) : pn < 8 ? (pn - 6) : (pn - 8)) * 256 + wc * 64 + 8 * fq + (odd ? 32 : 0);
        const float sc = (pn < 2 ? C2F : 1.f);
        bf16_t* base = (bf16_t*)(ws + off) + col0;
        EPI_ROWS(
            const u32x4 x0 = pack8(acc[ai][0][m][0] * sc, acc[ai][0][m][1] * sc), x1 = pack8(acc[ai][1][m][0] * sc, acc[ai][1][m][1] * sc);
            const u32x4 snd = odd ? x0 : x1; u32x4 rcv; rcv.x = lane_xor1(snd.x); rcv.y = lane_xor1(snd.y); rcv.z = lane_xor1(snd.z); rcv.w = lane_xor1(snd.w);
            bf16_t* rp = base + (size_t)(row & ~1) * ld;
            *(u32x4*)rp = odd ? rcv : x0; *(u32x4*)(rp + ld) = odd ? x1 : rcv;
        )
    }
};
struct EpiQup {
    static constexpr bool PERM = true, WIDE = false;
    bf16_t* QM; const float *SSQ, *CS;
    __device__ __forceinline__ void operator()(AccRef acc, const Unit& u, int wr, int wc, int fr, int fq) const {
        const int pn = u.pn;
        if (pn < 2) {
            EPI_ROWS(
                const float rs = C2M * SSQ[(size_t)row * 2];
                _Pragma("unroll") for (int bj = 0; bj < 2; ++bj) { const int c = pn * 256 + bj * HALF + wc * 32 + 8 * fq, h = c >> 6, d = c & 63;
                    *(u32x4*)(QM + (size_t)row * 768 + h * 96 + d) = pack8(acc[ai][bj][m][0] * rs, acc[ai][bj][m][1] * rs); }
            )
        } else {
            const float sgn = (fq < 2) ? -1.f : 1.f;
            EPI_ROWS(
                const float rs = C2M * SSQ[(size_t)row * 2];
                const float* cs = CS + (size_t)row * 32 + ((8 * fq) & 15);
                f32x4 c0 = *(const f32x4*)(cs) * rs, c1 = *(const f32x4*)(cs + 4) * rs, s0 = *(const f32x4*)(cs + 16) * (rs * sgn), s1 = *(const f32x4*)(cs + 20) * (rs * sgn);
                _Pragma("unroll") for (int bj = 0; bj < 2; ++bj) { const int h = 4 * bj + wc; f32x4 o0, o1;
                    _Pragma("unroll") for (int i = 0; i < 4; ++i) {
                        const float v0 = acc[ai][bj][m][0][i], v1 = acc[ai][bj][m][1][i]; const float p0 = __shfl_xor(v0, 32), p1 = __shfl_xor(v1, 32);
                        o0[i] = v0 * c0[i] + p0 * s0[i]; o1[i] = v1 * c1[i] + p1 * s1[i]; }
                    *(u32x4*)(QM + (size_t)row * 768 + h * 96 + 64 + 8 * fq) = pack8(o0, o1); }
            )
        }
    }
};
struct EpiKvup {
    static constexpr bool PERM = true, WIDE = false;
    bf16_t* KN; const float* SSQ;
    __device__ __forceinline__ void operator()(AccRef acc, const Unit& u, int wr, int wc, int fr, int fq) const {
        bf16_t* base = KN + (size_t)(u.pn >> 1) * ((WS_VM - WS_KN) / 2) + (u.pn & 1) * 256 + wc * 32 + 8 * fq;
        EPI_ROWS(
            const float rs = SSQ[(size_t)row * 2 + 1];
            _Pragma("unroll") for (int bj = 0; bj < 2; ++bj) *(u32x4*)(base + (size_t)row * 512 + bj * HALF) = pack8(acc[ai][bj][m][0] * rs, acc[ai][bj][m][1] * rs);
        )
    }
};
template <int STEP> struct EpiMerge {
    static constexpr bool PERM = true, WIDE = true;
    bf16_t *T0, *MG; const bf16_t* G; const float* b_merge;
    __device__ __forceinline__ void operator()(AccRef acc, const Unit& u, int wr, int wc, int fr, int fq) const {
        const int c0 = u.pn * 256 + wc * 64 + 8 * fq; const bool odd = fr & 1;
        f32x4 bm[2][2];
        _Pragma("unroll") for (int bj = 0; bj < 2; ++bj) { bm[bj][0] = *(const f32x4*)(b_merge + STEP * 1024 + c0 + bj * 32); bm[bj][1] = *(const f32x4*)(b_merge + STEP * 1024 + c0 + bj * 32 + 4); }
        _Pragma("unroll") for (int ai = 0; ai < 2; ++ai) {
            u32x4 tv[4][2];
#if G_FP8
            u32x2 gv[4][2];
#else
            u32x4 gv[4][2];
#endif
            _Pragma("unroll") for (int m = 0; m < 4; ++m) _Pragma("unroll") for (int bj = 0; bj < 2; ++bj) { const size_t row = (size_t)(u.pm * BM + ai * HALF + wr * 64 + m * 16 + fr);
#if G_FP8
                gv[m][bj] = *(const u32x2*)((const unsigned char*)G + row * 2048 + STEP * 1024 + c0 + bj * 32);
#else
                gv[m][bj] = *(const u32x4*)(G + row * 2048 + STEP * 1024 + c0 + bj * 32);
#endif
                if (STEP == 1) tv[m][bj] = *(const u32x4*)(T0 + row * 1024 + c0 + bj * 32); }
            _Pragma("unroll") for (int m = 0; m < 4; ++m) { const size_t row = (size_t)(u.pm * BM + ai * HALF + wr * 64 + m * 16 + fr); u32x4 xo[2];
              _Pragma("unroll") for (int bj = 0; bj < 2; ++bj) {
                const f32x4 bm0 = bm[bj][0], bm1 = bm[bj][1];
                f32x4 a = acc[ai][bj][m][0], b = acc[ai][bj][m][1];
#if G_FP8
                { const u32x2 g = gv[m][bj];
                  const f32x2 g01 = __builtin_amdgcn_cvt_pk_f32_fp8((int)g.x, false), g23 = __builtin_amdgcn_cvt_pk_f32_fp8((int)g.x, true), g45 = __builtin_amdgcn_cvt_pk_f32_fp8((int)g.y, false), g67 = __builtin_amdgcn_cvt_pk_f32_fp8((int)g.y, true);
                  const f32x2 s01 = fsigmoid2(g01 + (f32x2){bm0[0], bm0[1]}), s23 = fsigmoid2(g23 + (f32x2){bm0[2], bm0[3]}), s45 = fsigmoid2(g45 + (f32x2){bm1[0], bm1[1]}), s67 = fsigmoid2(g67 + (f32x2){bm1[2], bm1[3]});
                  const f32x2 a01 = (f32x2){a[0], a[1]} * s01, a23 = (f32x2){a[2], a[3]} * s23, b01 = (f32x2){b[0], b[1]} * s45, b23 = (f32x2){b[2], b[3]} * s67;
                  a = (f32x4){a01.x, a01.y, a23.x, a23.y}; b = (f32x4){b01.x, b01.y, b23.x, b23.y}; }
#else
                const u32x4 g = gv[m][bj];
                a[0] *= fsigmoid(bflo(g.x) + bm0[0]); a[1] *= fsigmoid(bfhi(g.x) + bm0[1]); a[2] *= fsigmoid(bflo(g.y) + bm0[2]); a[3] *= fsigmoid(bfhi(g.y) + bm0[3]);
                b[0] *= fsigmoid(bflo(g.z) + bm1[0]); b[1] *= fsigmoid(bfhi(g.z) + bm1[1]); b[2] *= fsigmoid(bflo(g.w) + bm1[2]); b[3] *= fsigmoid(bfhi(g.w) + bm1[3]);
#endif
                if (STEP == 1) { const u32x4 t = tv[m][bj];
                    a[0] += bflo(t.x); a[1] += bfhi(t.x); a[2] += bflo(t.y); a[3] += bfhi(t.y); b[0] += bflo(t.z); b[1] += bfhi(t.z); b[2] += bflo(t.w); b[3] += bfhi(t.w);
#if WO_FP8
                    { _Pragma("unroll") for (int i = 0; i < 4; ++i) { a[i] = fminf(fmaxf(a[i] * 16.f, -448.f), 448.f); b[i] = fminf(fmaxf(b[i] * 16.f, -448.f), 448.f); }
                      const u32x2 q8 = pack8_fp8(a, b); xo[bj] = (u32x4){q8.x, q8.y, 0u, 0u}; } }
#else
                    xo[bj] = pack8(a, b); }
#endif
                else xo[bj] = pack8(a, b); }
#if WO_FP8
              if (STEP == 1) { const u32x2 s2 = odd ? (u32x2){xo[0].x, xo[0].y} : (u32x2){xo[1].x, xo[1].y}; u32x2 r2; r2.x = lane_xor1(s2.x); r2.y = lane_xor1(s2.y);
                unsigned char* rp = (unsigned char*)MG + (row & ~(size_t)1) * 1024 + c0 + (odd ? 32 : 0);
                *(u32x2*)rp = odd ? r2 : (u32x2){xo[0].x, xo[0].y}; *(u32x2*)(rp + 1024) = odd ? (u32x2){xo[1].x, xo[1].y} : r2; } else
#endif
              { const u32x4 snd = odd ? xo[0] : xo[1]; u32x4 rcv; rcv.x = lane_xor1(snd.x); rcv.y = lane_xor1(snd.y); rcv.z = lane_xor1(snd.z); rcv.w = lane_xor1(snd.w);
                bf16_t* rp = (STEP == 1 ? MG : T0) + (row & ~(size_t)1) * 1024 + c0 + (odd ? 32 : 0);
                *(u32x4*)rp = odd ? rcv : xo[0]; *(u32x4*)(rp + 1024) = odd ? xo[1] : rcv; } }
        }
    }
};
template <int MB> struct EpiWoT {
    static constexpr bool PERM = true, WIDE = (MB == 2);
    const float* x; bf16_t* X1;
    __device__ __forceinline__ void operator()(AccRef acc, const Unit& u, int wr, int wc, int fr, int fq) const {
        if constexpr (MB == 1) {
            const int c0 = u.pn * 256 + wc * 32 + 8 * fq;
            EPI_ROWS(
                const float* xl = x + (size_t)row * 1024 + c0; asm volatile("" : "+v"(xl));
                _Pragma("unroll") for (int bj = 0; bj < 2; ++bj) { const f32x4 xa = *(const f32x4*)(xl + bj * HALF), xb = *(const f32x4*)(xl + bj * HALF + 4);
                    *(u32x4*)(X1 + (size_t)row * 1024 + c0 + bj * HALF) = pack8(xa + acc[ai][bj][m][0], xb + acc[ai][bj][m][1]); }
            )
        } else {
        const int c0 = u.pn * 256 + wc * 64 + 8 * fq; const bool odd = fr & 1;
        _Pragma("unroll") for (int ai = 0; ai < 2; ++ai) _Pragma("unroll") for (int mh = 0; mh < 2; ++mh) {
            f32x4 xv[2][2][2];
            _Pragma("unroll") for (int mm = 0; mm < 2; ++mm) _Pragma("unroll") for (int bj = 0; bj < 2; ++bj) { const size_t off = (size_t)(u.pm * BM + ai * HALF + wr * 64 + (2 * mh + mm) * 16 + fr) * 1024 + c0 + bj * 32;
                xv[mm][bj][0] = *(const f32x4*)(x + off); xv[mm][bj][1] = *(const f32x4*)(x + off + 4); }
            _Pragma("unroll") for (int mm = 0; mm < 2; ++mm) { const int m = 2 * mh + mm; const size_t row = (size_t)(u.pm * BM + ai * HALF + wr * 64 + m * 16 + fr);
                const u32x4 x0 = pack8(xv[mm][0][0] + acc[ai][0][m][0], xv[mm][0][1] + acc[ai][0][m][1]), x1 = pack8(xv[mm][1][0] + acc[ai][1][m][0], xv[mm][1][1] + acc[ai][1][m][1]);
                const u32x4 snd = odd ? x0 : x1; u32x4 rcv; rcv.x = lane_xor1(snd.x); rcv.y = lane_xor1(snd.y); rcv.z = lane_xor1(snd.z); rcv.w = lane_xor1(snd.w);
                bf16_t* rp = X1 + (row & ~(size_t)1) * 1024 + c0 + (odd ? 32 : 0);
                *(u32x4*)rp = odd ? rcv : x0; *(u32x4*)(rp + 1024) = odd ? x1 : rcv; }
        }
        }
    }
};
#if WO_FP8
typedef EpiWoT<1> EpiWo;
#else
typedef EpiWoT<2> EpiWo;
#endif
template <bool F8> struct EpiSwiglu {
    static constexpr bool PERM = true, WIDE = false;
    bf16_t* ACT; const float* b_gu;
    __device__ __forceinline__ void operator()(AccRef acc, const Unit& u, int wr, int wc, int fr, int fq) const {
        const int c = u.pn * 128 + wc * 32 + 8 * fq; const float* bg = b_gu + (size_t)u.e * 2048 + c; const float sc = 1.f;
        const f32x4 g0 = *(const f32x4*)(bg), g1 = *(const f32x4*)(bg + 4), u0 = *(const f32x4*)(bg + 1024), u1 = *(const f32x4*)(bg + 1028);
        EPI_ROWS(
            f32x4 ga = acc[ai][0][m][0] * sc + g0, gb = acc[ai][0][m][1] * sc + g1, ua = acc[ai][1][m][0] * sc + u0, ub = acc[ai][1][m][1] * sc + u1, oa, ob;
            _Pragma("unroll") for (int i = 0; i < 4; ++i) {
                const f32x2 x = (f32x2){fminf(ga[i], 7.f), fminf(gb[i], 7.f)}, y = (f32x2){fminf(fmaxf(ua[i], -7.f), 7.f), fminf(fmaxf(ub[i], -7.f), 7.f)};
                const f32x2 r = (y + 1.f) * x * fsigmoid2(x * 1.702f);
                oa[i] = r.x; ob[i] = r.y; }
            if (F8) *(u32x2*)((unsigned char*)ACT + (size_t)row * 1024 + c) = pack8_fp8(oa, ob);
            else *(u32x4*)(ACT + (size_t)row * 1024 + c) = pack8(oa, ob);
        )
    }
};
template <bool F8> struct EpiDown {
    static constexpr bool PERM = true, WIDE = false;
    bf16_t* Z; const float* b_down; const int* ROWSLOT; const float* ROWW; const volatile PG8_LAS int* cntL; const volatile PG8_LAS int* bst;
    __device__ __forceinline__ void operator()(AccRef acc, const Unit& u, int wr, int wc, int fr, int fq) const {
        const int c0 = u.pn * 256 + wc * 32 + 8 * fq; const float* bd = b_down + (size_t)u.e * 1024 + c0; const float sc = 1.f;
#if FUSED_ROWS
        const int eb = u.e * ESTR + ((u.pm - bst[u.e]) << 8) - u.pm * BM;
#endif
        f32x4 bv[2][2];
        _Pragma("unroll") for (int bj = 0; bj < 2; ++bj) _Pragma("unroll") for (int n = 0; n < 2; ++n) bv[bj][n] = *(const f32x4*)(bd + bj * HALF + 4 * n);
        EPI_ROWS(
#if FUSED_ROWS
            const int slot = ROWSLOT[eb + row]; const float w = ROWW[eb + row];
#else
            const int slot = ROWSLOT[row]; const float w = ROWW[row];
#endif
#if Z_FP8
            const float w16 = w * 16.f;
            _Pragma("unroll") for (int bj = 0; bj < 2; ++bj)
                { f32x4 za = (acc[ai][bj][m][0] * sc + bv[bj][0]) * w16, zb = (acc[ai][bj][m][1] * sc + bv[bj][1]) * w16;
                    _Pragma("unroll") for (int i = 0; i < 4; ++i) { za[i] = fminf(fmaxf(za[i], -448.f), 448.f); zb[i] = fminf(fmaxf(zb[i], -448.f), 448.f); }
                    *(u32x2*)((unsigned char*)Z + (size_t)slot * 1024 + c0 + bj * HALF) = pack8_fp8(za, zb); }
#else
            _Pragma("unroll") for (int bj = 0; bj < 2; ++bj)
                *(u32x4*)(Z + (size_t)slot * 1024 + c0 + bj * HALF) = pack8((acc[ai][bj][m][0] * sc + bv[bj][0]) * w, (acc[ai][bj][m][1] * sc + bv[bj][1]) * w);
#endif
        )
    }
};
#undef EPI_ROWS
}

namespace att {
constexpr int KB_OFF = 0, K_OFF = 16384, KSLOT = 12288, V_OFF = K_OFF + 2 * KSLOT, VSLOT = 8192, OST_OFF = V_OFF + 2 * VSLOT, OST_W = 4608, ATT_LDS = OST_OFF + 8 * OST_W + 64;
constexpr int BG_STAGE_OFF = 96 * 1024;
static_assert(ATT_LDS <= BG_STAGE_OFF && BG_STAGE_OFF + 32768 <= RING_BYTES, "attention LDS");
typedef short v4i16_t __attribute__((ext_vector_type(4)));
__device__ __forceinline__ s16x4 vtr(const LAS unsigned char* p) { return __builtin_bit_cast(s16x4, __builtin_amdgcn_ds_read_tr16_b64_v4i16((LAS v4i16_t*)p)); }
__device__ __forceinline__ float xor32(float v) { return __shfl_xor(v, 32); }
__device__ __forceinline__ void glds16(const void* gsrc, unsigned lds_dst) { unsigned keep;
    asm volatile("s_mov_b32 %0, m0\n\ts_mov_b32 m0, %2\n\ts_nop 0\n\tglobal_load_lds_dwordx4 %1, off\n\ts_mov_b32 m0, %0" : "=&s"(keep) : "v"(gsrc), "s"(lds_dst) : "memory"); }

template <int DQ, bool FOX, class CV>
__device__ __forceinline__ void attn_unit(CV& cv, LAS unsigned char* lds, int b, int h, int qb, const bf16* Q, const bf16* K, const bf16* KP, const bf16* V, const float* KBg, bf16* O, float kmax2) {
    constexpr int QP = FOX ? 512 : 768, ND = DQ / 16;
    int tid_ = threadIdx.x; asm volatile("" : "+v"(tid_));
    const int tid = tid_, lane = tid & 63, r32 = lane & 31, hi = lane >> 5; const int wid = __builtin_amdgcn_readfirstlane(tid >> 6);
    const size_t rowbase = (size_t)b * SEQ; const int q0 = qb * 256, NT = q0 / 64 + 4, qw0 = q0 + 32 * wid, my_last = (qw0 + 31) >> 6;
    const bf16* ksrc = K + (rowbase + lane) * 512 + h * 64 + wid * 8;
    const bf16* kpsrc = KP + (rowbase + lane) * 32 + (wid & 3) * 8;
    const bf16* vsrc = V + (rowbase + 16 * (wid & 3) + (lane >> 2)) * 512 + h * 64 + (wid >> 2) * 32 + (lane & 3) * 8;
    const unsigned ldsb = (unsigned)(size_t)lds;
#define ATT_ISSUE(t, buf) do { \
        glds16(ksrc + (size_t)(t) * 64 * 512, (unsigned)__builtin_amdgcn_readfirstlane(ldsb + K_OFF + (buf) * KSLOT + wid * 1024)); \
        if (DQ > 64 && wid < 4) glds16(kpsrc + (size_t)(t) * 64 * 32, (unsigned)__builtin_amdgcn_readfirstlane(ldsb + K_OFF + (buf) * KSLOT + (8 + wid) * 1024)); \
        glds16(vsrc + (size_t)(t) * 64 * 512, (unsigned)__builtin_amdgcn_readfirstlane(ldsb + V_OFF + (buf) * VSLOT + wid * 1024)); } while (0)
    ATT_ISSUE(NT - 1, 0);
    if (FOX) { const f32x4* src = (const f32x4*)(KBg + (size_t)(b * 8 + h) * SEQ); LAS f32x4* dst = (LAS f32x4*)(lds + KB_OFF);
        for (int i = tid; i < NT * 16; i += 512) dst[i] = src[i]; }
    bf16x8 qr[ND];
    { const bf16* Qw = Q + (rowbase + qw0 + r32) * QP + h * DQ + hi * 8;
#pragma unroll
      for (int d0 = 0; d0 < ND; ++d0) qr[d0] = *(const bf16x8*)(Qw + d0 * 16);
#pragma unroll
      for (int d0 = 0; d0 < ND; ++d0) asm volatile("" : "+v"(qr[d0])); }
    float m = 0.f, l = 0.f; f32x16 o0 = {}, o1 = {}, negm = {};
    float bq = 0.f; bool wdone = false;
    volatile LAS int* dflag = (volatile LAS int*)(lds + OST_OFF + 8 * OST_W);
    if (FOX) {
        float qs = 0.f;
#pragma unroll
        for (int d0 = 0; d0 < ND; ++d0)
#pragma unroll
            for (int j = 0; j < 8; ++j) { const float v = bf2f((bf16)qr[d0][j]); qs += v * v; }
        qs += xor32(qs);
        bq = sqrtf(qs) * sqrtf(kmax2) + 1.f;
        if (lane == 0) dflag[wid] = 0x7fffffff;
    }
    if (wid >= 4) __builtin_amdgcn_s_setprio(1);
    for (int it = 0; it < NT; ++it) {
        const int t = NT - 1 - it;
        const bool full = (it == 0) || !(cv.pend && cv.age == 0);
        if (full) VM_WAIT(); else asm volatile("s_waitcnt vmcnt(4)" ::: "memory");
        LDS_WAIT(); __builtin_amdgcn_s_barrier(); asm volatile("" ::: "memory");
        if (FOX && it + 1 < NT) ATT_ISSUE(t - 1, (it + 1) & 1);
        if (FOX && it > 0) { typedef int i32x4_ __attribute__((ext_vector_type(4)));
            const i32x4_ f0 = *(const LAS i32x4_*)(lds + OST_OFF + 8 * OST_W), f1 = *(const LAS i32x4_*)(lds + OST_OFF + 8 * OST_W + 16);
            const int mxf = max(max(max(f0.x, f0.y), max(f0.z, f0.w)), max(max(f1.x, f1.y), max(f1.z, f1.w)));
            if (mxf < it) break; }
        if (cv.pend) { if (full) cv.consume(lane); else cv.age = 1; }
        if (!FOX && it + 1 < NT) ATT_ISSUE(t - 1, (it + 1) & 1);
        if (!FOX && !cv.pend) cv.issue(lane);
        __builtin_amdgcn_sched_barrier(0);
        if (t <= my_last && !wdone) {
            const LAS unsigned char* Kb = lds + K_OFF + (it & 1) * KSLOT + hi * 1024 + r32 * 16;
            const LAS unsigned char* vp = lds + V_OFF + (it & 1) * VSLOT + ((lane >> 4) & 1) * 32 + (lane & 3) * 8 + (4 * hi + ((lane & 15) >> 2)) * 64;
            bf16x8 kf[2 * ND]; s16x4 vt[16];
            f32x16 p0, p1;
            if (FOX) {
                const LAS float* kbt = (const LAS float*)(lds + KB_OFF) + t * 64 + 4 * hi;
#pragma unroll
                for (int g = 0; g < 4; ++g) { const f32x4 a = *(const LAS f32x4*)(kbt + 8 * g), c = *(const LAS f32x4*)(kbt + 32 + 8 * g);
                    const f32x2 mm = (f32x2){m, m};
                    const f32x2 a01 = (f32x2){a[0], a[1]} - mm, a23 = (f32x2){a[2], a[3]} - mm, c01 = (f32x2){c[0], c[1]} - mm, c23 = (f32x2){c[2], c[3]} - mm;
                    p0[4 * g] = a01.x; p0[4 * g + 1] = a01.y; p0[4 * g + 2] = a23.x; p0[4 * g + 3] = a23.y; p1[4 * g] = c01.x; p1[4 * g + 1] = c01.y; p1[4 * g + 2] = c23.x; p1[4 * g + 3] = c23.y; }
            }
#pragma unroll
            for (int d0 = 0; d0 < ND; ++d0) { kf[2 * d0] = *(const LAS bf16x8*)(Kb + d0 * 2048); kf[2 * d0 + 1] = *(const LAS bf16x8*)(Kb + d0 * 2048 + 512); }
            __builtin_amdgcn_sched_barrier(0);
            if (!FOX) { p0 = negm; p1 = negm; }
#pragma unroll
            for (int d0 = 0; d0 < ND; ++d0) {
                p0 = __builtin_amdgcn_mfma_f32_32x32x16_bf16(kf[2 * d0], qr[d0], p0, 0, 0, 0); p1 = __builtin_amdgcn_mfma_f32_32x32x16_bf16(kf[2 * d0 + 1], qr[d0], p1, 0, 0, 0); }
            __builtin_amdgcn_sched_barrier(0);
#pragma unroll
            for (int k = 0; k < 4; ++k) { vt[4 * k] = vtr(vp + k * 1024); vt[4 * k + 1] = vtr(vp + k * 1024 + 512); vt[4 * k + 2] = vtr(vp + 4096 + k * 1024); vt[4 * k + 3] = vtr(vp + 4096 + k * 1024 + 512); }
            __builtin_amdgcn_sched_barrier(0);
            const bool first = (t == my_last);
            if (FOX && first) { const int qabs = qw0 + r32, kv0 = t * 64 + 4 * hi;
#pragma unroll
                for (int r = 0; r < 16; ++r) { const int kv = kv0 + (r & 3) + 8 * (r >> 2); if (kv > qabs) p0[r] = -INFINITY; if (kv + 32 > qabs) p1[r] = -INFINITY; } }
            asm volatile("s_nop 15\n\ts_nop 3" : "+v"(p0), "+v"(p1));
            float mx;
            asm("v_max_f32 %0, %1, %2" : "=v"(mx) : "v"(p0[0]), "v"(p1[0]));
#pragma unroll
            for (int r = 1; r < 16; ++r) asm("v_max3_f32 %0, %1, %2, %3" : "=v"(mx) : "v"(mx), "v"(p0[r]), "v"(p1[r]));
            { const auto sw_ = __builtin_amdgcn_permlane32_swap(__float_as_uint(mx), __float_as_uint(mx), false, false);
              asm("v_max_f32 %0, %1, %2" : "=v"(mx) : "v"(__uint_as_float(sw_[0])), "v"(__uint_as_float(sw_[1]))); }
            if (first || __any(mx > 6.f)) {
                const float dl = first ? mx : fmaxf(mx, 0.f), al = __builtin_amdgcn_exp2f(-dl);
                m += dl; l *= al;
#pragma unroll
                for (int r = 0; r < 16; ++r) { p0[r] -= dl; p1[r] -= dl; o0[r] *= al; o1[r] *= al; negm[r] = -m; }
            }
            float sum = 0.f;
#pragma unroll
            for (int r = 0; r < 16; ++r) { p0[r] = __builtin_amdgcn_exp2f(p0[r]); p1[r] = __builtin_amdgcn_exp2f(p1[r]); sum += p0[r] + p1[r]; }
            l += sum;
            u32x4 pw[4];
#pragma unroll
            for (int k = 0; k < 2; ++k) {
                pw[k] = (u32x4){cvt_pk_bf16(p0[8 * k], p0[8 * k + 1]), cvt_pk_bf16(p0[8 * k + 2], p0[8 * k + 3]), cvt_pk_bf16(p0[8 * k + 4], p0[8 * k + 5]), cvt_pk_bf16(p0[8 * k + 6], p0[8 * k + 7])};
                pw[2 + k] = (u32x4){cvt_pk_bf16(p1[8 * k], p1[8 * k + 1]), cvt_pk_bf16(p1[8 * k + 2], p1[8 * k + 3]), cvt_pk_bf16(p1[8 * k + 4], p1[8 * k + 5]), cvt_pk_bf16(p1[8 * k + 6], p1[8 * k + 7])}; }
#pragma unroll
            for (int k = 0; k < 4; ++k) {
                const s16x4 a0 = vt[4 * k], a1 = vt[4 * k + 1], c0 = vt[4 * k + 2], c1 = vt[4 * k + 3];
                const bf16x8 vf0 = (bf16x8){a0[0], a0[1], a0[2], a0[3], a1[0], a1[1], a1[2], a1[3]}, vf1 = (bf16x8){c0[0], c0[1], c0[2], c0[3], c1[0], c1[1], c1[2], c1[3]};
                const bf16x8 pk = __builtin_bit_cast(bf16x8, pw[k]);
                o0 = __builtin_amdgcn_mfma_f32_32x32x16_bf16(vf0, pk, o0, 0, 0, 0); o1 = __builtin_amdgcn_mfma_f32_32x32x16_bf16(vf1, pk, o1, 0, 0, 0); }
            if (FOX && t > 0) { const float kbn = ((const LAS float*)(lds + KB_OFF))[64 * t - 1];
                if (__all(bq + kbn - m <= -40.f)) { wdone = true; if (lane == 0) dflag[wid] = it; } }
        }
    }
#undef ATT_ISSUE
    __builtin_amdgcn_s_setprio(0);
    l += xor32(l); const float il = 1.f / l;
    LAS bf16* stg = (LAS bf16*)(lds + OST_OFF + wid * OST_W);
#pragma unroll
    for (int g = 0; g < 4; ++g) {
        u32x2 w0, w1; w0.x = cvt_pk_bf16(o0[4 * g] * il, o0[4 * g + 1] * il); w0.y = cvt_pk_bf16(o0[4 * g + 2] * il, o0[4 * g + 3] * il);
        w1.x = cvt_pk_bf16(o1[4 * g] * il, o1[4 * g + 1] * il); w1.y = cvt_pk_bf16(o1[4 * g + 2] * il, o1[4 * g + 3] * il);
        *(LAS u32x2*)(stg + r32 * 72 + 8 * g + 4 * hi) = w0; *(LAS u32x2*)(stg + r32 * 72 + 32 + 8 * g + 4 * hi) = w1; }
    LDS_WAIT();
    bf16* Ow = O + (rowbase + qw0) * 512 + h * 64;
#pragma unroll
    for (int i = 0; i < 4; ++i) { const int row = i * 8 + (lane >> 3), ch = lane & 7; const u32x4 v = *(const LAS u32x4*)(stg + row * 72 + ch * 8); *(u32x4*)(Ow + (size_t)row * 512 + ch * 8) = v; }
    LDS_WAIT(); __builtin_amdgcn_s_barrier(); asm volatile("" ::: "memory");
}
}

#define XB_TMO      128
#define XB_XCNT(j)  (256  + 64 * (j))
#define XB_XSUB(j)  (1280 + 64 * (j))
#define XB_XGEN(j)  (2304 + 64 * (j))
#define XB_TOP      3328
#define XB_TOPGEN   3392
#define XCD_BAR_WORDS 3456
#define XB_SPIN_CAP (1u << 18)
__device__ __forceinline__ unsigned xb_ld(unsigned* p)              { return __hip_atomic_load(p, __ATOMIC_RELAXED, __HIP_MEMORY_SCOPE_AGENT); }
__device__ __forceinline__ unsigned xb_add(unsigned* p, unsigned v) { return __hip_atomic_fetch_add(p, v, __ATOMIC_RELAXED, __HIP_MEMORY_SCOPE_AGENT); }
__device__ __forceinline__ unsigned xb_xcc_id() { return (unsigned)__builtin_amdgcn_s_getreg((3 << 11) | 20) & 0xFu; }
#define XB_SPIN(cond, bar) do { unsigned _sp = 0; while (cond) { __builtin_amdgcn_s_sleep(1); \
    if ((++_sp & 255u) == 0u) { if (xb_ld(&(bar)[XB_TMO])) break; if (_sp > XB_SPIN_CAP) { atomicAdd(&(bar)[XB_TMO], 1u); break; } } } } while (0)
struct XcdBarrier { unsigned* bar; unsigned x; volatile LAS unsigned* st; };
__device__ __forceinline__ XcdBarrier xcd_barrier_post(unsigned* bar, volatile LAS unsigned* st) {
    XcdBarrier b; b.bar = bar; b.x = xb_xcc_id(); b.st = st;
    if (threadIdx.x == 0) (void)xb_add(&bar[XB_XCNT(b.x)], 1u);
    return b;
}
__device__ __forceinline__ void xcd_barrier_complete(unsigned* bar, unsigned x, unsigned& nloc, unsigned& nx) {
    const unsigned G = gridDim.x * gridDim.y * gridDim.z;
    unsigned sum, cnt, mine, sp = 0u;
    for (;;) {
        sum = 0u; cnt = 0u; mine = 0u;
#pragma unroll
        for (unsigned j = 0; j < 16; ++j) { const unsigned c = xb_ld(&bar[XB_XCNT(j)]); sum += c; cnt += (c > 0u) ? 1u : 0u; mine = (j == x) ? c : mine; }
        if (sum == G) break;
        __builtin_amdgcn_s_sleep(1);
        if ((++sp & 255u) == 0u) { if (xb_ld(&bar[XB_TMO])) break; if (sp > XB_SPIN_CAP) { atomicAdd(&bar[XB_TMO], 1u); break; } }
    }
    nloc = mine > 0u ? mine : 1u; nx = cnt > 0u ? cnt : 1u;
}
__device__ __forceinline__ void xcd_barrier(const XcdBarrier& b) {
    asm volatile("s_waitcnt vmcnt(0)" ::: "memory");
    __syncthreads();
    if (threadIdx.x == 0) {
        unsigned* bar = b.bar;
        __builtin_amdgcn_s_waitcnt(0);
        unsigned nloc = b.st[0], nx = b.st[1];
        if (nloc == 0u) { xcd_barrier_complete(bar, b.x, nloc, nx); b.st[0] = nloc; b.st[1] = nx; }
        const unsigned old = xb_add(&bar[XB_XSUB(b.x)], 1u);
        const unsigned gen = old / nloc;
        if (old + 1u == (gen + 1u) * nloc) {
            __builtin_amdgcn_fence(__ATOMIC_RELEASE, "agent");
            asm volatile("s_waitcnt vmcnt(0)" ::: "memory");
            const unsigned og = xb_add(&bar[XB_TOP], 1u);
            const unsigned tg = og / nx;
            if (og + 1u == (tg + 1u) * nx) xb_add(&bar[XB_TOPGEN], 1u);
            else XB_SPIN(xb_ld(&bar[XB_TOPGEN]) == tg, bar);
            __builtin_amdgcn_fence(__ATOMIC_ACQUIRE, "agent");
            xb_add(&bar[XB_XGEN(b.x)], 1u);
            asm volatile("s_waitcnt vmcnt(0)" ::: "memory");
        } else {
            XB_SPIN(xb_ld(&bar[XB_XGEN(b.x)]) == gen, bar);
            __builtin_amdgcn_fence(__ATOMIC_ACQUIRE, "agent");
            asm volatile("s_waitcnt vmcnt(0)" ::: "memory");
        }
    }
    __syncthreads();
}

struct Frame { LAS unsigned char* lds; volatile LAS unsigned* MISC; int tid, wave, vcu, G; };

constexpr int W_SMALL = 128 * 16 + 24 * 4 + 32 * 4 + 32 * 8 + 32 * 8 + 32 * 16, W_ALL = W_SMALL + 32 * 64 * 16 + 32 * 32 * 16;
struct WItem { const float* src; const float* ksc; bf16* dst; int ldw, ldt, nvalid, fp8; };
__device__ __forceinline__ WItem wt_decode(const P& p, int it) {
    constexpr int I_WIN = 128 * 16, I_WQ = 24 * 4, I_WKV = 32 * 4, I_WF = 32 * 8, I_WM = 32 * 8, I_WO = 32 * 16, I_GU = 32 * 64 * 16;
    WItem w; w.ksc = nullptr; w.nvalid = 32; w.fp8 = 0; int r = it;
    if (r < I_WIN) { const int db = r & 127, kb = r >> 7, n = 32 * db; int src0;
        if (n < 1536) src0 = n; else if (n < 1792) src0 = C_QL + (n - 1536);
        else if (n < 2048) { const int j = n - 1792; if (j < 128) src0 = C_KV + j; else if (j == 128) src0 = C_KPE; else if (j == 160) { src0 = C_FL; w.nvalid = 8; } else { src0 = 0; w.nvalid = 0; } }
        else src0 = C_G + (n - 2048);
        w.src = p.w_in + (size_t)(64 * kb) * IN_COLS + src0; w.ldw = IN_COLS; w.dst = WSP(bf16, WS_WIN) + (size_t)n * 1024 + 64 * kb; w.ldt = 1024;
#if GATE_FP8
        if (n >= 2048) { w.fp8 = 1; w.dst = (bf16*)(WSP(unsigned char, WS_WIN8) + (size_t)(n - 2048) * 1024 + 64 * kb); }
#endif
        return w; }
    r -= I_WIN;
    if (r < I_WQ) { const int db = r % 24, kb = r / 24, n = 32 * db; const int src0 = (n < 512) ? (n >> 6) * 96 + (n & 63) : ((n - 512) >> 5) * 96 + 64;
        w.src = p.w_q_b + (size_t)(64 * kb) * 768 + src0; w.ldw = 768; w.ksc = p.g_q_a + 64 * kb; w.dst = WSP(bf16, WS_WQ) + (size_t)n * 256 + 64 * kb; w.ldt = 256; return w; }
    r -= I_WQ;
    if (r < I_WKV) { const int db = r & 31, kb = r >> 5, n = 32 * db; const int nn = n & 511; const int src0 = (nn >> 6) * 128 + (n >= 512 ? 64 : 0) + (nn & 63);
        w.src = p.w_kv_b + (size_t)((kb < 2) ? 64 * kb : 0) * 1024 + src0; w.ldw = 1024; w.ksc = p.g_kv_a + ((kb < 2) ? 64 * kb : 0); w.nvalid = (kb < 2) ? 32 : 0; w.dst = (kb < 2) ? WSP(bf16, WS_WKV) + (size_t)n * 128 + 64 * kb : WSP(bf16, WS_WKV) + (size_t)1024 * 128 + (size_t)n * 128 + 64 * (kb - 2); w.ldt = 128; return w; }
    r -= I_WKV;
    if (r < I_WF) { const int db = r & 31, kb = r >> 5; w.src = p.w_fox + (size_t)(64 * kb) * 1024 + 32 * db; w.ldw = 1024; w.dst = WSP(bf16, WS_WF) + (size_t)(32 * db) * 512 + 64 * kb; w.ldt = 512; return w; }
    r -= I_WF;
    if (r < I_WM) { const int db = r & 31, kb = r >> 5; w.src = p.w_mla + (size_t)(64 * kb) * 1024 + 32 * db; w.ldw = 1024; w.dst = WSP(bf16, WS_WM) + (size_t)(32 * db) * 512 + 64 * kb; w.ldt = 512; return w; }
    r -= I_WM;
    if (r < I_WO) { const int db = r & 31, kb = r >> 5; w.src = p.w_o + (size_t)(64 * kb) * 1024 + 32 * db; w.ldw = 1024; w.ldt = 1024;
#if WO_FP8
        w.fp8 = 1; w.dst = (bf16*)(WSP(unsigned char, WS_WO) + (size_t)(32 * db) * 1024 + 64 * kb);
#else
        w.dst = WSP(bf16, WS_WO) + (size_t)(32 * db) * 1024 + 64 * kb;
#endif
        return w; }
    r -= I_WO;
    if (r < I_GU) { const int e = r >> 10, rr = r & 1023, db = rr & 63, kb = rr >> 6, n = 32 * db; const int src0 = ((n >> 7) & 1) * 1024 + (n >> 8) * 128 + (n & 127);
        w.src = p.w_gu + (size_t)e * 1024 * 2048 + (size_t)(64 * kb) * 2048 + src0; w.ldw = 2048; w.ldt = 1024;
#if MOE_FP8
        w.fp8 = 1; w.dst = (bf16*)(WSP(unsigned char, WS_WGU) + (size_t)e * 2048 * 1024 + (size_t)n * 1024 + 64 * kb);
#else
        w.dst = WSP(bf16, WS_WGU) + (size_t)e * 2048 * 1024 + (size_t)n * 1024 + 64 * kb;
#endif
        return w; }
    r -= I_GU;
    { const int e = r >> 9, rr = r & 511, db = rr & 31, kb = rr >> 5;
        w.src = p.w_down + (size_t)e * 1024 * 1024 + (size_t)(64 * kb) * 1024 + 32 * db; w.ldw = 1024; w.ldt = 1024;
#if MOE_FP8
        w.fp8 = 1; w.dst = (bf16*)(WSP(unsigned char, WS_WD) + (size_t)e * 1024 * 1024 + (size_t)(32 * db) * 1024 + 64 * kb);
#else
        w.dst = WSP(bf16, WS_WD) + (size_t)e * 1024 * 1024 + (size_t)(32 * db) * 1024 + 64 * kb;
#endif
        return w; }
}
struct BgConv {
    const P* p; LAS unsigned char* scr; unsigned stage; int it, step, stride, age; bool active, pend; WItem w;
    __device__ __forceinline__ void init(const P& p_, LAS unsigned char* scr_, LAS unsigned char* stage_, int it0, int stride_) { p = &p_; scr = scr_; stage = (unsigned)(size_t)stage_; it = it0; stride = stride_; step = 0; age = 0; active = it0 < W_ALL; pend = false; w = wt_decode(p_, active ? it0 : W_SMALL); }
    __device__ __forceinline__ void issue(int lane) {
        if (!active) return;
        const float* g = w.src + (size_t)(8 * step + (lane >> 3)) * w.ldw + 4 * (lane & 7);
#pragma unroll
        for (int j = 0; j < 4; ++j) att::glds16(g + (size_t)(8 * j) * w.ldw, stage + 1024 * j);
        pend = true; age = 0;
    }
    __device__ __forceinline__ void consume(int lane) {
        if (!pend) return;
        pend = false;
        { const LAS unsigned char* sp = (const LAS unsigned char*)(size_t)stage + 16 * lane;
          f32x4 x[4];
#pragma unroll
          for (int j = 0; j < 4; ++j) x[j] = *(const LAS f32x4*)(sp + 1024 * j) * 32.f;
          LDS_WAIT(); asm volatile("" ::: "memory");
          LAS unsigned char* q = scr + (8 * step + (lane >> 3)) * 36 + 4 * (lane & 7);
#pragma unroll
          for (int j = 0; j < 4; ++j) { int b = __builtin_amdgcn_cvt_pk_fp8_f32(x[j][0], x[j][1], 0, false); b = __builtin_amdgcn_cvt_pk_fp8_f32(x[j][2], x[j][3], b, true); *(LAS int*)(q + 8 * 36 * j) = b; } }
        step += 4;
        if (step < 8) return;
        LDS_WAIT(); asm volatile("" ::: "memory");
        const int c = lane & 7, ng = lane >> 3;
        unsigned d[8];
#pragma unroll
        for (int q = 0; q < 8; ++q) d[q] = *(const LAS unsigned*)(scr + (8 * c + q) * 36 + 4 * ng);
        unsigned t[2][4];
#pragma unroll
        for (int h = 0; h < 2; ++h) {
            const unsigned p01l = __builtin_amdgcn_perm(d[4 * h + 1], d[4 * h], 0x05010400u), p01h = __builtin_amdgcn_perm(d[4 * h + 1], d[4 * h], 0x07030602u);
            const unsigned p23l = __builtin_amdgcn_perm(d[4 * h + 3], d[4 * h + 2], 0x05010400u), p23h = __builtin_amdgcn_perm(d[4 * h + 3], d[4 * h + 2], 0x07030602u);
            t[h][0] = __builtin_amdgcn_perm(p23l, p01l, 0x05040100u); t[h][1] = __builtin_amdgcn_perm(p23l, p01l, 0x07060302u);
            t[h][2] = __builtin_amdgcn_perm(p23h, p01h, 0x05040100u); t[h][3] = __builtin_amdgcn_perm(p23h, p01h, 0x07060302u); }
        unsigned char* dst = (unsigned char*)w.dst;
#pragma unroll
        for (int j = 0; j < 4; ++j) *(u32x2*)(dst + (size_t)(4 * ng + j) * w.ldt + 8 * c) = (u32x2){t[0][j], t[1][j]};
        LDS_WAIT(); asm volatile("" ::: "memory");
        step = 0; it += stride; active = it < W_ALL; if (active) w = wt_decode(*p, it);
    }
};
__device__ __forceinline__ void wt_load(const WItem& w, f32x4 (&v)[8], int lane) {
    const int n4 = lane & 7;
#pragma unroll
    for (int i = 0; i < 8; ++i) { const int kk = 8 * i + (lane >> 3); v[i] = (f32x4){0.f, 0.f, 0.f, 0.f};
        if (4 * n4 < w.nvalid) { v[i] = *(const f32x4*)(w.src + (size_t)kk * w.ldw + 4 * n4); if (w.ksc) v[i] = v[i] * w.ksc[kk]; } }
}
__device__ __forceinline__ void wt_store(const WItem& w, const f32x4 (&v)[8], LAS float* scr, int lane) {
    const int n4 = lane & 7;
#pragma unroll
    for (int i = 0; i < 8; ++i) { const int kk = 8 * i + (lane >> 3); LAS float* s = scr + kk * 33 + 4 * n4; s[0] = v[i][0]; s[1] = v[i][1]; s[2] = v[i][2]; s[3] = v[i][3]; }
    LDS_WAIT(); asm volatile("" ::: "memory");
    const int c = lane & 7;
#pragma unroll
    for (int j = 0; j < 4; ++j) { const int n = (lane >> 3) + 8 * j; const LAS float* s = scr + (8 * c) * 33 + n;
        if (w.fp8) { *(u32x2*)((unsigned char*)w.dst + (size_t)n * w.ldt + 8 * c) = pack8_fp8((f32x4){s[0 * 33], s[1 * 33], s[2 * 33], s[3 * 33]} * 32.f, (f32x4){s[4 * 33], s[5 * 33], s[6 * 33], s[7 * 33]} * 32.f); }
        else { u32x4 o; o.x = cvt_pk_bf16(s[0 * 33], s[1 * 33]); o.y = cvt_pk_bf16(s[2 * 33], s[3 * 33]); o.z = cvt_pk_bf16(s[4 * 33], s[5 * 33]); o.w = cvt_pk_bf16(s[6 * 33], s[7 * 33]);
            *(u32x4*)(w.dst + (size_t)n * w.ldt + 8 * c) = o; } }
    LDS_WAIT(); asm volatile("" ::: "memory");
}
__device__ __forceinline__ void wt_convert_range(const P& p, Frame& F, int lo, int hi) {
    LAS float* scr = (LAS float*)(F.lds + F.wave * 16384);
    const int gw = F.vcu * NWAVES + F.wave, NGW = F.G * NWAVES;
    int it = lo + gw; f32x4 va[8], vb[8];
    WItem wa = wt_decode(p, it < hi ? it : lo), wb = wa;
    if (it < hi) wt_load(wa, va, (F.tid & 63));
    while (it < hi) {
        const int nx = it + NGW;
        if (nx < hi) { wb = wt_decode(p, nx); wt_load(wb, vb, (F.tid & 63)); }
        wt_store(wa, va, scr, (F.tid & 63));
        it = nx; if (it >= hi) break;
        const int nx2 = it + NGW;
        if (nx2 < hi) { wa = wt_decode(p, nx2); wt_load(wa, va, (F.tid & 63)); }
        wt_store(wb, vb, scr, (F.tid & 63));
        it = nx2;
    }
}
__device__ __forceinline__ void p0_prologue(const P& p, Frame& F) {
    LAS float* scr = (LAS float*)(F.lds + F.wave * 16384);
    const int gw = F.vcu * NWAVES + F.wave, NGW = F.G * NWAVES;
    constexpr int NITEMS = W_SMALL;
    {
        int it = gw; f32x4 va[8], vb[8];
        WItem wa = wt_decode(p, it < NITEMS ? it : 0), wb = wa;
        if (it < NITEMS) wt_load(wa, va, (F.tid & 63));
        while (it < NITEMS) {
            const int nx = it + NGW;
            if (nx < NITEMS) { wb = wt_decode(p, nx); wt_load(wb, vb, (F.tid & 63)); }
            wt_store(wa, va, scr, (F.tid & 63));
            it = nx; if (it >= NITEMS) break;
            const int nx2 = it + NGW;
            if (nx2 < NITEMS) { wa = wt_decode(p, nx2); wt_load(wa, va, (F.tid & 63)); }
            wt_store(wb, vb, scr, (F.tid & 63));
            it = nx2;
        }
    }
    for (int m0 = gw; m0 < NTOK; m0 += 2 * NGW) {
        f32x4 v[2][4];
#pragma unroll
        for (int q = 0; q < 2; ++q) { const int mrow = (m0 + q * NGW < NTOK) ? m0 + q * NGW : m0; const f32x4* xr = (const f32x4*)(p.x + (size_t)mrow * DM) + (F.tid & 63);
#pragma unroll
            for (int j = 0; j < 4; ++j) v[q][j] = xr[64 * j]; }
#pragma unroll
        for (int q = 0; q < 2; ++q) { const int mrow = m0 + q * NGW; if (mrow >= NTOK) break;
            float s = 0.f;
#pragma unroll
            for (int j = 0; j < 4; ++j) s += (v[q][j].x * v[q][j].x + v[q][j].y * v[q][j].y) + (v[q][j].z * v[q][j].z + v[q][j].w * v[q][j].w);
            const float rs = 1.f / sqrtf(wave_sum(s) * (1.f / DM) + EPS);
            const f32x4* gr = (const f32x4*)p.g_attn + (F.tid & 63); u32x2* o8 = (u32x2*)(WSP(bf16, WS_H) + (size_t)mrow * DM) + (F.tid & 63);
#pragma unroll
            for (int j = 0; j < 4; ++j) { const f32x4 g = gr[64 * j]; const f32x4 hv = (f32x4){v[q][j].x * rs * g.x, v[q][j].y * rs * g.y, v[q][j].z * rs * g.z, v[q][j].w * rs * g.w};
                u32x2 w; w.x = cvt_pk_bf16(hv.x, hv.y); w.y = cvt_pk_bf16(hv.z, hv.w); o8[64 * j] = w;
#if GATE_FP8
                { int b8 = __builtin_amdgcn_cvt_pk_fp8_f32(hv.x, hv.y, 0, false); b8 = __builtin_amdgcn_cvt_pk_fp8_f32(hv.z, hv.w, b8, true); ((unsigned*)(WSP(unsigned char, WS_H8) + (size_t)mrow * DM))[(F.tid & 63) + 64 * j] = (unsigned)b8; }
#endif
            } }
    }
    if (blockIdx.x == 0 && F.tid < 64) WSP(unsigned, WS_MISC)[GM_KMAX + F.tid] = 0u;
    if (blockIdx.x == 0 && F.tid < 32) WSP(int, WS_MISC)[GM_CUR + F.tid] = 0;
    for (int idx = (F.vcu * NWAVES * 64) + F.tid; idx < NTOK * 16; idx += F.G * NWAVES * 64) {
        const int tok = idx >> 4, j = idx & 15;
        const float inv_freq = powf(10000.0f, -(float)j / 16.0f); const float ang = (float)p.pos[tok] * inv_freq;
        float* cs = WSP(float, WS_CS) + (size_t)tok * 32; cs[j] = cosf(ang); cs[16 + j] = sinf(ang);
    }
}
__device__ __forceinline__ void p2a_rows(const P& p, Frame& F) {
    const int gw = F.vcu * NWAVES + F.wave, l = (F.tid & 63); const int bb = gw >> 8, r0 = bb * SEQ + (gw & 255);
    float kmx = 0.f;
    for (int jb = 0; jb < 16; jb += 4) {
        u32x4 wv[4], kv[4];
#pragma unroll
        for (int q = 0; q < 4; ++q) { const int mrow = r0 + 256 * (jb + q); wv[q] = *((const u32x4*)(WSP(const bf16, WS_QL) + (size_t)mrow * 512) + l); kv[q] = *((const u32x4*)(WSP(const bf16, WS_KF) + (size_t)mrow * 512) + l); }
#pragma unroll
        for (int q = 0; q < 4; ++q) { const int mrow = r0 + 256 * (jb + q); const u32x4 w = wv[q];
            { const u32x4 k = kv[q]; const float k8[8] = {bflo(k.x), bfhi(k.x), bflo(k.y), bfhi(k.y), bflo(k.z), bfhi(k.z), bflo(k.w), bfhi(k.w)}; float ks = 0.f;
#pragma unroll
              for (int i = 0; i < 8; ++i) ks += k8[i] * k8[i];
              ks += __shfl_xor(ks, 1); ks += __shfl_xor(ks, 2); ks += __shfl_xor(ks, 4); kmx = fmaxf(kmx, ks); }
            float v[8] = {bflo(w.x), bfhi(w.x), bflo(w.y), bfhi(w.y), bflo(w.z), bfhi(w.z), bflo(w.w), bfhi(w.w)};
            float s = 0.f;
#pragma unroll
            for (int i = 0; i < 8; ++i) s += v[i] * v[i];
            const float sq = wave_sum(l < 32 ? s : 0.f), sk = wave_sum((l >= 32 && l < 48) ? s : 0.f);
            if (l == 0) { float* rs = WSP(float, WS_SSQ) + (size_t)mrow * 2; rs[0] = 1.f / sqrtf(sq * (1.f / 256) + EPS); rs[1] = 1.f / sqrtf(sk * (1.f / 128) + EPS); }
            float pv[8];
#pragma unroll
            for (int i = 0; i < 8; ++i) pv[i] = __shfl_xor(v[i], 2);
            if (l >= 48 && l < 52) {
                const int jq = 8 * (l - 48); const float* cs = WSP(const float, WS_CS) + (size_t)mrow * 32 + (jq & 15); const float sg = (jq < 16) ? -1.f : 1.f;
                float o[8];
#pragma unroll
                for (int i = 0; i < 8; ++i) o[i] = v[i] * cs[i] + sg * pv[i] * cs[16 + i];
                u32x4 ow; ow.x = cvt_pk_bf16(o[0], o[1]); ow.y = cvt_pk_bf16(o[2], o[3]); ow.z = cvt_pk_bf16(o[4], o[5]); ow.w = cvt_pk_bf16(o[6], o[7]);
                *(u32x4*)(WSP(bf16, WS_KPE) + (size_t)mrow * 32 + jq) = ow;
            }
            if (l == 52) {
                float* lf = WSP(float, WS_LOGF) + (size_t)mrow * 8;
#pragma unroll
                for (int i = 0; i < 8; ++i) { const float z = v[i] + p.b_fgate[i]; lf[i] = fminf(z, 0.f) - log1pf(expf(-fabsf(z))); }
            }
        }
    }
    if ((l & 7) == 0) atomicMax(WSP(unsigned, WS_MISC) + GM_KMAX + bb * 8 + (l >> 3), __float_as_uint(kmx));
}
__device__ __forceinline__ void p2_cumsum(const P& p, Frame& F, int bh) {
    const int b = bh >> 3, h = bh & 7, t = F.tid;
    const float* lf = WSP(const float, WS_LOGF) + ((size_t)b * SEQ + 8 * t) * 8 + h;
    float v[8], tot = 0.f;
#pragma unroll
    for (int i = 0; i < 8; ++i) { v[i] = lf[i * 8]; tot += v[i]; }
    float inc = tot;
#pragma unroll
    for (int o = 1; o < 64; o <<= 1) { const float x = __shfl_up(inc, o); if ((F.tid & 63) >= o) inc += x; }
    LAS float* wt = (LAS float*)(F.lds);
    if ((F.tid & 63) == 63) wt[F.wave] = inc;
    __syncthreads();
    float run = inc - tot;
    for (int w = 0; w < F.wave; ++w) run += wt[w];
    float* kb = WSP(float, WS_KB) + (size_t)bh * SEQ + 8 * t;
#pragma unroll
    for (int i = 0; i < 8; ++i) { run += v[i]; kb[i] = -run * LOG2E; }
    __syncthreads();
}
__device__ __forceinline__ void p6_router(const P& p, Frame& F) {
    LAS bf16x8* WRH = (LAS bf16x8*)F.lds; LAS bf16x8* WRL = WRH + 4096;
    for (int f = F.tid; f < 4096; f += NWAVES * 64) { const int ln = f & 63, nb = (f >> 6) & 1, ks = f >> 7; const float* src = p.w_router + (size_t)(32 * ks + 8 * (ln >> 4)) * 32 + 16 * nb + (ln & 15);
        bf16x8 h, lo;
#pragma unroll
        for (int j = 0; j < 8; ++j) { const float w = src[j * 32]; const unsigned hb = f2bf(w); h[j] = (short)hb; lo[j] = (short)f2bf(w - bf2f((bf16)hb)); }
        WRH[f] = h; WRL[f] = lo; }
    volatile LAS unsigned* hist = F.MISC + 32;
    if (F.tid < 32) hist[F.tid] = 0u;
    __syncthreads();
    const int wg = blockIdx.x, lane = (F.tid & 63), tr = lane & 15, kq = lane >> 4;
    const int tok0 = wg * 128 + F.wave * 16;
    const bf16* xr = WSP(const bf16, WS_X1) + (size_t)(tok0 + tr) * DM + 8 * kq;
    const float* gr = p.g_ffn + 8 * kq;
    f32x4 acc0 = {0.f, 0.f, 0.f, 0.f}, acc1 = {0.f, 0.f, 0.f, 0.f}; float ss = 0.f;
#pragma unroll 4
    for (int ks = 0; ks < 32; ++ks) {
        const u32x4 xw = *(const u32x4*)(xr + 32 * ks); const f32x4 x0 = (f32x4){bflo(xw.x), bfhi(xw.x), bflo(xw.y), bfhi(xw.y)}, x1 = (f32x4){bflo(xw.z), bfhi(xw.z), bflo(xw.w), bfhi(xw.w)}, g0 = *(const f32x4*)(gr + 32 * ks), g1 = *(const f32x4*)(gr + 32 * ks + 4);
        ss += (x0[0] * x0[0] + x0[1] * x0[1]) + (x0[2] * x0[2] + x0[3] * x0[3]) + (x1[0] * x1[0] + x1[1] * x1[1]) + (x1[2] * x1[2] + x1[3] * x1[3]);
        const f32x4 a0 = x0 * g0, a1 = x1 * g1;
        bf16x8 ah, al;
#pragma unroll
        for (int j = 0; j < 4; ++j) { const unsigned h0 = f2bf(a0[j]), h1 = f2bf(a1[j]); ah[j] = (short)h0; ah[4 + j] = (short)h1; al[j] = (short)f2bf(a0[j] - bf2f((bf16)h0)); al[4 + j] = (short)f2bf(a1[j] - bf2f((bf16)h1)); }
        const bf16x8 bh0 = WRH[(ks * 2 + 0) * 64 + lane], bh1 = WRH[(ks * 2 + 1) * 64 + lane], bl0 = WRL[(ks * 2 + 0) * 64 + lane], bl1 = WRL[(ks * 2 + 1) * 64 + lane];
        acc0 = __builtin_amdgcn_mfma_f32_16x16x32_bf16(ah, bh0, acc0, 0, 0, 0); acc1 = __builtin_amdgcn_mfma_f32_16x16x32_bf16(ah, bh1, acc1, 0, 0, 0);
        acc0 = __builtin_amdgcn_mfma_f32_16x16x32_bf16(al, bh0, acc0, 0, 0, 0); acc1 = __builtin_amdgcn_mfma_f32_16x16x32_bf16(al, bh1, acc1, 0, 0, 0);
        acc0 = __builtin_amdgcn_mfma_f32_16x16x32_bf16(ah, bl0, acc0, 0, 0, 0); acc1 = __builtin_amdgcn_mfma_f32_16x16x32_bf16(ah, bl1, acc1, 0, 0, 0);
    }
    ss += __shfl_xor(ss, 16); ss += __shfl_xor(ss, 32);
    const float rs = 1.f / sqrtf(ss * (1.f / DM) + EPS);
    LAS float* LG = (LAS float*)(F.lds + ROWTAB_OFF) + F.wave * 544;
#pragma unroll
    for (int r = 0; r < 4; ++r) { LG[(4 * kq + r) * 32 + tr] = acc0[r]; LG[(4 * kq + r) * 32 + 16 + tr] = acc1[r]; }
    if (kq == 0) LG[512 + tr] = rs;
    LDS_WAIT(); asm volatile("" ::: "memory");
    int idx[4] = {0, 0, 0, 0}, rnk[4] = {0, 0, 0, 0}; float wgt[4] = {0.f, 0.f, 0.f, 0.f};
    if (lane < 16) {
        const float rst = LG[512 + lane]; float lg[32];
#pragma unroll
        for (int c = 0; c < 8; ++c) { const f32x4 v = *(const LAS f32x4*)(LG + lane * 32 + 4 * c); const f32x4 b = *(const f32x4*)(p.b_router + 4 * c);
            lg[4 * c] = v[0] * rst + b[0]; lg[4 * c + 1] = v[1] * rst + b[1]; lg[4 * c + 2] = v[2] * rst + b[2]; lg[4 * c + 3] = v[3] * rst + b[3]; }
        float val[4];
#pragma unroll
        for (int k = 0; k < 4; ++k) { float bv = -INFINITY; int bi = 0;
#pragma unroll
            for (int e = 0; e < 32; ++e) { const bool tk = lg[e] > bv; bv = tk ? lg[e] : bv; bi = tk ? e : bi; }
            idx[k] = bi; val[k] = bv;
#pragma unroll
            for (int e = 0; e < 32; ++e) lg[e] = (e == bi) ? -INFINITY : lg[e]; }
        float ex[4], sum = 0.f;
#pragma unroll
        for (int k = 0; k < 4; ++k) { ex[k] = expf(val[k] - val[0]); sum += ex[k]; }
        const float inv = 1.f / sum; const int tok = tok0 + lane;
        *(u32x4*)(WSP(int, WS_TOPI) + tok * 4) = (u32x4){(unsigned)idx[0], (unsigned)idx[1], (unsigned)idx[2], (unsigned)idx[3]};
        *(f32x4*)(WSP(float, WS_TOPW) + tok * 4) = (f32x4){ex[0] * inv, ex[1] * inv, ex[2] * inv, ex[3] * inv};
#pragma unroll
        for (int k = 0; k < 4; ++k) { rnk[k] = (int)__hip_atomic_fetch_add((LAS unsigned*)(F.lds + MISC_OFF) + 32 + idx[k], 1u, __ATOMIC_RELAXED, __HIP_MEMORY_SCOPE_WORKGROUP); wgt[k] = ex[k] * inv; }
    }
#if MOE_FP8
    unsigned char* H2 = WSP(unsigned char, WS_H2) + (size_t)(tok0 + tr) * DM + 8 * kq;
#else
    bf16* H2 = WSP(bf16, WS_H2) + (size_t)(tok0 + tr) * DM + 8 * kq;
#endif
#pragma unroll 4
    for (int ks = 0; ks < 32; ++ks) {
        const u32x4 xw = *(const u32x4*)(xr + 32 * ks); const f32x4 x0 = (f32x4){bflo(xw.x), bfhi(xw.x), bflo(xw.y), bfhi(xw.y)}, x1 = (f32x4){bflo(xw.z), bfhi(xw.z), bflo(xw.w), bfhi(xw.w)}, g0 = *(const f32x4*)(gr + 32 * ks), g1 = *(const f32x4*)(gr + 32 * ks + 4);
#if MOE_FP8
        *(u32x2*)(H2 + 32 * ks) = pack8_fp8(x0 * g0 * rs, x1 * g1 * rs); }
#else
        *(u32x4*)(H2 + 32 * ks) = pack8(x0 * g0 * rs, x1 * g1 * rs); }
#endif
    __syncthreads();
#if FUSED_ROWS
    volatile LAS int* gbase = (volatile LAS int*)(F.MISC + 64);
    if (F.tid < 32) gbase[F.tid] = atomicAdd(WSP(int, WS_MISC) + GM_CUR + F.tid, (int)hist[F.tid]);
    __syncthreads();
    if (lane < 16) { const int tok = tok0 + lane;
#pragma unroll
        for (int k = 0; k < 4; ++k) { const size_t pos = (size_t)idx[k] * ESTR + gbase[idx[k]] + rnk[k];
            WSP(int, WS_EROWTOK)[pos] = tok; WSP(int, WS_EROWSLOT)[pos] = tok * 4 + k; WSP(float, WS_EROWW)[pos] = wgt[k]; } }
#else
    if (F.tid < 32) WSP(int, WS_MISC)[GM_CNT + wg * 32 + F.tid] = (int)hist[F.tid];
#endif
    __syncthreads();
}
__device__ __forceinline__ void p7_rows(const P& p, Frame& F) {
    const int wg = blockIdx.x, tid = F.tid;
    LAS int* part = (LAS int*)F.lds;
    LAS int* tot = part + 512; LAS int* pre = tot + 32; LAS int* pstart = pre + 32; LAS int* base = pstart + 33; LAS unsigned* lcnt = (LAS unsigned*)(base + 32);
    const int* cnt = WSP(const int, WS_MISC) + GM_CNT;
    { const int e = tid & 31, j = tid >> 5; int s = 0;
#pragma unroll
      for (int w = 0; w < 16; ++w) s += cnt[(j * 16 + w) * 32 + e];
      part[j * 32 + e] = s; }
    __syncthreads();
    if (tid < 32) { int t = 0, pr = 0;
        for (int j = 0; j < 16; ++j) { if (j < (wg >> 4)) pr += part[j * 32 + tid]; t += part[j * 32 + tid]; }
        for (int w = (wg & ~15); w < wg; ++w) pr += cnt[w * 32 + tid];
        tot[tid] = t; pre[tid] = pr; lcnt[tid] = 0u; }
    __syncthreads();
    if (tid == 0) { int s = 0; for (int e = 0; e < 32; ++e) { pstart[e] = s; s += ((tot[e] + 255) >> 8) << 8; } pstart[32] = s; }
    __syncthreads();
    if (tid < 32) base[tid] = pstart[tid] + pre[tid];
    __syncthreads();
    { const int a = wg * 512 + tid; const int e = WSP(const int, WS_TOPI)[a]; const float w = WSP(const float, WS_TOPW)[a];
      const int pos = base[e] + (int)__hip_atomic_fetch_add(lcnt + e, 1u, __ATOMIC_RELAXED, __HIP_MEMORY_SCOPE_WORKGROUP);
      WSP(int, WS_ROWTOK)[pos] = a >> 2; WSP(int, WS_ROWSLOT)[pos] = a; WSP(float, WS_ROWW)[pos] = w; }
    if (wg < 32) { const int e = wg; const int s0 = pstart[e] + tot[e], s1 = pstart[e + 1];
        for (int r = s0 + tid; r < s1; r += NWAVES * 64) { WSP(int, WS_ROWTOK)[r] = 0; WSP(int, WS_ROWSLOT)[r] = NTOK * 4; WSP(float, WS_ROWW)[r] = 0.f; } }
    if (wg == 0) {
        if (tid == 0) WSP(int, WS_MISC)[GM_NBLK] = pstart[32] >> 8;
        if (tid < 32) { for (int bk = pstart[tid] >> 8; bk < (pstart[tid + 1] >> 8); ++bk) WSP(int, WS_MISC)[GM_BLKE + bk] = tid; }
    }
    __syncthreads();
}
__device__ __forceinline__ void moe_setup(const P& p, Frame& F, pg8::MoeOrder& S, int shift, int gc_log2, bool gather) {
    LAS int* blke = (LAS int*)(F.lds + BLKE_OFF); LAS int* rowtab = (LAS int*)(F.lds + ROWTAB_OFF);
#if FUSED_ROWS
    volatile LAS int* cntL = (volatile LAS int*)(F.MISC + 32); volatile LAS int* bst = (volatile LAS int*)(F.MISC + 64);
    if (F.tid < 64) {
        const int l = F.tid, c = (l < 32) ? WSP(const int, WS_MISC)[GM_CUR + l] : 0, nb = (c + 255) >> 8;
        int inc = nb;
#pragma unroll
        for (int d = 1; d < 32; d <<= 1) { const int o = __shfl_up(inc, d); if (l >= d) inc += o; }
        if (l < 32) { cntL[l] = c; bst[l] = inc - nb; }
        if (l == 31) bst[32] = inc;
    }
    __syncthreads();
    const int nblk = bst[32];
    for (int i = F.tid; i < MAXBLK; i += NWAVES * 64) { int e = 0;
#pragma unroll
        for (int st = 16; st >= 1; st >>= 1) { if (bst[e + st] <= i) e += st; }
        blke[i] = (i < nblk) ? e : 0; }
    __syncthreads();
    S.init(nblk, F.G, (int)blockIdx.x, shift, gc_log2, (const LAS int*)blke);
    if (gather) {
        for (int i = 0; i < ROWTAB_UNITS; ++i) { const int rb = S.rb_of(i); if (rb >= nblk) break;
            if (F.tid < 256) { const int e = blke[rb], pos = ((rb - bst[e]) << 8) + F.tid; rowtab[i * 256 + F.tid] = (pos < cntL[e]) ? WSP(const int, WS_EROWTOK)[(size_t)e * ESTR + pos] : 0; } }
        if (blockIdx.x < 32) { const int e = (int)blockIdx.x, c0_ = cntL[e], c1_ = ((c0_ + 255) >> 8) << 8;
            for (int q = c0_ + F.tid; q < c1_; q += NWAVES * 64) { WSP(int, WS_EROWSLOT)[(size_t)e * ESTR + q] = NTOK * 4; WSP(float, WS_EROWW)[(size_t)e * ESTR + q] = 0.f; } }
    }
#else
    const int nblk = WSP(const int, WS_MISC)[GM_NBLK];
    for (int i = F.tid; i < MAXBLK; i += NWAVES * 64) blke[i] = (i < nblk) ? WSP(const int, WS_MISC)[GM_BLKE + i] : 0;
    S.init(nblk, F.G, (int)blockIdx.x, shift, gc_log2, (const LAS int*)blke);
    if (gather) {
        for (int i = 0; i < ROWTAB_UNITS; ++i) { const int rb = S.rb_of(i); if (rb >= nblk) break;
            if (F.tid < 256) rowtab[i * 256 + F.tid] = WSP(const int, WS_ROWTOK)[rb * 256 + F.tid]; }
    }
#endif
    __syncthreads();
}
__device__ __forceinline__ void p10_final(const P& p, Frame& F) {
    const int gw = F.vcu * NWAVES + F.wave, NGW = F.G * NWAVES, lane = F.tid & 63;
#if Z_FP8
    typedef float f32x2 __attribute__((ext_vector_type(2)));
    for (int m0 = gw; m0 < NTOK; m0 += 2 * NGW) {
        f32x4 v[2][4]; unsigned z[2][4][4];
#pragma unroll
        for (int q = 0; q < 2; ++q) { const int mrow = (m0 + q * NGW < NTOK) ? m0 + q * NGW : m0;
            const u32x2* xr = (const u32x2*)(WSP(const bf16, WS_X1) + (size_t)mrow * DM) + lane;
#pragma unroll
            for (int j = 0; j < 4; ++j) { const u32x2 xw = xr[64 * j]; v[q][j] = (f32x4){bflo(xw.x), bfhi(xw.x), bflo(xw.y), bfhi(xw.y)};
#pragma unroll
                for (int k = 0; k < 4; ++k) z[q][j][k] = *((const unsigned*)(WSP(const unsigned char, WS_Z) + ((size_t)mrow * 4 + k) * 1024) + lane + 64 * j); } }
#pragma unroll
        for (int q = 0; q < 2; ++q) { const int mrow = m0 + q * NGW; if (mrow >= NTOK) break;
            float s = 0.f;
#pragma unroll
            for (int j = 0; j < 4; ++j) { f32x4 a = {0.f, 0.f, 0.f, 0.f};
#pragma unroll
                for (int k = 0; k < 4; ++k) { const f32x2 lo = __builtin_amdgcn_cvt_pk_f32_fp8((int)z[q][j][k], false), hi = __builtin_amdgcn_cvt_pk_f32_fp8((int)z[q][j][k], true); a.x += lo.x; a.y += lo.y; a.z += hi.x; a.w += hi.y; }
                v[q][j] = v[q][j] + a * 0.0625f;
                s += (v[q][j].x * v[q][j].x + v[q][j].y * v[q][j].y) + (v[q][j].z * v[q][j].z + v[q][j].w * v[q][j].w); }
            const float rs = 1.f / sqrtf(wave_sum(s) * (1.f / DM) + EPS);
            f32x4* xo = (f32x4*)(p.out + (size_t)mrow * DM) + lane; const f32x4* gr = (const f32x4*)p.g_final + lane;
#pragma unroll
            for (int j = 0; j < 4; ++j) { const f32x4 g = gr[64 * j]; xo[64 * j] = (f32x4){v[q][j].x * rs * g.x, v[q][j].y * rs * g.y, v[q][j].z * rs * g.z, v[q][j].w * rs * g.w}; }
        }
    }
#else
    for (int m0 = gw; m0 < NTOK; m0 += 2 * NGW) {
        f32x4 v[2][4]; u32x2 z[2][4][4];
#pragma unroll
        for (int q = 0; q < 2; ++q) { const int mrow = (m0 + q * NGW < NTOK) ? m0 + q * NGW : m0;
            const u32x2* xr = (const u32x2*)(WSP(const bf16, WS_X1) + (size_t)mrow * DM) + lane;
#pragma unroll
            for (int j = 0; j < 4; ++j) { const u32x2 xw = xr[64 * j]; v[q][j] = (f32x4){bflo(xw.x), bfhi(xw.x), bflo(xw.y), bfhi(xw.y)};
#pragma unroll
                for (int k = 0; k < 4; ++k) z[q][j][k] = *((const u32x2*)(WSP(const bf16, WS_Z) + ((size_t)mrow * 4 + k) * 1024) + lane + 64 * j); } }
#pragma unroll
        for (int q = 0; q < 2; ++q) { const int mrow = m0 + q * NGW; if (mrow >= NTOK) break;
            float s = 0.f;
#pragma unroll
            for (int j = 0; j < 4; ++j) {
#pragma unroll
                for (int k = 0; k < 4; ++k) { v[q][j].x += bflo(z[q][j][k].x); v[q][j].y += bfhi(z[q][j][k].x); v[q][j].z += bflo(z[q][j][k].y); v[q][j].w += bfhi(z[q][j][k].y); }
                s += (v[q][j].x * v[q][j].x + v[q][j].y * v[q][j].y) + (v[q][j].z * v[q][j].z + v[q][j].w * v[q][j].w); }
            const float rs = 1.f / sqrtf(wave_sum(s) * (1.f / DM) + EPS);
            f32x4* xo = (f32x4*)(p.out + (size_t)mrow * DM) + lane; const f32x4* gr = (const f32x4*)p.g_final + lane;
#pragma unroll
            for (int j = 0; j < 4; ++j) { const f32x4 g = gr[64 * j]; xo[64 * j] = (f32x4){v[q][j].x * rs * g.x, v[q][j].y * rs * g.y, v[q][j].z * rs * g.z, v[q][j].w * rs * g.w}; }
        }
    }
#endif
}

constexpr int NPHASE = 12;
struct Args { P p; int ph_lo, ph_hi; };
__global__ void __launch_bounds__(NWAVES * 64, 2) mk_fwd(Args args) {
    extern __shared__ __attribute__((aligned(16))) unsigned char lds_raw[];
    const P& p = args.p;
    Frame F;
    F.lds = (LAS unsigned char*)lds_raw; F.MISC = (volatile LAS unsigned*)(F.lds + MISC_OFF);
    F.tid = threadIdx.x; F.wave = __builtin_amdgcn_readfirstlane(F.tid >> 6);
    F.G = gridDim.x; { const int bx = blockIdx.x; F.vcu = (F.G % 8 == 0) ? (bx % 8) * (F.G / 8) + bx / 8 : bx; }
    for (int u = F.tid; u < 256; u += NWAVES * 64) F.MISC[u] = 0u;
    __syncthreads();
    const int lo = args.ph_lo, hi = args.ph_hi;
    const bool one = (hi - lo) > 1;
    XcdBarrier bar; bar.bar = (unsigned*)(p.ws + WS_CTL) + 4096; bar.x = 0; bar.st = nullptr;
    if (one) bar = xcd_barrier_post((unsigned*)(p.ws + WS_CTL) + 4096, F.MISC + 8);
#ifndef PH_MASK
#define PH_MASK 0xfff
#endif
#define IN(k) (((PH_MASK >> (k)) & 1) && lo <= (k) && (k) < hi)
#define SEAM(k) do { if (IN(k) && IN((k) + 1)) xcd_barrier(bar); } while (0)
    using namespace pg8;
    const int bx = (int)blockIdx.x;
    if (IN(0)) { p0_prologue(p, F); } SEAM(0);
    if (IN(1)) {
#if GATE_FP8
        { Gemm g{WSP(const bf16, WS_H), WSP(const bf16, WS_WIN), 1024, 1024}; StaticOrder S; S.init(NTOK, 2048, F.G, bx);
          EpiInproj<false> E{p.ws};
          gemm_phase<EpiInproj<false>, StaticOrder, true, false>(F.lds, g, S, E, nullptr); }
        { Gemm g{WSP(const bf16, WS_H8), WSP(const bf16, WS_WIN8), 1024, 1024}; StaticOrder S; S.init(NTOK, 2048, F.G, bx);
          EpiInproj<true> E{p.ws};
          gemm_phase8<EpiInproj<true>, StaticOrder, true, false>(F.lds, g, S, E, nullptr); }
#else
        Gemm g{WSP(const bf16, WS_H), WSP(const bf16, WS_WIN), 1024, 1024}; StaticOrder S; S.init(NTOK, 4096, F.G, bx);
        EpiInproj<false> E{p.ws};
        gemm_phase<EpiInproj<false>, StaticOrder, true, false>(F.lds, g, S, E, nullptr);
#endif
    } SEAM(1);
    if (IN(2)) { p2a_rows(p, F); } SEAM(2);
    if (IN(3)) {
        if (F.vcu < 64) p2_cumsum(p, F, F.vcu);
        { Gemm g{WSP(const bf16, WS_QL), WSP(const bf16, WS_WQ), 256, 512}; StaticOrder S; S.init(NTOK, 768, F.G, (F.G == 256) ? (((bx & 7) + 6) & 7) * 32 + (bx >> 3) : bx);
          EpiQup E{WSP(bf16, WS_QM), WSP(const float, WS_SSQ), WSP(const float, WS_CS)};
          gemm_phase<EpiQup, StaticOrder, true, false>(F.lds, g, S, E, nullptr); }
        { Gemm g{WSP(const bf16, WS_QL) + 256, WSP(const bf16, WS_WKV), 128, 512}; StaticOrder S; S.init(NTOK, 1024, F.G, bx);
          EpiKvup E{WSP(bf16, WS_KN), WSP(const float, WS_SSQ)};
          gemm_phase<EpiKvup, StaticOrder, true, false>(F.lds, g, S, E, nullptr); }
    } SEAM(3);
    if (IN(4)) {
        BgConv cv; cv.init(p, F.lds + ROWTAB_OFF + F.wave * 2304, F.lds + att::BG_STAGE_OFF + F.wave * 4096, W_SMALL + F.vcu * NWAVES + F.wave, F.G * NWAVES);
        const int flip = (F.G == 256) ? ((F.vcu >> 5) & 1) * 1024 : 0;
        for (int j0 = F.vcu; j0 < 2048; j0 += F.G) {
            const int j = (j0 + flip) & 2047;
            const int br = j >> 10, jj = j & 1023, r = jj >> 8, bh = (jj & 255) >> 2, s = jj & 3;
            const int qb = (r == 0) ? s : (r == 1) ? 7 - s : (r == 2) ? 8 + s : 15 - s;
            const int hf = ((bh & 7) + 2 * r) & 7;
            if (br == 0) att::attn_unit<64, true>(cv, F.lds, bh >> 3, hf, qb, WSP(const bf16, WS_QF), WSP(const bf16, WS_KF), WSP(const bf16, WS_KPE), WSP(const bf16, WS_VF), WSP(const float, WS_KB), WSP(bf16, WS_YF), __uint_as_float(WSP(const unsigned, WS_MISC)[GM_KMAX + (bh & ~7) + hf]));
            else att::attn_unit<96, false>(cv, F.lds, bh >> 3, bh & 7, qb, WSP(const bf16, WS_QM), WSP(const bf16, WS_KN), WSP(const bf16, WS_KPE), WSP(const bf16, WS_VM), WSP(const float, WS_KB), WSP(bf16, WS_YM), 0.f);
        }
        VM_WAIT(); cv.consume(F.tid & 63);
        while (cv.active) { cv.issue(F.tid & 63); VM_WAIT(); cv.consume(F.tid & 63); }
    } SEAM(4);
    if (IN(5)) {
        { Gemm g{WSP(const bf16, WS_YF), WSP(const bf16, WS_WF), 512, 512}; StaticOrder S; S.init(NTOK, 1024, F.G, bx);
          EpiMerge<0> E{WSP(bf16, WS_T0), WSP(bf16, WS_MG), WSP(const bf16, WS_G), p.b_merge};
          gemm_phase<EpiMerge<0>, StaticOrder, true, false>(F.lds, g, S, E, nullptr); }
        { Gemm g{WSP(const bf16, WS_YM), WSP(const bf16, WS_WM), 512, 512}; StaticOrder S; S.init(NTOK, 1024, F.G, bx);
          EpiMerge<1> E{WSP(bf16, WS_T0), WSP(bf16, WS_MG), WSP(const bf16, WS_G), p.b_merge};
          gemm_phase<EpiMerge<1>, StaticOrder, true, false>(F.lds, g, S, E, nullptr); }
    } SEAM(5);
    if (IN(6)) {
        StaticOrder S; S.init(NTOK, 1024, F.G, bx);
        EpiWo E{p.x, WSP(bf16, WS_X1)};
#if WO_FP8
        Gemm g{WSP(const bf16, WS_MG), WSP(const bf16, WS_WO), 1024, 1024, 0x7B7B7B7B};
        gemm_phase8<EpiWo, StaticOrder, true, false>(F.lds, g, S, E, nullptr);
#else
        Gemm g{WSP(const bf16, WS_MG), WSP(const bf16, WS_WO), 1024, 1024};
        gemm_phase<EpiWo, StaticOrder, true, false>(F.lds, g, S, E, nullptr);
#endif
    } SEAM(6);
    if (IN(7)) { p6_router(p, F); } SEAM(7);
#if !FUSED_ROWS
    if (IN(8)) { p7_rows(p, F); } SEAM(8);
#endif
    if (IN(9)) {
        MoeOrder S; moe_setup(p, F, S, 3, 1, true);
        Gemm g{WSP(const bf16, WS_H2), WSP(const bf16, WS_WGU), 1024, 1024};
        EpiSwiglu<MOE_FP8 != 0> E{WSP(bf16, WS_ACT), p.b_gu};
#if MOE_FP8
        gemm_phase8<EpiSwiglu<true>, MoeOrder, false, true>(F.lds, g, S, E, (const LAS int*)(F.lds + ROWTAB_OFF));
#else
        gemm_phase<EpiSwiglu<false>, MoeOrder, false, true>(F.lds, g, S, E, (const LAS int*)(F.lds + ROWTAB_OFF));
#endif
    } SEAM(9);
    if (IN(10)) {
        MoeOrder S; moe_setup(p, F, S, 2, 0, false);
        Gemm g{WSP(const bf16, WS_ACT), WSP(const bf16, WS_WD), 1024, 1024};
#if FUSED_ROWS
        EpiDown<MOE_FP8 != 0> E{WSP(bf16, WS_Z), p.b_down, WSP(const int, WS_EROWSLOT), WSP(const float, WS_EROWW), (const volatile LAS int*)(F.MISC + 32), (const volatile LAS int*)(F.MISC + 64)};
#else
        EpiDown<MOE_FP8 != 0> E{WSP(bf16, WS_Z), p.b_down, WSP(const int, WS_ROWSLOT), WSP(const float, WS_ROWW), nullptr, nullptr};
#endif
#if MOE_FP8
        gemm_phase8<EpiDown<true>, MoeOrder, true, false>(F.lds, g, S, E, nullptr);
#else
        gemm_phase<EpiDown<false>, MoeOrder, true, false>(F.lds, g, S, E, nullptr);
#endif
    } SEAM(10);
    if (IN(11)) { p10_final(p, F); }
#undef IN
#undef SEAM
}

extern "C" void kernel_launch(void* const* d_in, const int* in_sizes, int n_in, void* d_out, int out_size, void* d_ws, size_t ws_size, hipStream_t stream) {
    static int grid = 0;
    if (grid == 0) {
        if (n_in != 21 || out_size != NTOK * DM || ws_size < WS_END) { fprintf(stderr, "kernel_launch: unexpected sizes n_in %d out %d ws %zu\n", n_in, out_size, ws_size); grid = -1; return; }
        int dev = 0, cus = 0, per_cu = 0;
        if (hipGetDevice(&dev) != hipSuccess || hipDeviceGetAttribute(&cus, hipDeviceAttributeMultiprocessorCount, dev) != hipSuccess) { grid = -1; return; }
        if (hipFuncSetAttribute((const void*)mk_fwd, hipFuncAttributeMaxDynamicSharedMemorySize, LDS_BYTES) != hipSuccess) { fprintf(stderr, "kernel_launch: hipFuncSetAttribute failed\n"); grid = -1; return; }
        if (hipOccupancyMaxActiveBlocksPerMultiprocessor(&per_cu, (const void*)mk_fwd, NWAVES * 64, LDS_BYTES) != hipSuccess || per_cu < 1) { fprintf(stderr, "kernel_launch: occupancy query says %d\n", per_cu); }
        (void)hipGetLastError();
        if (cus != 256) { fprintf(stderr, "kernel_launch: built for 256 CUs, found %d\n", cus); grid = -1; return; }
        grid = 256;
    }
    if (grid < 0) return;
    P p{};
    p.x = (const float*)d_in[0]; p.pos = (const int*)d_in[1]; p.g_attn = (const float*)d_in[2]; p.w_in = (const float*)d_in[3]; p.b_fgate = (const float*)d_in[4];
    p.g_q_a = (const float*)d_in[5]; p.w_q_b = (const float*)d_in[6]; p.g_kv_a = (const float*)d_in[7]; p.w_kv_b = (const float*)d_in[8];
    p.w_fox = (const float*)d_in[9]; p.w_mla = (const float*)d_in[10]; p.b_merge = (const float*)d_in[11]; p.w_o = (const float*)d_in[12];
    p.g_ffn = (const float*)d_in[13]; p.w_router = (const float*)d_in[14]; p.b_router = (const float*)d_in[15];
    p.w_gu = (const float*)d_in[16]; p.b_gu = (const float*)d_in[17]; p.w_down = (const float*)d_in[18]; p.b_down = (const float*)d_in[19]; p.g_final = (const float*)d_in[20];
    p.out = (float*)d_out; p.ws = (unsigned char*)d_ws;
    (void)hipMemsetAsync((char*)d_ws + WS_CTL, 0, 64 * 1024, stream);
    Args a{}; a.p = p;
    a.ph_lo = 0; a.ph_hi = NPHASE;
    hipLaunchKernelGGL(mk_fwd, dim3(grid), dim3(NWAVES * 64), LDS_BYTES, stream, a);
}
```
